# Optimizing an MI355X kernel written in HIP

```python
import jax, jax.numpy as jnp
from jax import lax
import numpy as np

D_MODEL = 2048
BATCH = 1
SEQ = 16384
DEPTH = 1

GRID_W = 64
NA_HEAD_DIM = 64
NA_WIDTH = D_MODEL // 2
NA_HEADS = NA_WIDTH // NA_HEAD_DIM
NA_WIN_ROWS = 8
NA_WIN_COLS = 16
HG_KEY_DIM = 128
HG_VAL_DIM = 128
HG_WIDTH = D_MODEL // 2
HG_HEADS = HG_WIDTH // HG_VAL_DIM
HG_KEY_WIDTH = HG_HEADS * HG_KEY_DIM
HG_CHUNK = 64
N_BRANCHES = 2
NORM_EPS = 1e-6
IN_COLS = 4 * NA_WIDTH + 3 * HG_KEY_WIDTH + 2 * HG_WIDTH + N_BRANCHES * D_MODEL

kernel_name = "hybrid_natten_hgrn2_gated_merge_encoder"


def _rmsnorm(x, w):
    xf = x.astype(jnp.float32)
    y = xf * lax.rsqrt(jnp.mean(xf * xf, axis=-1, keepdims=True) + NORM_EPS)
    return (y * w.astype(jnp.float32)).astype(x.dtype)


def _neighbourhood_attention(q, k, v, rpb):
    B, T, H, Dh = q.shape
    rows = T // GRID_W
    wr = min(NA_WIN_ROWS, rows)
    qg = q.reshape(B, rows, GRID_W, H, Dh)
    kg = k.reshape(B, rows, GRID_W, H, Dh)
    vg = v.reshape(B, rows, GRID_W, H, Dh)
    qc = jnp.arange(GRID_W)
    kc = jnp.arange(GRID_W)
    cs = jnp.clip(qc - NA_WIN_COLS // 2, 0, GRID_W - NA_WIN_COLS)
    col_mask = (kc[None, :] >= cs[:, None]) & (kc[None, :] < cs[:, None] + NA_WIN_COLS)
    col_idx = jnp.clip(kc[None, :] - qc[:, None] + NA_WIN_COLS - 1, 0, 2 * NA_WIN_COLS - 2)
    scale = Dh ** -0.5

    def row_block(r):
        rs = jnp.clip(r - wr // 2, 0, rows - wr)
        kb = lax.dynamic_slice_in_dim(kg, rs, wr, axis=1)
        vb = lax.dynamic_slice_in_dim(vg, rs, wr, axis=1)
        qr = lax.dynamic_index_in_dim(qg, r, axis=1, keepdims=False)
        s = jnp.einsum('bqhd,bjkhd->bhqjk', qr, kb).astype(jnp.float32) * scale
        row_idx = rs + jnp.arange(wr) - r + NA_WIN_ROWS - 1
        bias = rpb[:, row_idx][:, :, col_idx]
        s = s + jnp.transpose(bias, (0, 2, 1, 3)).astype(jnp.float32)[None]
        s = jnp.where(col_mask[None, None, :, None, :], s, -jnp.inf)
        p = jax.nn.softmax(s.reshape(B, H, GRID_W, wr * GRID_W), axis=-1).astype(v.dtype)
        return jnp.einsum('bhqn,bnhd->bqhd', p, vb.reshape(B, wr * GRID_W, H, Dh))

    o = lax.map(row_block, jnp.arange(rows))
    return jnp.transpose(o, (1, 0, 2, 3, 4)).reshape(B, T, H, Dh)


def _gated_linear_scan(q, k, v, log_f):
    B, T, H, Dk = q.shape
    Dv = v.shape[-1]
    C = HG_CHUNK
    N = T // C

    def to_chunks(a):
        return a.reshape(B, N, C, H, a.shape[-1]).transpose(1, 0, 3, 2, 4)

    causal = jnp.tril(jnp.ones((C, C), dtype=bool))

    def step(S, inp):
        qb, kb, vb, gb = inp
        A = jnp.cumsum(gb, axis=2)
        diff = A[:, :, :, None, :] - A[:, :, None, :, :]
        decay = jnp.exp(jnp.where(causal[:, :, None], diff, -jnp.inf))
        scores = jnp.sum(qb[:, :, :, None, :] * kb[:, :, None, :, :] * decay, axis=-1)
        o = jnp.einsum('bhts,bhsv->bhtv', scores, vb) + \
            jnp.einsum('bhtd,bhdv->bhtv', qb * jnp.exp(A), S)
        A_last = A[:, :, -1, :]
        S = jnp.exp(A_last)[..., None] * S + \
            jnp.einsum('bhsd,bhsv->bhdv', kb * jnp.exp(A_last[:, :, None, :] - A), vb)
        return S, o

    S0 = jnp.zeros((B, H, Dk, Dv), jnp.float32)
    _, o = lax.scan(step, S0, (to_chunks(q), to_chunks(k), to_chunks(v), to_chunks(log_f)))
    return o.transpose(1, 0, 3, 2, 4).reshape(B, T, H, Dv)


def _hgrn2_bidirectional(q, f_fwd, f_bwd, i, lb):
    q = q.astype(jnp.float32)
    i = i.astype(jnp.float32)

    def gates(fl, lbd):
        fl = fl.astype(jnp.float32)
        f = lbd + (1.0 - lbd) * jax.nn.sigmoid(fl)
        return jnp.log(f), (1.0 - lbd) * jax.nn.sigmoid(-fl)

    lf_f, k_f = gates(f_fwd, lb[0])
    lf_b, k_b = gates(f_bwd, lb[1])
    o_fwd = _gated_linear_scan(q, k_f, i, lf_f)
    flip = lambda a: jnp.flip(a, axis=1)
    o_bwd = flip(_gated_linear_scan(flip(q), flip(k_b), flip(i), flip(lf_b)))
    return o_fwd + o_bwd


def setup_inputs(seed: int = 0) -> dict:
    key = jax.random.key(seed)
    ks = jax.random.split(key, 11)
    f32 = jnp.float32
    nrm = lambda k, s: jax.random.normal(k, s, f32)
    x = nrm(ks[0], (BATCH, SEQ, D_MODEL))
    norm_pre_w = 1.0 + 0.02 * nrm(ks[1], (DEPTH, D_MODEL))
    w_in = nrm(ks[2], (DEPTH, D_MODEL, IN_COLS)) * D_MODEL ** -0.5
    b_gate = 0.02 * nrm(ks[3], (DEPTH, N_BRANCHES * D_MODEL))
    na_rel_bias = 0.1 * nrm(ks[4], (DEPTH, NA_HEADS, 2 * NA_WIN_ROWS - 1, 2 * NA_WIN_COLS - 1))
    hg_lb_logits = 0.5 * nrm(ks[5], (DEPTH + 1, 2, HG_KEY_WIDTH))
    hg_norm_w = 1.0 + 0.02 * nrm(ks[6], (DEPTH, HG_WIDTH))
    w_branch = nrm(ks[7], (DEPTH, NA_WIDTH + HG_WIDTH, D_MODEL)) * NA_WIDTH ** -0.5
    w_out = nrm(ks[8], (DEPTH, D_MODEL, D_MODEL)) * D_MODEL ** -0.5
    norm_post_w = 1.0 + 0.02 * nrm(ks[9], (DEPTH, D_MODEL))
    return {"x": x, "norm_pre_w": norm_pre_w, "w_in": w_in, "b_gate": b_gate,
            "na_rel_bias": na_rel_bias, "hg_lb_logits": hg_lb_logits, "hg_norm_w": hg_norm_w,
            "w_branch": w_branch, "w_out": w_out, "norm_post_w": norm_post_w}


def reference(x, norm_pre_w, w_in, b_gate, na_rel_bias, hg_lb_logits, hg_norm_w, w_branch, w_out, norm_post_w):
    B, T, _ = x.shape
    lb_all = jnp.cumsum(jax.nn.softmax(hg_lb_logits.astype(jnp.float32), axis=0), axis=0)
    splits = [int(s) for s in np.cumsum([NA_WIDTH] * 4 + [HG_KEY_WIDTH] * 3 + [HG_WIDTH] * 2)]
    for l in range(DEPTH):
        xn = _rmsnorm(x, norm_pre_w[l])
        h = xn @ w_in[l]
        na_q, na_k, na_v, na_z, hg_q, hg_ff, hg_fb, hg_i, hg_z, gate_pre = jnp.split(h, splits, axis=-1)

        ha = lambda a: a.reshape(B, T, NA_HEADS, NA_HEAD_DIM)
        o_a = _neighbourhood_attention(ha(na_q), ha(na_k), ha(na_v), na_rel_bias[l]).reshape(B, T, NA_WIDTH)
        o_a = o_a * jax.nn.silu(na_z)

        hk = lambda a: a.reshape(B, T, HG_HEADS, HG_KEY_DIM)
        lb = lb_all[l].reshape(2, HG_HEADS, HG_KEY_DIM)
        o_b = _hgrn2_bidirectional(hk(hg_q), hk(hg_ff), hk(hg_fb), hg_i.reshape(B, T, HG_HEADS, HG_VAL_DIM), lb)
        o_b = _rmsnorm(o_b, hg_norm_w[l].reshape(HG_HEADS, HG_VAL_DIM)).reshape(B, T, HG_WIDTH).astype(x.dtype)
        o_b = o_b * jax.nn.silu(hg_z)

        g = jax.nn.sigmoid(gate_pre + b_gate[l])
        g_a, g_b = jnp.split(g, N_BRANCHES, axis=-1)
        y = g_a * (o_a @ w_branch[l, :NA_WIDTH]) + g_b * (o_b @ w_branch[l, NA_WIDTH:])
        x = x + _rmsnorm(y @ w_out[l], norm_post_w[l])
    return x
```

```cpp
#include <hip/hip_runtime.h>
#include <cstdio>
#include <cstdint>
namespace pg8 {
#define PG8_LAS __attribute__((address_space(3)))
typedef unsigned short bf16_t;
typedef short bf16x8 __attribute__((ext_vector_type(8)));
typedef float f32x4 __attribute__((ext_vector_type(4)));
typedef unsigned u32x4 __attribute__((ext_vector_type(4)));
constexpr int BM = 256, BK = 64, HALF = 128, HTB = HALF * BK * 2  , STAGE_BYTES = 8 * HTB, NXCD = 8, WGM = 8;

__host__ __device__ __forceinline__ int lds_byte(int r, int c) { const int st = (r >> 4) * 2 + (c >> 5), rr = r & 15, cc = c & 31, ob = rr * 64 + cc * 2; return st * 1024 + (ob ^ (((ob >> 9) & 1) << 5)); }
__host__ __device__ __forceinline__ void stage_rc(int b, int& R, int& C) { const int st = b / 1024, sb = b % 1024, swz = sb ^ (((sb >> 9) & 1) << 5); R = (st >> 1) * 16 + swz / 64; C = (st & 1) * 32 + (swz % 64) / 2; }
__host__ __device__ __forceinline__ int perm32(int rho) { const int n = rho >> 4, i = rho & 15; return 8 * (i >> 2) + 4 * n + (i & 3); }

struct Unit { int pm, pn; };
struct Gemm { const bf16_t* A; const bf16_t* Bt; int M, N, K; };

struct StaticOrder {
    int nM, nN, nwg, G, c;
    __host__ __device__ void init(int M, int N, int G_, int c_) { nM = M / BM; nN = N / BM; nwg = nM * nN; G = G_; c = c_; }
    __host__ __device__ bool next(int i, Unit& u) const {
        const long L = (long)i * G + c; if (L >= nwg) return false;
        int wgid = (int)L; { const int q = nwg / NXCD, r = nwg % NXCD, xcd = wgid % NXCD, off = wgid / NXCD; wgid = (xcd < r ? xcd * (q + 1) : r * (q + 1) + (xcd - r) * q) + off; }
        const int nig = WGM * nN, gid = wgid / nig, fm = gid * WGM, gsz = (nM - fm) < WGM ? (nM - fm) : WGM;
        u.pm = fm + ((wgid % nig) % gsz); u.pn = (wgid % nig) / gsz; return true;
    }
    __device__ __forceinline__ void a_ready(const Unit&) const {}
    __device__ __forceinline__ void done(const Unit&) const {}
};

__device__ __forceinline__ unsigned cvt_pk_bf16(float lo, float hi) { unsigned r; asm volatile("v_cvt_pk_bf16_f32 %0, %1, %2" : "=v"(r) : "v"(lo), "v"(hi)); return r; }
typedef float f32x2 __attribute__((ext_vector_type(2)));
struct EpiBf16 {
    static constexpr bool PERM = true, AFTER_DRAIN = false;
    bf16_t* O; int ldc; int split_cols; size_t split_stride; float scale0;
    __device__ __forceinline__ void operator()(const f32x4 (&acc)[2][2][4][2], const Unit& u, int wr, int wc, int fr, int fq) const {
        const int row0 = u.pm * BM + wr * 64 + fr; int colt = u.pn * BM; bf16_t* base = O;
        float sc = 1.f; if (split_cols) { const int t = colt / split_cols; base += (size_t)t * split_stride; colt -= t * split_cols; if (t == 0) sc = scale0; }
        const int col0 = colt + wc * 32 + 8 * fq;
#pragma unroll
        for (int ai = 0; ai < 2; ++ai)
#pragma unroll
            for (int m = 0; m < 4; ++m) { bf16_t* rowp = base + (size_t)(row0 + ai * HALF + m * 16) * ldc + col0;
#pragma unroll
                for (int bj = 0; bj < 2; ++bj) { f32x4 v0 = acc[ai][bj][m][0] * sc, v1 = acc[ai][bj][m][1] * sc;
                    u32x4 w; w.x = cvt_pk_bf16(v0[0], v0[1]); w.y = cvt_pk_bf16(v0[2], v0[3]); w.z = cvt_pk_bf16(v1[0], v1[1]); w.w = cvt_pk_bf16(v1[2], v1[3]);
                    *(u32x4*)(rowp + bj * HALF) = w; } }
    }
};
__device__ __forceinline__ float bf_lo(unsigned w) { return __builtin_bit_cast(float, w << 16); }
__device__ __forceinline__ float bf_hi(unsigned w) { return __builtin_bit_cast(float, w & 0xffff0000u); }
__device__ __forceinline__ float sigmoidf_(float x) { return __builtin_amdgcn_rcpf(1.0f + __builtin_amdgcn_exp2f(-1.44269504089f * x)); }
template <bool ADD> struct EpiGate {
    static constexpr bool PERM = true, AFTER_DRAIN = false;
    const bf16_t* G; size_t piece_stride; const float* bg; const bf16_t* prev; bf16_t* O; int ldc;
    __device__ __forceinline__ void operator()(const f32x4 (&acc)[2][2][4][2], const Unit& u, int wr, int wc, int fr, int fq) const {
        const int row0 = u.pm * BM + wr * 64 + fr; const int col0 = u.pn * BM + wc * 32 + 8 * fq;
        f32x4 bv[2][2];
#pragma unroll
        for (int bj = 0; bj < 2; ++bj)
#pragma unroll
            for (int n = 0; n < 2; ++n) bv[bj][n] = *(const f32x4*)(bg + col0 + bj * HALF + 4 * n);
#pragma unroll
        for (int ai = 0; ai < 2; ++ai)
#pragma unroll
            for (int m = 0; m < 4; ++m) { const int row = row0 + ai * HALF + m * 16;
#pragma unroll
                for (int bj = 0; bj < 2; ++bj) { const int col = col0 + bj * HALF;
                    const u32x4 gw = *(const u32x4*)(G + (size_t)(col >> 10) * piece_stride + (size_t)row * 1024 + (col & 1023));
                    f32x4 v0 = acc[ai][bj][m][0], v1 = acc[ai][bj][m][1];
                    v0[0] *= sigmoidf_(bf_lo(gw.x) + bv[bj][0][0]); v0[1] *= sigmoidf_(bf_hi(gw.x) + bv[bj][0][1]);
                    v0[2] *= sigmoidf_(bf_lo(gw.y) + bv[bj][0][2]); v0[3] *= sigmoidf_(bf_hi(gw.y) + bv[bj][0][3]);
                    v1[0] *= sigmoidf_(bf_lo(gw.z) + bv[bj][1][0]); v1[1] *= sigmoidf_(bf_hi(gw.z) + bv[bj][1][1]);
                    v1[2] *= sigmoidf_(bf_lo(gw.w) + bv[bj][1][2]); v1[3] *= sigmoidf_(bf_hi(gw.w) + bv[bj][1][3]);
                    if (ADD) { const u32x4 pw = *(const u32x4*)(prev + (size_t)row * ldc + col);
                        v0[0] += bf_lo(pw.x); v0[1] += bf_hi(pw.x); v0[2] += bf_lo(pw.y); v0[3] += bf_hi(pw.y);
                        v1[0] += bf_lo(pw.z); v1[1] += bf_hi(pw.z); v1[2] += bf_lo(pw.w); v1[3] += bf_hi(pw.w); }
                    u32x4 w; w.x = cvt_pk_bf16(v0[0], v0[1]); w.y = cvt_pk_bf16(v0[2], v0[3]); w.z = cvt_pk_bf16(v1[0], v1[1]); w.w = cvt_pk_bf16(v1[2], v1[3]);
                    *(u32x4*)(O + (size_t)row * ldc + col) = w; }
                asm volatile("" ::: "memory"); }
    }
};
struct EpiSsq {
    static constexpr bool PERM = true, AFTER_DRAIN = false;
    bf16_t* O; int ldc; float* ssq;
    __device__ __forceinline__ void operator()(const f32x4 (&acc)[2][2][4][2], const Unit& u, int wr, int wc, int fr, int fq) const {
        const int row0 = u.pm * BM + wr * 64 + fr; const int col0 = u.pn * BM + wc * 32 + 8 * fq;
#pragma unroll
        for (int ai = 0; ai < 2; ++ai)
#pragma unroll
            for (int m = 0; m < 4; ++m) { const int row = row0 + ai * HALF + m * 16; float ss = 0.f;
#pragma unroll
                for (int bj = 0; bj < 2; ++bj) { const f32x4 v0 = acc[ai][bj][m][0], v1 = acc[ai][bj][m][1];
                    ss += (v0[0] * v0[0] + v0[1] * v0[1]) + (v0[2] * v0[2] + v0[3] * v0[3]) + (v1[0] * v1[0] + v1[1] * v1[1]) + (v1[2] * v1[2] + v1[3] * v1[3]);
                    u32x4 w; w.x = cvt_pk_bf16(v0[0], v0[1]); w.y = cvt_pk_bf16(v0[2], v0[3]); w.z = cvt_pk_bf16(v1[0], v1[1]); w.w = cvt_pk_bf16(v1[2], v1[3]);
                    *(u32x4*)(O + (size_t)row * ldc + col0 + bj * HALF) = w; }
                ss += __shfl_xor(ss, 16); ss += __shfl_xor(ss, 32);
                if (fq == 0) ssq[(size_t)row * 32 + u.pn * 4 + wc] = ss; }
    }
};

template <class Epi, class Sched, bool ALIGN_EPI = false, bool SP2 = false>
__device__ __forceinline__ void gemm_phase(PG8_LAS unsigned char* lds, const Gemm g, const Sched& S, const Epi& E) {
    const int tid = threadIdx.x, wid = __builtin_amdgcn_readfirstlane(tid >> 6), lane = tid & 63, wr = wid >> 2, wc = wid & 3, fr = lane & 15, fq = lane >> 4;
    const int K = g.K, nt = K / BK;
    unsigned voffA[2], voffB[2];
#pragma unroll
    for (int i = 0; i < 2; ++i) { int R, C; stage_rc(tid * 16 + i * 8192, R, C); const int Rb = Epi::PERM ? ((R & ~31) + perm32(R & 31)) : R;
        voffA[i] = (unsigned)(R * K + C) * 2u; voffB[i] = (unsigned)(Rb * K + C) * 2u; }
    const size_t kstep = (size_t)(BK * 2);
    const size_t hstep = (size_t)HALF * K * 2;
    const size_t tstep = 2 * hstep;
    const unsigned ldsw = (unsigned)wid * 1024u;
    const int aoff = lds_byte(wr * 64 + fr, fq * 8), boff = lds_byte(wc * 32 + fr, fq * 8);
#define PG8_SA(b, h) (((b) * 2 + (h)) * HTB)
#define PG8_SB(b, h) ((4 + (b) * 2 + (h)) * HTB)
#define PG8_STAGE(bufoff, gbase, voff) do { _Pragma("unroll") for (int _i = 0; _i < 2; ++_i) \
        __builtin_amdgcn_global_load_lds((const unsigned*)((const char*)(gbase) + (voff)[_i]), (PG8_LAS unsigned*)(lds + (bufoff) + ldsw + _i * 8192), 16, 0, 0); } while (0)
#define PG8_LDA(dst, b, h) do { _Pragma("unroll") for (int m = 0; m < 4; ++m) _Pragma("unroll") for (int k = 0; k < 2; ++k) dst[m][k] = *(const PG8_LAS bf16x8*)(lds + PG8_SA(b, h) + aoff + m * 2048 + k * 1024); } while (0)
#define PG8_LDB(dst, b, h) do { _Pragma("unroll") for (int n = 0; n < 2; ++n) _Pragma("unroll") for (int k = 0; k < 2; ++k) dst[n][k] = *(const PG8_LAS bf16x8*)(lds + PG8_SB(b, h) + boff + n * 2048 + k * 1024); } while (0)
#define PG8_MMA(ai, bj, At, Bt) do { __builtin_amdgcn_s_setprio(1); _Pragma("unroll") for (int m = 0; m < 4; ++m) _Pragma("unroll") for (int n = 0; n < 2; ++n) _Pragma("unroll") for (int k = 0; k < 2; ++k) \
        acc[ai][bj][m][n] = __builtin_amdgcn_mfma_f32_16x16x32_bf16(Bt[n][k], At[m][k], acc[ai][bj][m][n], 0, 0, 0); __builtin_amdgcn_s_setprio(0); } while (0)
#define PG8_WAIT_V(n) asm volatile("s_waitcnt vmcnt(" #n ")" ::: "memory")
#define PG8_WAIT_L(n) asm volatile("s_waitcnt lgkmcnt(" #n ")" ::: "memory")
#define PG8_BAR __builtin_amdgcn_s_barrier()
#define PG8_SCHED __builtin_amdgcn_sched_barrier(0)
    Unit cur, nxt; int ui = 0;
    if (!S.next(0, cur)) return;
    f32x4 acc[2][2][4][2];
#pragma unroll
    for (int a = 0; a < 2; ++a)
#pragma unroll
        for (int b = 0; b < 2; ++b)
#pragma unroll
            for (int m = 0; m < 4; ++m)
#pragma unroll
                for (int n = 0; n < 2; ++n) acc[a][b][m][n] = (f32x4){0.f, 0.f, 0.f, 0.f};
    bf16x8 At[4][2], B0[2][2], B1[2][2];
    const char* cA = (const char*)g.A + (size_t)cur.pm * tstep; const char* cB = (const char*)g.Bt + (size_t)cur.pn * tstep;
    S.a_ready(cur);
    if constexpr (SP2) {
        PG8_STAGE(PG8_SB(0, 0), cB, voffB); PG8_STAGE(PG8_SB(0, 1), cB + hstep, voffB); PG8_STAGE(PG8_SA(0, 0), cA, voffA); PG8_STAGE(PG8_SA(0, 1), cA + hstep, voffA);
        if (wr == 1) PG8_BAR;
        PG8_WAIT_V(2); PG8_BAR;
        PG8_STAGE(PG8_SB(1, 0), cB + kstep, voffB); PG8_STAGE(PG8_SA(1, 0), cA + kstep, voffA); PG8_STAGE(PG8_SB(1, 1), cB + hstep + kstep, voffB);
        PG8_WAIT_V(6); PG8_BAR;
    } else {
        PG8_STAGE(PG8_SB(0, 0), cB, voffB); PG8_STAGE(PG8_SA(0, 0), cA, voffA); PG8_STAGE(PG8_SB(0, 1), cB + hstep, voffB); PG8_STAGE(PG8_SA(0, 1), cA + hstep, voffA);
        if (wr == 1) PG8_BAR;
        PG8_WAIT_V(4); PG8_BAR;
        PG8_STAGE(PG8_SB(1, 0), cB + kstep, voffB); PG8_STAGE(PG8_SA(1, 0), cA + kstep, voffA); PG8_STAGE(PG8_SB(1, 1), cB + hstep + kstep, voffB);
        PG8_WAIT_V(6); PG8_BAR;
    }
    for (;;) {
        const bool has_next = S.next(ui + 1, nxt);
        const char* nA = has_next ? (const char*)g.A + (size_t)nxt.pm * tstep : cA; const char* nB = has_next ? (const char*)g.Bt + (size_t)nxt.pn * tstep : cB;
        for (int t = 0; t < nt; t += 2) {
            const bool last = (t == nt - 2);
            const char* a1 = cA + (size_t)(t + 1) * kstep;
            const char* a2 = last ? nA : cA + (size_t)(t + 2) * kstep; const char* b2 = last ? nB : cB + (size_t)(t + 2) * kstep;
            const char* a3 = a2 + kstep; const char* b3 = b2 + kstep;
            if (last && has_next) S.a_ready(nxt);
            if constexpr (SP2) {
            PG8_LDB(B0, 0, 0); PG8_LDB(B1, 0, 1); PG8_SCHED; PG8_LDA(At, 0, 0); PG8_STAGE(PG8_SA(1, 1), a1 + hstep, voffA);
            PG8_WAIT_V(8); PG8_WAIT_L(0); PG8_BAR; PG8_MMA(0, 0, At, B0); PG8_MMA(0, 1, At, B1); PG8_BAR; PG8_SCHED;
            PG8_LDA(At, 0, 1); PG8_STAGE(PG8_SB(0, 0), b2, voffB); PG8_STAGE(PG8_SB(0, 1), b2 + hstep, voffB); PG8_STAGE(PG8_SA(0, 0), a2, voffA);
            PG8_WAIT_V(8); PG8_WAIT_L(0); PG8_BAR; PG8_MMA(1, 0, At, B0); PG8_MMA(1, 1, At, B1); PG8_BAR; PG8_SCHED;
            PG8_LDB(B0, 1, 0); PG8_LDB(B1, 1, 1); PG8_SCHED; PG8_LDA(At, 1, 0); PG8_STAGE(PG8_SA(0, 1), a2 + hstep, voffA);
            PG8_WAIT_V(8); PG8_WAIT_L(0); PG8_BAR; PG8_MMA(0, 0, At, B0); PG8_MMA(0, 1, At, B1); PG8_BAR; PG8_SCHED;
            PG8_LDA(At, 1, 1); PG8_STAGE(PG8_SB(1, 0), b3, voffB); PG8_STAGE(PG8_SB(1, 1), b3 + hstep, voffB); PG8_STAGE(PG8_SA(1, 0), a3, voffA);
            PG8_WAIT_V(8); PG8_WAIT_L(0); PG8_BAR; PG8_MMA(1, 0, At, B0); PG8_MMA(1, 1, At, B1); PG8_BAR; PG8_SCHED;
            } else {
            PG8_LDB(B0, 0, 0); PG8_SCHED; PG8_LDA(At, 0, 0); PG8_STAGE(PG8_SA(1, 1), a1 + hstep, voffA);
            PG8_WAIT_L(8); PG8_BAR; PG8_WAIT_L(0); PG8_MMA(0, 0, At, B0); PG8_BAR; PG8_SCHED;
            PG8_LDB(B1, 0, 1); PG8_STAGE(PG8_SB(0, 0), b2, voffB);
            PG8_BAR; PG8_WAIT_L(0); PG8_MMA(0, 1, At, B1); PG8_BAR;
            PG8_LDA(At, 0, 1); PG8_STAGE(PG8_SA(0, 0), a2, voffA);
            PG8_BAR; PG8_WAIT_L(0); PG8_MMA(1, 0, At, B0); PG8_BAR; PG8_SCHED;
            PG8_STAGE(PG8_SB(0, 1), b2 + hstep, voffB);
            PG8_WAIT_V(6); PG8_BAR; PG8_MMA(1, 1, At, B1); PG8_BAR;
            PG8_LDB(B0, 1, 0); PG8_SCHED; PG8_LDA(At, 1, 0); PG8_STAGE(PG8_SA(0, 1), a2 + hstep, voffA);
            PG8_WAIT_L(8); PG8_BAR; PG8_WAIT_L(0); PG8_MMA(0, 0, At, B0); PG8_BAR; PG8_SCHED;
            PG8_LDB(B1, 1, 1); PG8_STAGE(PG8_SB(1, 0), b3, voffB);
            PG8_BAR; PG8_WAIT_L(0); PG8_MMA(0, 1, At, B1); PG8_BAR;
            PG8_LDA(At, 1, 1); PG8_STAGE(PG8_SA(1, 0), a3, voffA);
            PG8_BAR; PG8_WAIT_L(0); PG8_MMA(1, 0, At, B0); PG8_BAR; PG8_SCHED;
            PG8_STAGE(PG8_SB(1, 1), b3 + hstep, voffB);
            PG8_WAIT_V(6); PG8_BAR; PG8_MMA(1, 1, At, B1); PG8_BAR;
            }
        }
        if constexpr (ALIGN_EPI) { if (wr == 0) PG8_BAR; }
        if constexpr (!Epi::AFTER_DRAIN) { E(acc, cur, wr, wc, fr, fq); S.done(cur); }
        if (!has_next) break;
#pragma unroll
        for (int a = 0; a < 2; ++a)
#pragma unroll
            for (int b = 0; b < 2; ++b)
#pragma unroll
                for (int m = 0; m < 4; ++m)
#pragma unroll
                    for (int n = 0; n < 2; ++n) acc[a][b][m][n] = (f32x4){0.f, 0.f, 0.f, 0.f};
        cur = nxt; cA = nA; cB = nB; ++ui;
        if constexpr (ALIGN_EPI) { if (wr == 1) PG8_BAR; }
    }
    PG8_WAIT_V(0);
    if constexpr (!ALIGN_EPI) { if (wr == 0) PG8_BAR; }
    PG8_BAR;
    if constexpr (Epi::AFTER_DRAIN) { E.fused(acc, cur, wr, wc, fr, fq, lds, wid, lane); S.done(cur); }
#undef PG8_SA
#undef PG8_SB
#undef PG8_STAGE
#undef PG8_LDA
#undef PG8_LDB
#undef PG8_MMA
#undef PG8_WAIT_V
#undef PG8_WAIT_L
#undef PG8_BAR
#undef PG8_SCHED
}
}
constexpr int NWAVES = 8;
constexpr int M = 16384, D = 2048, INC = 13312, PW = 1024, NPIECE = 13;
constexpr int GW = 64, GROWS = 256;
constexpr int NAH = 16, NADH = 64, HGH = 8, HGD = 128;
constexpr float EPS = 1e-6f;
enum { P_NQ = 0, P_NK = 1, P_NV = 2, P_NZ = 3, P_HQ = 4, P_HFF = 5, P_HFB = 6, P_HI = 7, P_HZ = 8, P_GA = 9, P_GB = 11 };
constexpr size_t MiB = 1u << 20;
constexpr size_t WS_CTL = 0, CTL_ZERO_BYTES = 1 * MiB;
constexpr size_t WS_SSQ = 2 * MiB;
constexpr size_t WS_WIN = 4 * MiB;
constexpr size_t WS_WBA = 56 * MiB, WS_WBB = 60 * MiB;
constexpr size_t WS_WOUT = 64 * MiB;
constexpr size_t WS_H = 72 * MiB;
constexpr size_t PIECE_BYTES = (size_t)M * PW * 2, PIECE_ELEMS = (size_t)M * PW;
constexpr size_t WS_END = WS_H + NPIECE * PIECE_BYTES;
static_assert(WS_WIN + (size_t)INC * D * 2 <= WS_WBA && WS_WOUT + (size_t)D * D * 2 <= WS_H, "ws map");
constexpr int CW_BAR = 4096;
constexpr int RING_OFF = 0, RING_BYTES = 131072;
constexpr int LDSCTL_OFF = RING_BYTES, MISC_OFF = LDSCTL_OFF + 320;
constexpr int LDS_BYTES = 147456;
#define GAS __attribute__((address_space(1)))
#define LAS __attribute__((address_space(3)))
typedef unsigned short bf16;
typedef unsigned v4u __attribute__((ext_vector_type(4)));
typedef float f32x4 __attribute__((ext_vector_type(4)));
typedef short bf16x8 __attribute__((ext_vector_type(8)));
typedef GAS unsigned gu32;
typedef GAS unsigned long long gu64;
#define RLX_AGENT __ATOMIC_RELAXED, __HIP_MEMORY_SCOPE_AGENT
#define LDS_WAIT() asm volatile("s_waitcnt lgkmcnt(0)" ::: "memory")
#define VM_WAIT() asm volatile("s_waitcnt vmcnt(0)" ::: "memory")
__device__ __forceinline__ unsigned long long rt() { return __builtin_amdgcn_s_memrealtime(); }
__device__ __forceinline__ unsigned f2bf(float f) { unsigned u = __builtin_bit_cast(unsigned, f); return (u + 0x7fffu + ((u >> 16) & 1u)) >> 16; }
__device__ __forceinline__ unsigned pk2(float lo, float hi) { return f2bf(lo) | (f2bf(hi) << 16); }

#define XB_TMO      128
#define XB_XCNT(j)  (256  + 64 * (j))
#define XB_XSUB(j)  (1280 + 64 * (j))
#define XB_XGEN(j)  (2304 + 64 * (j))
#define XB_TOP      3328
#define XB_TOPGEN   3392
#define XCD_BAR_WORDS 3456
#define XB_SPIN_CAP (1u << 18)

__device__ __forceinline__ unsigned xb_ld(unsigned* p)              { return __hip_atomic_load(p, __ATOMIC_RELAXED, __HIP_MEMORY_SCOPE_AGENT); }
__device__ __forceinline__ unsigned xb_add(unsigned* p, unsigned v) { return __hip_atomic_fetch_add(p, v, __ATOMIC_RELAXED, __HIP_MEMORY_SCOPE_AGENT); }
__device__ __forceinline__ unsigned xb_xcc_id() { return (unsigned)__builtin_amdgcn_s_getreg((3 << 11) | 20) & 0xFu; }
#define XB_SPIN(cond, bar) do { unsigned _sp = 0; while (cond) { __builtin_amdgcn_s_sleep(1); \
    if ((++_sp & 255u) == 0u) { if (xb_ld(&(bar)[XB_TMO])) break; if (_sp > XB_SPIN_CAP) { atomicAdd(&(bar)[XB_TMO], 1u); break; } } } } while (0)

struct XcdBarrier {
    unsigned* bar; unsigned x;
    volatile LAS unsigned* st;
};

__device__ __forceinline__ XcdBarrier xcd_barrier_post(unsigned* bar, volatile LAS unsigned* st) {
    XcdBarrier b; b.bar = bar; b.x = xb_xcc_id(); b.st = st;
    if (threadIdx.x == 0) (void)xb_add(&bar[XB_XCNT(b.x)], 1u);
    return b;
}
__device__ __forceinline__ void xcd_barrier_complete(unsigned* bar, unsigned x, unsigned& nloc, unsigned& nx) {
    const unsigned G = gridDim.x * gridDim.y * gridDim.z;
    unsigned sum, cnt, mine, sp = 0u;
    for (;;) {
        sum = 0u; cnt = 0u; mine = 0u;
#pragma unroll
        for (unsigned j = 0; j < 16; ++j) { const unsigned c = xb_ld(&bar[XB_XCNT(j)]); sum += c; cnt += (c > 0u) ? 1u : 0u; mine = (j == x) ? c : mine; }
        if (sum == G) break;
        __builtin_amdgcn_s_sleep(1);
        if ((++sp & 255u) == 0u) { if (xb_ld(&bar[XB_TMO])) break; if (sp > XB_SPIN_CAP) { atomicAdd(&bar[XB_TMO], 1u); break; } }
    }
    nloc = mine > 0u ? mine : 1u; nx = cnt > 0u ? cnt : 1u;
}

__device__ __forceinline__ void xcd_barrier(const XcdBarrier& b) {
    asm volatile("s_waitcnt vmcnt(0)" ::: "memory");
    __syncthreads();
    if (threadIdx.x == 0) {
        unsigned* bar = b.bar;
        __builtin_amdgcn_s_waitcnt(0);
        unsigned nloc = b.st[0], nx = b.st[1];
        if (nloc == 0u) { xcd_barrier_complete(bar, b.x, nloc, nx); b.st[0] = nloc; b.st[1] = nx; }
        const unsigned old = xb_add(&bar[XB_XSUB(b.x)], 1u);
        const unsigned gen = old / nloc;
        if (old + 1u == (gen + 1u) * nloc) {
            __builtin_amdgcn_fence(__ATOMIC_RELEASE, "agent");
            asm volatile("s_waitcnt vmcnt(0)" ::: "memory");
            const unsigned og = xb_add(&bar[XB_TOP], 1u);
            const unsigned tg = og / nx;
            if (og + 1u == (tg + 1u) * nx) xb_add(&bar[XB_TOPGEN], 1u);
            else XB_SPIN(xb_ld(&bar[XB_TOPGEN]) == tg, bar);
            __builtin_amdgcn_fence(__ATOMIC_ACQUIRE, "agent");
            xb_add(&bar[XB_XGEN(b.x)], 1u);
            asm volatile("s_waitcnt vmcnt(0)" ::: "memory");
        } else {
            XB_SPIN(xb_ld(&bar[XB_XGEN(b.x)]) == gen, bar);
            __builtin_amdgcn_fence(__ATOMIC_ACQUIRE, "agent");
            asm volatile("s_waitcnt vmcnt(0)" ::: "memory");
        }
    }
    __syncthreads();
}
__device__ __forceinline__ float wave_sum(float v) {
#pragma unroll
    for (int o = 1; o < 64; o <<= 1) v += __shfl_xor(v, o);
    return v;
}
__device__ __forceinline__ void p0_transpose_item(const float* W, int K, int N, bf16* WT, int row_off, LAS float* scr, int item, int lane) {
    const int nblk = N / 32, kb = item / nblk, nb = item % nblk, k0 = 64 * kb, n0 = 32 * nb;
#pragma unroll 8
    for (int i = 0; i < 32; ++i) { const int kk = 2 * i + (lane >> 5); scr[kk * 33 + (lane & 31)] = W[(size_t)(k0 + kk) * N + n0 + (lane & 31)]; }
    LDS_WAIT(); asm volatile("" ::: "memory");
    const int c = lane & 7;
#pragma unroll
    for (int j = 0; j < 4; ++j) { const int n = (lane >> 3) + 8 * j; const LAS float* s = scr + (8 * c) * 33 + n;
        v4u o; o.x = pk2(s[0 * 33], s[1 * 33]); o.y = pk2(s[2 * 33], s[3 * 33]); o.z = pk2(s[4 * 33], s[5 * 33]); o.w = pk2(s[6 * 33], s[7 * 33]);
        *(GAS v4u*)(WT + (size_t)(row_off + n0 + n) * K + k0 + 8 * c) = o; }
    LDS_WAIT(); asm volatile("" ::: "memory");
}
struct Frame {
    LAS unsigned char* lds;
    volatile LAS unsigned* MISC;
    gu32* ctl;
    int tid, lane, wave;
    int vcu, G;
};
__device__ __forceinline__ float bf2f(bf16 b) { return __builtin_bit_cast(float, (unsigned)b << 16); }
__device__ __forceinline__ float wave_max(float v) {
#pragma unroll
    for (int o = 1; o < 64; o <<= 1) v = fmaxf(v, __shfl_xor(v, o));
    return v;
}
__device__ __forceinline__ float sigm(float x) { return 1.0f / (1.0f + __expf(-x)); }

__device__ __forceinline__ void p0_prologue(Frame& F, const float* x, const float* w_pre, const float* w_in, const float* w_br, const float* w_out,
                                            bf16* XN, bf16* WIN_T, bf16* WBA_T, bf16* WBB_T, bf16* WOUT_T) {
    LAS float* scr = (LAS float*)(F.lds + RING_OFF + F.wave * 16384);
    const int gw = F.vcu * NWAVES + F.wave, NGW = F.G * NWAVES;
    constexpr int I_IN = (D / 64) * (INC / 32), I_BR = (PW / 64) * (D / 32), I_OUT = (D / 64) * (D / 32);
    constexpr int NITEMS = I_IN + 2 * I_BR + I_OUT;
    for (int it = gw; it < NITEMS; it += NGW) {
        int r = it;
        if (r < I_IN) { p0_transpose_item(w_in, D, INC, WIN_T, 0, scr, r, F.lane); continue; } r -= I_IN;
        if (r < I_BR) { p0_transpose_item(w_br, PW, D, WBA_T, 0, scr, r, F.lane); continue; } r -= I_BR;
        if (r < I_BR) { p0_transpose_item(w_br + (size_t)PW * D, PW, D, WBB_T, 0, scr, r, F.lane); continue; } r -= I_BR;
        p0_transpose_item(w_out, D, D, WOUT_T, 0, scr, r, F.lane);
    }
    for (int m = gw; m < M; m += NGW) {
        const f32x4* xr = (const f32x4*)(x + (size_t)m * D) + F.lane;
        f32x4 v[8]; float s = 0.f;
#pragma unroll
        for (int j = 0; j < 8; ++j) { v[j] = xr[64 * j]; s += (v[j].x * v[j].x + v[j].y * v[j].y) + (v[j].z * v[j].z + v[j].w * v[j].w); }
        const float rstd = 1.0f / sqrtf(wave_sum(s) * (1.f / D) + EPS);
        unsigned long long* o8 = (unsigned long long*)(XN + (size_t)m * D) + F.lane;
#pragma unroll
        for (int j = 0; j < 8; ++j) { const f32x4 w = *((const f32x4*)w_pre + F.lane + 64 * j);
            o8[64 * j] = (unsigned long long)pk2(v[j].x * rstd * w.x, v[j].y * rstd * w.y) | ((unsigned long long)pk2(v[j].z * rstd * w.z, v[j].w * rstd * w.w) << 32); }
    }
}

__device__ __forceinline__ void na_naive(Frame& F, bf16* Q, const bf16* K, const bf16* V, const bf16* Z, const float* rpb) {
    const int gw = F.vcu * NWAVES + F.wave, NGW = F.G * NWAVES, lane = F.lane;
    for (int it = gw; it < M * NAH; it += NGW) {
        const int h = it & 15, tq = it >> 4, r = tq >> 6, c = tq & 63;
        int rs = r - 4; rs = rs < 0 ? 0 : (rs > GROWS - 8 ? GROWS - 8 : rs);
        int cs = c - 8; cs = cs < 0 ? 0 : (cs > GW - 16 ? GW - 16 : cs);
        const v4u* qp = (const v4u*)(Q + (size_t)tq * PW + h * NADH);
        v4u qv[8];
#pragma unroll
        for (int i = 0; i < 8; ++i) qv[i] = qp[i];
        float sc[2];
#pragma unroll
        for (int e = 0; e < 2; ++e) {
            const int j = lane + 64 * e, kr = rs + (j >> 4), kc = cs + (j & 15), tk = kr * GW + kc;
            const v4u* kp = (const v4u*)(K + (size_t)tk * PW + h * NADH);
            float a = 0.f;
#pragma unroll
            for (int i = 0; i < 8; ++i) { const v4u kv = kp[i];
                a += pg8::bf_lo(qv[i].x) * pg8::bf_lo(kv.x) + pg8::bf_hi(qv[i].x) * pg8::bf_hi(kv.x) + pg8::bf_lo(qv[i].y) * pg8::bf_lo(kv.y) + pg8::bf_hi(qv[i].y) * pg8::bf_hi(kv.y)
                   + pg8::bf_lo(qv[i].z) * pg8::bf_lo(kv.z) + pg8::bf_hi(qv[i].z) * pg8::bf_hi(kv.z) + pg8::bf_lo(qv[i].w) * pg8::bf_lo(kv.w) + pg8::bf_hi(qv[i].w) * pg8::bf_hi(kv.w); }
            sc[e] = a * 0.125f + rpb[(h * 15 + (kr - r + 7)) * 31 + (kc - c + 15)];
        }
        const float mx = wave_max(fmaxf(sc[0], sc[1]));
        const float e0 = __expf(sc[0] - mx), e1 = __expf(sc[1] - mx);
        const float inv = 1.0f / wave_sum(e0 + e1);
        const float p0 = e0 * inv, p1 = e1 * inv;
        float o = 0.f;
        for (int j = 0; j < 64; ++j) {
            const int kr = rs + (j >> 4), kc = cs + (j & 15), tk = kr * GW + kc;
            const float pa = __shfl(p0, j), pb = __shfl(p1, j);
            o += pa * bf2f(V[(size_t)tk * PW + h * NADH + lane]);
            o += pb * bf2f(V[(size_t)(tk + 4 * GW) * PW + h * NADH + lane]);
        }
        const float z = bf2f(Z[(size_t)tq * PW + h * NADH + lane]);
        o *= z * sigm(z);
        Q[(size_t)tq * PW + h * NADH + lane] = (bf16)f2bf(o);
    }
}

__device__ __forceinline__ void hg_naive(Frame& F, const bf16* HQ, const bf16* HFF, const bf16* HFB, const bf16* HI, const float* lb_logits, float* OFWD, float* OBWD) {
    LAS float* red = (LAS float*)(F.lds + RING_OFF);
    for (int u = blockIdx.x; u < 256; u += F.G) {
        const int hd = u >> 4, head = hd >> 1, dir = hd & 1, dv0 = (u & 15) * 8;
        const int dk = F.tid & 127, part = F.tid >> 7;
        const int ch = head * HGD + dk;
        const float lbv = sigm(lb_logits[dir * 1024 + ch] - lb_logits[2048 + dir * 1024 + ch]);
        const bf16* FL = dir ? HFB : HFF; float* OUT = dir ? OBWD : OFWD;
        const int cv = head * HGD + dv0 + part * 2;
        float S0 = 0.f, S1 = 0.f;
        for (int cb = 0; cb < M / 64; ++cb) {
            LAS float* rb = red + (cb & 1) * 1024;
#pragma unroll 8
            for (int s = 0; s < 64; ++s) {
                const int step = cb * 64 + s, t = dir ? (M - 1 - step) : step;
                const float fl = bf2f(FL[(size_t)t * PW + ch]), q = bf2f(HQ[(size_t)t * PW + ch]);
                const unsigned vv = *(const unsigned*)(HI + (size_t)t * PW + cv);
                const float v0 = pg8::bf_lo(vv), v1 = pg8::bf_hi(vv);
                const float sg = sigm(fl), f = lbv + (1.f - lbv) * sg, k = (1.f - lbv) * (1.f - sg);
                S0 = f * S0 + k * v0; S1 = f * S1 + k * v1;
                const float p0 = wave_sum(S0 * q), p1 = wave_sum(S1 * q);
                if (F.lane == 0) { rb[(s * 8 + F.wave) * 2] = p0; rb[(s * 8 + F.wave) * 2 + 1] = p1; }
            }
            __syncthreads();
            { const int s = F.tid >> 3, j = F.tid & 7, pp = j >> 1, e = j & 1;
              const int step = cb * 64 + s, t = dir ? (M - 1 - step) : step;
              OUT[(size_t)t * PW + head * HGD + dv0 + j] = rb[(s * 8 + 2 * pp) * 2 + e] + rb[(s * 8 + 2 * pp + 1) * 2 + e]; }
        }
        __syncthreads();
    }
}
__device__ __forceinline__ void hg_finish(Frame& F, const float* OFWD, const float* OBWD, const bf16* HZ, const float* w, bf16* OB) {
    const int gw = F.vcu * NWAVES + F.wave, NGW = F.G * NWAVES, lane = F.lane;
    for (int m = gw; m < M; m += NGW) {
        const f32x4* a = (const f32x4*)(OFWD + (size_t)m * PW) + lane * 4; const f32x4* b = (const f32x4*)(OBWD + (size_t)m * PW) + lane * 4;
        f32x4 o[4]; float ss = 0.f;
#pragma unroll
        for (int i = 0; i < 4; ++i) { o[i] = a[i] + b[i]; ss += (o[i].x * o[i].x + o[i].y * o[i].y) + (o[i].z * o[i].z + o[i].w * o[i].w); }
        ss += __shfl_xor(ss, 1); ss += __shfl_xor(ss, 2); ss += __shfl_xor(ss, 4);
        const float rstd = 1.0f / sqrtf(ss * (1.f / HGD) + EPS);
        const v4u* zp = (const v4u*)(HZ + (size_t)m * PW) + lane * 2; v4u* op = (v4u*)(OB + (size_t)m * PW) + lane * 2;
#pragma unroll
        for (int hh = 0; hh < 2; ++hh) { const v4u zz = zp[hh]; const f32x4 w0 = *((const f32x4*)w + lane * 4 + hh * 2), w1 = *((const f32x4*)w + lane * 4 + hh * 2 + 1);
            const f32x4 o0 = o[hh * 2], o1 = o[hh * 2 + 1];
            float zf[8] = {pg8::bf_lo(zz.x), pg8::bf_hi(zz.x), pg8::bf_lo(zz.y), pg8::bf_hi(zz.y), pg8::bf_lo(zz.z), pg8::bf_hi(zz.z), pg8::bf_lo(zz.w), pg8::bf_hi(zz.w)};
            float r[8] = {o0.x * w0.x, o0.y * w0.y, o0.z * w0.z, o0.w * w0.w, o1.x * w1.x, o1.y * w1.y, o1.z * w1.z, o1.w * w1.w};
#pragma unroll
            for (int i = 0; i < 8; ++i) r[i] = r[i] * rstd * zf[i] * sigm(zf[i]);
            v4u ow; ow.x = pk2(r[0], r[1]); ow.y = pk2(r[2], r[3]); ow.z = pk2(r[4], r[5]); ow.w = pk2(r[6], r[7]); op[hh] = ow; }
    }
}
__device__ __forceinline__ void final_phase(Frame& F, const float* x, const bf16* Zb, const float* ssq, const float* w, float* out) {
    const int gw = F.vcu * NWAVES + F.wave, NGW = F.G * NWAVES, lane = F.lane;
    for (int m = gw; m < M; m += NGW) {
        const float part = lane < 32 ? ssq[(size_t)m * 32 + lane] : 0.f;
        const float rstd = 1.0f / sqrtf(wave_sum(part) * (1.f / D) + EPS);
        const f32x4* xr = (const f32x4*)(x + (size_t)m * D) + lane; f32x4* orow = (f32x4*)(out + (size_t)m * D) + lane;
        const unsigned long long* zr = (const unsigned long long*)(Zb + (size_t)m * D) + lane;
#pragma unroll
        for (int j = 0; j < 8; ++j) { const f32x4 xv = xr[64 * j]; const unsigned long long zz = zr[64 * j]; const f32x4 wv = *((const f32x4*)w + lane + 64 * j);
            const unsigned lo = (unsigned)zz, hi = (unsigned)(zz >> 32);
            f32x4 o; o.x = xv.x + pg8::bf_lo(lo) * rstd * wv.x; o.y = xv.y + pg8::bf_hi(lo) * rstd * wv.y; o.z = xv.z + pg8::bf_lo(hi) * rstd * wv.z; o.w = xv.w + pg8::bf_hi(hi) * rstd * wv.w;
            orow[64 * j] = o; }
    }
}
struct Args { const float* in[10]; float* out; unsigned char* ws; int ph_lo, ph_hi, li, pad; };
constexpr int N_PHASES = 7;
__global__ void __launch_bounds__(NWAVES * 64, 2) fwd_kernel(Args args) {
    extern __shared__ __attribute__((aligned(16))) unsigned char lds[];
    Frame F;
    F.lds = (LAS unsigned char*)lds;
    F.MISC = (volatile LAS unsigned*)(F.lds + MISC_OFF);
    F.tid = threadIdx.x; F.lane = F.tid & 63; F.wave = __builtin_amdgcn_readfirstlane(F.tid >> 6);
    F.G = gridDim.x; { const int bx = blockIdx.x; F.vcu = (F.G % 8 == 0) ? (bx % 8) * (F.G / 8) + bx / 8 : bx; }
    unsigned char* ws = args.ws;
    F.ctl = (gu32*)(ws + WS_CTL);
    const float* x = args.in[0]; const float* w_pre = args.in[1]; const float* w_in = args.in[2]; const float* b_gate = args.in[3]; const float* rpb = args.in[4];
    const float* lb_logits = args.in[5]; const float* hg_norm_w = args.in[6]; const float* w_br = args.in[7]; const float* w_out = args.in[8]; const float* w_post = args.in[9];
    bf16* WIN_T = (bf16*)(ws + WS_WIN); bf16* WBA_T = (bf16*)(ws + WS_WBA); bf16* WBB_T = (bf16*)(ws + WS_WBB); bf16* WOUT_T = (bf16*)(ws + WS_WOUT);
    bf16* H = (bf16*)(ws + WS_H);
    float* SSQ = (float*)(ws + WS_SSQ);
    bf16* XN = (bf16*)args.out;
    float* OFWD = args.out; float* OBWD = args.out + (size_t)M * PW;
    bf16* OA = H + P_NQ * PIECE_ELEMS; bf16* OB = H + P_HQ * PIECE_ELEMS; bf16* YA = H + P_NK * PIECE_ELEMS; bf16* Y = H + P_HFF * PIECE_ELEMS; bf16* Zb = H + P_HI * PIECE_ELEMS;
    for (int u = F.tid; u < (LDS_BYTES - LDSCTL_OFF) / 4; u += NWAVES * 64) ((LAS unsigned*)(F.lds + LDSCTL_OFF))[u] = 0u;
    __syncthreads();
    XcdBarrier bar = xcd_barrier_post((unsigned*)(F.ctl + CW_BAR) + args.li * XCD_BAR_WORDS, F.MISC + 8);
    const int lo = args.ph_lo, hi = args.ph_hi;
#define IN(k) (lo <= (k) && (k) < hi)
#define BOTH(k) (IN(k) && IN((k) + 1))
#define GRID_BAR() xcd_barrier(bar)

    if (IN(0)) { p0_prologue(F, x, w_pre, w_in, w_br, w_out, XN, WIN_T, WBA_T, WBB_T, WOUT_T); if (BOTH(0)) GRID_BAR(); }
    if (IN(1)) {
        pg8::Gemm g{XN, WIN_T, M, INC, D}; pg8::StaticOrder S; S.init(M, INC, F.G, (int)blockIdx.x);
        pg8::EpiBf16 E{H, PW, PW, PIECE_ELEMS, 1.0f};
        pg8::gemm_phase<pg8::EpiBf16, pg8::StaticOrder, true, true>(F.lds + RING_OFF, g, S, E);
        if (BOTH(1)) GRID_BAR();
    }
    if (IN(2)) {
        hg_naive(F, H + P_HQ * PIECE_ELEMS, H + P_HFF * PIECE_ELEMS, H + P_HFB * PIECE_ELEMS, H + P_HI * PIECE_ELEMS, lb_logits, OFWD, OBWD);
        na_naive(F, H + P_NQ * PIECE_ELEMS, H + P_NK * PIECE_ELEMS, H + P_NV * PIECE_ELEMS, H + P_NZ * PIECE_ELEMS, rpb);
        if (BOTH(2)) GRID_BAR();
    }
    if (IN(3)) { hg_finish(F, OFWD, OBWD, H + P_HZ * PIECE_ELEMS, hg_norm_w, OB); if (BOTH(3)) GRID_BAR(); }
    if (IN(4)) {
        { pg8::Gemm g{OA, WBA_T, M, D, PW}; pg8::StaticOrder S; S.init(M, D, F.G, (int)blockIdx.x);
          pg8::EpiGate<false> E{H + P_GA * PIECE_ELEMS, PIECE_ELEMS, b_gate, nullptr, YA, D};
          pg8::gemm_phase<pg8::EpiGate<false>, pg8::StaticOrder, true, true>(F.lds + RING_OFF, g, S, E); }
        { pg8::Gemm g{OB, WBB_T, M, D, PW}; pg8::StaticOrder S; S.init(M, D, F.G, (int)blockIdx.x);
          pg8::EpiGate<true> E{H + P_GB * PIECE_ELEMS, PIECE_ELEMS, b_gate + D, YA, Y, D};
          pg8::gemm_phase<pg8::EpiGate<true>, pg8::StaticOrder, true, true>(F.lds + RING_OFF, g, S, E); }
        if (BOTH(4)) GRID_BAR();
    }
    if (IN(5)) {
        pg8::Gemm g{Y, WOUT_T, M, D, D}; pg8::StaticOrder S; S.init(M, D, F.G, (int)blockIdx.x);
        pg8::EpiSsq E{Zb, D, SSQ};
        pg8::gemm_phase<pg8::EpiSsq, pg8::StaticOrder, true, true>(F.lds + RING_OFF, g, S, E);
        if (BOTH(5)) GRID_BAR();
    }
    if (IN(6)) { final_phase(F, x, Zb, SSQ, w_post, args.out); }
#undef IN
#undef BOTH
}

#ifndef MK_N_LAUNCHES
#define MK_N_LAUNCHES 1
#endif
extern "C" void kernel_launch(void* const* d_in, const int* in_sizes, int n_in, void* d_out, int out_size, void* d_ws, size_t ws_size, hipStream_t stream) {
    static int grid = 0;
    if (grid == 0) {
        if (n_in != 10 || in_sizes[0] != M * D || out_size != M * D || ws_size < WS_END) { fprintf(stderr, "kernel_launch: unexpected shapes: n_in %d in0 %d out %d ws %zu (need %zu)\n", n_in, n_in > 0 ? in_sizes[0] : -1, out_size, ws_size, (size_t)WS_END); grid = -1; return; }
        int dev = 0, cus = 0, per_cu = 0;
        if (hipGetDevice(&dev) != hipSuccess || hipDeviceGetAttribute(&cus, hipDeviceAttributeMultiprocessorCount, dev) != hipSuccess) { fprintf(stderr, "kernel_launch: device query failed\n"); grid = -1; return; }
        if (hipFuncSetAttribute((const void*)fwd_kernel, hipFuncAttributeMaxDynamicSharedMemorySize, LDS_BYTES) != hipSuccess) { fprintf(stderr, "kernel_launch: hipFuncSetAttribute failed\n"); grid = -1; return; }
        if (hipOccupancyMaxActiveBlocksPerMultiprocessor(&per_cu, (const void*)fwd_kernel, NWAVES * 64, LDS_BYTES) != hipSuccess || per_cu < 1) { fprintf(stderr, "kernel_launch: occupancy query reports %d blocks/CU; nothing launched\n", per_cu); (void)hipGetLastError(); grid = -1; return; }
        grid = cus;
    }
    if (grid < 0) return;
    if (hipMemsetAsync((char*)d_ws + WS_CTL, 0, CTL_ZERO_BYTES, stream) != hipSuccess) { fprintf(stderr, "kernel_launch: memset failed\n"); return; }
    Args a{};
    for (int i = 0; i < 10; ++i) a.in[i] = (const float*)d_in[i];
    a.out = (float*)d_out; a.ws = (unsigned char*)d_ws;
#if MK_N_LAUNCHES == 1
    a.ph_lo = 0; a.ph_hi = N_PHASES; a.li = 0;
    hipLaunchKernelGGL(fwd_kernel, dim3(grid), dim3(NWAVES * 64), LDS_BYTES, stream, a);
#else
    for (int li = 0; li < N_PHASES; ++li) { a.ph_lo = li; a.ph_hi = li + 1; a.li = li;
        hipLaunchKernelGGL(fwd_kernel, dim3(grid), dim3(NWAVES * 64), LDS_BYTES, stream, a); }
#endif
    const hipError_t le = hipPeekAtLastError();
    if (le != hipSuccess) fprintf(stderr, "kernel_launch: launch failed: %s\n", hipGetErrorName(le));
}
```

```cpp
#include <hip/hip_runtime.h>
#include <cstdio>
#include <cstdint>
namespace pg8 {
#define PG8_LAS __attribute__((address_space(3)))
typedef unsigned short bf16_t;
typedef short bf16x8 __attribute__((ext_vector_type(8)));
typedef float f32x4 __attribute__((ext_vector_type(4)));
typedef unsigned u32x4 __attribute__((ext_vector_type(4)));
constexpr int BM = 256, BK = 64, HALF = 128, HTB = HALF * BK * 2  , STAGE_BYTES = 8 * HTB, NXCD = 8, WGM = 8;

__host__ __device__ __forceinline__ int lds_byte(int r, int c) { const int st = (r >> 4) * 2 + (c >> 5), rr = r & 15, cc = c & 31, ob = rr * 64 + cc * 2; return st * 1024 + (ob ^ (((ob >> 9) & 1) << 5)); }
__host__ __device__ __forceinline__ void stage_rc(int b, int& R, int& C) { const int st = b / 1024, sb = b % 1024, swz = sb ^ (((sb >> 9) & 1) << 5); R = (st >> 1) * 16 + swz / 64; C = (st & 1) * 32 + (swz % 64) / 2; }
__host__ __device__ __forceinline__ int perm32(int rho) { const int n = rho >> 4, i = rho & 15; return 8 * (i >> 2) + 4 * n + (i & 3); }

struct Unit { int pm, pn; };
struct Gemm { const bf16_t* A; const bf16_t* Bt; int M, N, K; };

struct StaticOrder {
    int nM, nN, nwg, G, c;
    __host__ __device__ void init(int M, int N, int G_, int c_) { nM = M / BM; nN = N / BM; nwg = nM * nN; G = G_; c = c_; }
    __host__ __device__ bool next(int i, Unit& u) const {
        const long L = (long)i * G + c; if (L >= nwg) return false;
        int wgid = (int)L; { const int q = nwg / NXCD, r = nwg % NXCD, xcd = wgid % NXCD, off = wgid / NXCD; wgid = (xcd < r ? xcd * (q + 1) : r * (q + 1) + (xcd - r) * q) + off; }
        const int nig = WGM * nN, gid = wgid / nig, fm = gid * WGM, gsz = (nM - fm) < WGM ? (nM - fm) : WGM;
        u.pm = fm + ((wgid % nig) % gsz); u.pn = (wgid % nig) / gsz; return true;
    }
    __device__ __forceinline__ void a_ready(const Unit&) const {}
    __device__ __forceinline__ void done(const Unit&) const {}
};

__device__ __forceinline__ unsigned cvt_pk_bf16(float lo, float hi) { unsigned r; asm volatile("v_cvt_pk_bf16_f32 %0, %1, %2" : "=v"(r) : "v"(lo), "v"(hi)); return r; }
typedef float f32x2 __attribute__((ext_vector_type(2)));
struct EpiBf16 {
    static constexpr bool PERM = true, AFTER_DRAIN = false;
    bf16_t* O; int ldc; int split_cols; size_t split_stride; float scale0;
    __device__ __forceinline__ void operator()(const f32x4 (&acc)[2][2][4][2], const Unit& u, int wr, int wc, int fr, int fq) const {
        const int row0 = u.pm * BM + wr * 64 + fr; int colt = u.pn * BM; bf16_t* base = O;
        float sc = 1.f; if (split_cols) { const int t = colt / split_cols; base += (size_t)t * split_stride; colt -= t * split_cols; if (t == 0) sc = scale0; }
        const int col0 = colt + wc * 32 + 8 * fq;
#pragma unroll
        for (int ai = 0; ai < 2; ++ai)
#pragma unroll
            for (int m = 0; m < 4; ++m) { bf16_t* rowp = base + (size_t)(row0 + ai * HALF + m * 16) * ldc + col0;
#pragma unroll
                for (int bj = 0; bj < 2; ++bj) { f32x4 v0 = acc[ai][bj][m][0] * sc, v1 = acc[ai][bj][m][1] * sc;
                    u32x4 w; w.x = cvt_pk_bf16(v0[0], v0[1]); w.y = cvt_pk_bf16(v0[2], v0[3]); w.z = cvt_pk_bf16(v1[0], v1[1]); w.w = cvt_pk_bf16(v1[2], v1[3]);
                    *(u32x4*)(rowp + bj * HALF) = w; } }
    }
};
__device__ __forceinline__ float bf_lo(unsigned w) { return __builtin_bit_cast(float, w << 16); }
__device__ __forceinline__ float bf_hi(unsigned w) { return __builtin_bit_cast(float, w & 0xffff0000u); }
__device__ __forceinline__ float sigmoidf_(float x) { return __builtin_amdgcn_rcpf(1.0f + __builtin_amdgcn_exp2f(-1.44269504089f * x)); }
template <bool ADD> struct EpiGate {
    static constexpr bool PERM = true, AFTER_DRAIN = false;
    const bf16_t* G; size_t piece_stride; const float* bg; const bf16_t* prev; bf16_t* O; int ldc;
    __device__ __forceinline__ void operator()(const f32x4 (&acc)[2][2][4][2], const Unit& u, int wr, int wc, int fr, int fq) const {
        const int row0 = u.pm * BM + wr * 64 + fr; const int col0 = u.pn * BM + wc * 32 + 8 * fq;
        f32x4 bv[2][2];
#pragma unroll
        for (int bj = 0; bj < 2; ++bj)
#pragma unroll
            for (int n = 0; n < 2; ++n) bv[bj][n] = *(const f32x4*)(bg + col0 + bj * HALF + 4 * n);
#pragma unroll
        for (int ai = 0; ai < 2; ++ai)
#pragma unroll
            for (int m = 0; m < 4; ++m) { const int row = row0 + ai * HALF + m * 16;
#pragma unroll
                for (int bj = 0; bj < 2; ++bj) { const int col = col0 + bj * HALF;
                    const u32x4 gw = *(const u32x4*)(G + (size_t)(col >> 10) * piece_stride + (size_t)row * 1024 + (col & 1023));
                    f32x4 v0 = acc[ai][bj][m][0], v1 = acc[ai][bj][m][1];
                    v0[0] *= sigmoidf_(bf_lo(gw.x) + bv[bj][0][0]); v0[1] *= sigmoidf_(bf_hi(gw.x) + bv[bj][0][1]);
                    v0[2] *= sigmoidf_(bf_lo(gw.y) + bv[bj][0][2]); v0[3] *= sigmoidf_(bf_hi(gw.y) + bv[bj][0][3]);
                    v1[0] *= sigmoidf_(bf_lo(gw.z) + bv[bj][1][0]); v1[1] *= sigmoidf_(bf_hi(gw.z) + bv[bj][1][1]);
                    v1[2] *= sigmoidf_(bf_lo(gw.w) + bv[bj][1][2]); v1[3] *= sigmoidf_(bf_hi(gw.w) + bv[bj][1][3]);
                    if (ADD) { const u32x4 pw = *(const u32x4*)(prev + (size_t)row * ldc + col);
                        v0[0] += bf_lo(pw.x); v0[1] += bf_hi(pw.x); v0[2] += bf_lo(pw.y); v0[3] += bf_hi(pw.y);
                        v1[0] += bf_lo(pw.z); v1[1] += bf_hi(pw.z); v1[2] += bf_lo(pw.w); v1[3] += bf_hi(pw.w); }
                    u32x4 w; w.x = cvt_pk_bf16(v0[0], v0[1]); w.y = cvt_pk_bf16(v0[2], v0[3]); w.z = cvt_pk_bf16(v1[0], v1[1]); w.w = cvt_pk_bf16(v1[2], v1[3]);
                    *(u32x4*)(O + (size_t)row * ldc + col) = w; }
                asm volatile("" ::: "memory"); }
    }
};
struct EpiSsq {
    static constexpr bool PERM = true, AFTER_DRAIN = false;
    bf16_t* O; int ldc; float* ssq;
    __device__ __forceinline__ void operator()(const f32x4 (&acc)[2][2][4][2], const Unit& u, int wr, int wc, int fr, int fq) const {
        const int row0 = u.pm * BM + wr * 64 + fr; const int col0 = u.pn * BM + wc * 32 + 8 * fq;
#pragma unroll
        for (int ai = 0; ai < 2; ++ai)
#pragma unroll
            for (int m = 0; m < 4; ++m) { const int row = row0 + ai * HALF + m * 16; float ss = 0.f;
#pragma unroll
                for (int bj = 0; bj < 2; ++bj) { const f32x4 v0 = acc[ai][bj][m][0], v1 = acc[ai][bj][m][1];
                    ss += (v0[0] * v0[0] + v0[1] * v0[1]) + (v0[2] * v0[2] + v0[3] * v0[3]) + (v1[0] * v1[0] + v1[1] * v1[1]) + (v1[2] * v1[2] + v1[3] * v1[3]);
                    u32x4 w; w.x = cvt_pk_bf16(v0[0], v0[1]); w.y = cvt_pk_bf16(v0[2], v0[3]); w.z = cvt_pk_bf16(v1[0], v1[1]); w.w = cvt_pk_bf16(v1[2], v1[3]);
                    *(u32x4*)(O + (size_t)row * ldc + col0 + bj * HALF) = w; }
                ss += __shfl_xor(ss, 16); ss += __shfl_xor(ss, 32);
                if (fq == 0) ssq[(size_t)row * 32 + u.pn * 4 + wc] = ss; }
    }
};

template <class Epi, class Sched, bool ALIGN_EPI = false, bool SP2 = false>
__device__ __forceinline__ void gemm_phase(PG8_LAS unsigned char* lds, const Gemm g, const Sched& S, const Epi& E) {
    const int tid = threadIdx.x, wid = __builtin_amdgcn_readfirstlane(tid >> 6), lane = tid & 63, wr = wid >> 2, wc = wid & 3, fr = lane & 15, fq = lane >> 4;
    const int K = g.K, nt = K / BK;
    unsigned voffA[2], voffB[2];
#pragma unroll
    for (int i = 0; i < 2; ++i) { int R, C; stage_rc(tid * 16 + i * 8192, R, C); const int Rb = Epi::PERM ? ((R & ~31) + perm32(R & 31)) : R;
        voffA[i] = (unsigned)(R * K + C) * 2u; voffB[i] = (unsigned)(Rb * K + C) * 2u; }
    const size_t kstep = (size_t)(BK * 2);
    const size_t hstep = (size_t)HALF * K * 2;
    const size_t tstep = 2 * hstep;
    const unsigned ldsw = (unsigned)wid * 1024u;
    const int aoff = lds_byte(wr * 64 + fr, fq * 8), boff = lds_byte(wc * 32 + fr, fq * 8);
#define PG8_SA(b, h) (((b) * 2 + (h)) * HTB)
#define PG8_SB(b, h) ((4 + (b) * 2 + (h)) * HTB)
#define PG8_STAGE(bufoff, gbase, voff) do { _Pragma("unroll") for (int _i = 0; _i < 2; ++_i) \
        __builtin_amdgcn_global_load_lds((const unsigned*)((const char*)(gbase) + (voff)[_i]), (PG8_LAS unsigned*)(lds + (bufoff) + ldsw + _i * 8192), 16, 0, 0); } while (0)
#define PG8_LDA(dst, b, h) do { _Pragma("unroll") for (int m = 0; m < 4; ++m) _Pragma("unroll") for (int k = 0; k < 2; ++k) dst[m][k] = *(const PG8_LAS bf16x8*)(lds + PG8_SA(b, h) + aoff + m * 2048 + k * 1024); } while (0)
#define PG8_LDB(dst, b, h) do { _Pragma("unroll") for (int n = 0; n < 2; ++n) _Pragma("unroll") for (int k = 0; k < 2; ++k) dst[n][k] = *(const PG8_LAS bf16x8*)(lds + PG8_SB(b, h) + boff + n * 2048 + k * 1024); } while (0)
#define PG8_MMA(ai, bj, At, Bt) do { __builtin_amdgcn_s_setprio(1); _Pragma("unroll") for (int m = 0; m < 4; ++m) _Pragma("unroll") for (int n = 0; n < 2; ++n) _Pragma("unroll") for (int k = 0; k < 2; ++k) \
        acc[ai][bj][m][n] = __builtin_amdgcn_mfma_f32_16x16x32_bf16(Bt[n][k], At[m][k], acc[ai][bj][m][n], 0, 0, 0); __builtin_amdgcn_s_setprio(0); } while (0)
#define PG8_WAIT_V(n) asm volatile("s_waitcnt vmcnt(" #n ")" ::: "memory")
#define PG8_WAIT_L(n) asm volatile("s_waitcnt lgkmcnt(" #n ")" ::: "memory")
#define PG8_BAR __builtin_amdgcn_s_barrier()
#define PG8_SCHED __builtin_amdgcn_sched_barrier(0)
    Unit cur, nxt; int ui = 0;
    if (!S.next(0, cur)) return;
    f32x4 acc[2][2][4][2];
#pragma unroll
    for (int a = 0; a < 2; ++a)
#pragma unroll
        for (int b = 0; b < 2; ++b)
#pragma unroll
            for (int m = 0; m < 4; ++m)
#pragma unroll
                for (int n = 0; n < 2; ++n) acc[a][b][m][n] = (f32x4){0.f, 0.f, 0.f, 0.f};
    bf16x8 At[4][2], B0[2][2], B1[2][2];
    const char* cA = (const char*)g.A + (size_t)cur.pm * tstep; const char* cB = (const char*)g.Bt + (size_t)cur.pn * tstep;
    S.a_ready(cur);
    if constexpr (SP2) {
        PG8_STAGE(PG8_SB(0, 0), cB, voffB); PG8_STAGE(PG8_SB(0, 1), cB + hstep, voffB); PG8_STAGE(PG8_SA(0, 0), cA, voffA); PG8_STAGE(PG8_SA(0, 1), cA + hstep, voffA);
        if (wr == 1) PG8_BAR;
        PG8_WAIT_V(2); PG8_BAR;
        PG8_STAGE(PG8_SB(1, 0), cB + kstep, voffB); PG8_STAGE(PG8_SA(1, 0), cA + kstep, voffA); PG8_STAGE(PG8_SB(1, 1), cB + hstep + kstep, voffB);
        PG8_WAIT_V(6); PG8_BAR;
    } else {
        PG8_STAGE(PG8_SB(0, 0), cB, voffB); PG8_STAGE(PG8_SA(0, 0), cA, voffA); PG8_STAGE(PG8_SB(0, 1), cB + hstep, voffB); PG8_STAGE(PG8_SA(0, 1), cA + hstep, voffA);
        if (wr == 1) PG8_BAR;
        PG8_WAIT_V(4); PG8_BAR;
        PG8_STAGE(PG8_SB(1, 0), cB + kstep, voffB); PG8_STAGE(PG8_SA(1, 0), cA + kstep, voffA); PG8_STAGE(PG8_SB(1, 1), cB + hstep + kstep, voffB);
        PG8_WAIT_V(6); PG8_BAR;
    }
    for (;;) {
        const bool has_next = S.next(ui + 1, nxt);
        const char* nA = has_next ? (const char*)g.A + (size_t)nxt.pm * tstep : cA; const char* nB = has_next ? (const char*)g.Bt + (size_t)nxt.pn * tstep : cB;
        for (int t = 0; t < nt; t += 2) {
            const bool last = (t == nt - 2);
            const char* a1 = cA + (size_t)(t + 1) * kstep;
            const char* a2 = last ? nA : cA + (size_t)(t + 2) * kstep; const char* b2 = last ? nB : cB + (size_t)(t + 2) * kstep;
            const char* a3 = a2 + kstep; const char* b3 = b2 + kstep;
            if (last && has_next) S.a_ready(nxt);
            if constexpr (SP2) {
            PG8_LDB(B0, 0, 0); PG8_LDB(B1, 0, 1); PG8_SCHED; PG8_LDA(At, 0, 0); PG8_STAGE(PG8_SA(1, 1), a1 + hstep, voffA);
            PG8_WAIT_V(8); PG8_WAIT_L(0); PG8_BAR; PG8_MMA(0, 0, At, B0); PG8_MMA(0, 1, At, B1); PG8_BAR; PG8_SCHED;
            PG8_LDA(At, 0, 1); PG8_STAGE(PG8_SB(0, 0), b2, voffB); PG8_STAGE(PG8_SB(0, 1), b2 + hstep, voffB); PG8_STAGE(PG8_SA(0, 0), a2, voffA);
            PG8_WAIT_V(8); PG8_WAIT_L(0); PG8_BAR; PG8_MMA(1, 0, At, B0); PG8_MMA(1, 1, At, B1); PG8_BAR; PG8_SCHED;
            PG8_LDB(B0, 1, 0); PG8_LDB(B1, 1, 1); PG8_SCHED; PG8_LDA(At, 1, 0); PG8_STAGE(PG8_SA(0, 1), a2 + hstep, voffA);
            PG8_WAIT_V(8); PG8_WAIT_L(0); PG8_BAR; PG8_MMA(0, 0, At, B0); PG8_MMA(0, 1, At, B1); PG8_BAR; PG8_SCHED;
            PG8_LDA(At, 1, 1); PG8_STAGE(PG8_SB(1, 0), b3, voffB); PG8_STAGE(PG8_SB(1, 1), b3 + hstep, voffB); PG8_STAGE(PG8_SA(1, 0), a3, voffA);
            PG8_WAIT_V(8); PG8_WAIT_L(0); PG8_BAR; PG8_MMA(1, 0, At, B0); PG8_MMA(1, 1, At, B1); PG8_BAR; PG8_SCHED;
            } else {
            PG8_LDB(B0, 0, 0); PG8_SCHED; PG8_LDA(At, 0, 0); PG8_STAGE(PG8_SA(1, 1), a1 + hstep, voffA);
            PG8_WAIT_L(8); PG8_BAR; PG8_WAIT_L(0); PG8_MMA(0, 0, At, B0); PG8_BAR; PG8_SCHED;
            PG8_LDB(B1, 0, 1); PG8_STAGE(PG8_SB(0, 0), b2, voffB);
            PG8_BAR; PG8_WAIT_L(0); PG8_MMA(0, 1, At, B1); PG8_BAR;
            PG8_LDA(At, 0, 1); PG8_STAGE(PG8_SA(0, 0), a2, voffA);
            PG8_BAR; PG8_WAIT_L(0); PG8_MMA(1, 0, At, B0); PG8_BAR; PG8_SCHED;
            PG8_STAGE(PG8_SB(0, 1), b2 + hstep, voffB);
            PG8_WAIT_V(6); PG8_BAR; PG8_MMA(1, 1, At, B1); PG8_BAR;
            PG8_LDB(B0, 1, 0); PG8_SCHED; PG8_LDA(At, 1, 0); PG8_STAGE(PG8_SA(0, 1), a2 + hstep, voffA);
            PG8_WAIT_L(8); PG8_BAR; PG8_WAIT_L(0); PG8_MMA(0, 0, At, B0); PG8_BAR; PG8_SCHED;
            PG8_LDB(B1, 1, 1); PG8_STAGE(PG8_SB(1, 0), b3, voffB);
            PG8_BAR; PG8_WAIT_L(0); PG8_MMA(0, 1, At, B1); PG8_BAR;
            PG8_LDA(At, 1, 1); PG8_STAGE(PG8_SA(1, 0), a3, voffA);
            PG8_BAR; PG8_WAIT_L(0); PG8_MMA(1, 0, At, B0); PG8_BAR; PG8_SCHED;
            PG8_STAGE(PG8_SB(1, 1), b3 + hstep, voffB);
            PG8_WAIT_V(6); PG8_BAR; PG8_MMA(1, 1, At, B1); PG8_BAR;
            }
        }
        if constexpr (ALIGN_EPI) { if (wr == 0) PG8_BAR; }
        if constexpr (!Epi::AFTER_DRAIN) { E(acc, cur, wr, wc, fr, fq); S.done(cur); }
        if (!has_next) break;
#pragma unroll
        for (int a = 0; a < 2; ++a)
#pragma unroll
            for (int b = 0; b < 2; ++b)
#pragma unroll
                for (int m = 0; m < 4; ++m)
#pragma unroll
                    for (int n = 0; n < 2; ++n) acc[a][b][m][n] = (f32x4){0.f, 0.f, 0.f, 0.f};
        cur = nxt; cA = nA; cB = nB; ++ui;
        if constexpr (ALIGN_EPI) { if (wr == 1) PG8_BAR; }
    }
    PG8_WAIT_V(0);
    if constexpr (!ALIGN_EPI) { if (wr == 0) PG8_BAR; }
    PG8_BAR;
    if constexpr (Epi::AFTER_DRAIN) { E.fused(acc, cur, wr, wc, fr, fq, lds, wid, lane); S.done(cur); }
#undef PG8_SA
#undef PG8_SB
#undef PG8_STAGE
#undef PG8_LDA
#undef PG8_LDB
#undef PG8_MMA
#undef PG8_WAIT_V
#undef PG8_WAIT_L
#undef PG8_BAR
#undef PG8_SCHED
}
}
constexpr int NWAVES = 8;
constexpr int M = 16384, D = 2048, INC = 13312, PW = 1024, NPIECE = 13;
constexpr int GW = 64, GROWS = 256;
constexpr int NAH = 16, NADH = 64, HGH = 8, HGD = 128;
constexpr float EPS = 1e-6f;
enum { P_NQ = 0, P_NK = 1, P_NV = 2, P_NZ = 3, P_HQ = 4, P_HFF = 5, P_HFB = 6, P_HI = 7, P_HZ = 8, P_GA = 9, P_GB = 11 };
constexpr size_t MiB = 1u << 20;
constexpr size_t WS_CTL = 0, CTL_ZERO_BYTES = 1 * MiB;
constexpr size_t WS_SSQ = 2 * MiB;
constexpr size_t WS_WIN = 4 * MiB;
constexpr size_t WS_WBA = 56 * MiB, WS_WBB = 60 * MiB;
constexpr size_t WS_WOUT = 64 * MiB;
constexpr size_t WS_H = 72 * MiB;
constexpr size_t PIECE_BYTES = (size_t)M * PW * 2, PIECE_ELEMS = (size_t)M * PW;
constexpr size_t WS_END = WS_H + NPIECE * PIECE_BYTES;
static_assert(WS_WIN + (size_t)INC * D * 2 <= WS_WBA && WS_WOUT + (size_t)D * D * 2 <= WS_H, "ws map");
constexpr int CW_BAR = 4096;
constexpr int RING_OFF = 0, RING_BYTES = 131072;
constexpr int LDSCTL_OFF = RING_BYTES, MISC_OFF = LDSCTL_OFF + 320;
constexpr int LDS_BYTES = 147456;
#define GAS __attribute__((address_space(1)))
#define LAS __attribute__((address_space(3)))
typedef unsigned short bf16;
typedef unsigned v4u __attribute__((ext_vector_type(4)));
typedef float f32x4 __attribute__((ext_vector_type(4)));
typedef short bf16x8 __attribute__((ext_vector_type(8)));
typedef GAS unsigned gu32;
typedef GAS unsigned long long gu64;
#define RLX_AGENT __ATOMIC_RELAXED, __HIP_MEMORY_SCOPE_AGENT
#define LDS_WAIT() asm volatile("s_waitcnt lgkmcnt(0)" ::: "memory")
#define VM_WAIT() asm volatile("s_waitcnt vmcnt(0)" ::: "memory")
__device__ __forceinline__ unsigned long long rt() { return __builtin_amdgcn_s_memrealtime(); }
__device__ __forceinline__ unsigned f2bf(float f) { unsigned u = __builtin_bit_cast(unsigned, f); return (u + 0x7fffu + ((u >> 16) & 1u)) >> 16; }
__device__ __forceinline__ unsigned pk2(float lo, float hi) { return f2bf(lo) | (f2bf(hi) << 16); }

#define XB_TMO      128
#define XB_XCNT(j)  (256  + 64 * (j))
#define XB_XSUB(j)  (1280 + 64 * (j))
#define XB_XGEN(j)  (2304 + 64 * (j))
#define XB_TOP      3328
#define XB_TOPGEN   3392
#define XCD_BAR_WORDS 3456
#define XB_SPIN_CAP (1u << 18)

__device__ __forceinline__ unsigned xb_ld(unsigned* p)              { return __hip_atomic_load(p, __ATOMIC_RELAXED, __HIP_MEMORY_SCOPE_AGENT); }
__device__ __forceinline__ unsigned xb_add(unsigned* p, unsigned v) { return __hip_atomic_fetch_add(p, v, __ATOMIC_RELAXED, __HIP_MEMORY_SCOPE_AGENT); }
__device__ __forceinline__ unsigned xb_xcc_id() { return (unsigned)__builtin_amdgcn_s_getreg((3 << 11) | 20) & 0xFu; }
#define XB_SPIN(cond, bar) do { unsigned _sp = 0; while (cond) { __builtin_amdgcn_s_sleep(1); \
    if ((++_sp & 255u) == 0u) { if (xb_ld(&(bar)[XB_TMO])) break; if (_sp > XB_SPIN_CAP) { atomicAdd(&(bar)[XB_TMO], 1u); break; } } } } while (0)

struct XcdBarrier {
    unsigned* bar; unsigned x;
    volatile LAS unsigned* st;
};

__device__ __forceinline__ XcdBarrier xcd_barrier_post(unsigned* bar, volatile LAS unsigned* st) {
    XcdBarrier b; b.bar = bar; b.x = xb_xcc_id(); b.st = st;
    if (threadIdx.x == 0) (void)xb_add(&bar[XB_XCNT(b.x)], 1u);
    return b;
}
__device__ __forceinline__ void xcd_barrier_complete(unsigned* bar, unsigned x, unsigned& nloc, unsigned& nx) {
    const unsigned G = gridDim.x * gridDim.y * gridDim.z;
    unsigned sum, cnt, mine, sp = 0u;
    for (;;) {
        sum = 0u; cnt = 0u; mine = 0u;
#pragma unroll
        for (unsigned j = 0; j < 16; ++j) { const unsigned c = xb_ld(&bar[XB_XCNT(j)]); sum += c; cnt += (c > 0u) ? 1u : 0u; mine = (j == x) ? c : mine; }
        if (sum == G) break;
        __builtin_amdgcn_s_sleep(1);
        if ((++sp & 255u) == 0u) { if (xb_ld(&bar[XB_TMO])) break; if (sp > XB_SPIN_CAP) { atomicAdd(&bar[XB_TMO], 1u); break; } }
    }
    nloc = mine > 0u ? mine : 1u; nx = cnt > 0u ? cnt : 1u;
}

__device__ __forceinline__ void xcd_barrier(const XcdBarrier& b) {
    asm volatile("s_waitcnt vmcnt(0)" ::: "memory");
    __syncthreads();
    if (threadIdx.x == 0) {
        unsigned* bar = b.bar;
        __builtin_amdgcn_s_waitcnt(0);
        unsigned nloc = b.st[0], nx = b.st[1];
        if (nloc == 0u) { xcd_barrier_complete(bar, b.x, nloc, nx); b.st[0] = nloc; b.st[1] = nx; }
        const unsigned old = xb_add(&bar[XB_XSUB(b.x)], 1u);
        const unsigned gen = old / nloc;
        if (old + 1u == (gen + 1u) * nloc) {
            __builtin_amdgcn_fence(__ATOMIC_RELEASE, "agent");
            asm volatile("s_waitcnt vmcnt(0)" ::: "memory");
            const unsigned og = xb_add(&bar[XB_TOP], 1u);
            const unsigned tg = og / nx;
            if (og + 1u == (tg + 1u) * nx) xb_add(&bar[XB_TOPGEN], 1u);
            else XB_SPIN(xb_ld(&bar[XB_TOPGEN]) == tg, bar);
            __builtin_amdgcn_fence(__ATOMIC_ACQUIRE, "agent");
            xb_add(&bar[XB_XGEN(b.x)], 1u);
            asm volatile("s_waitcnt vmcnt(0)" ::: "memory");
        } else {
            XB_SPIN(xb_ld(&bar[XB_XGEN(b.x)]) == gen, bar);
            __builtin_amdgcn_fence(__ATOMIC_ACQUIRE, "agent");
            asm volatile("s_waitcnt vmcnt(0)" ::: "memory");
        }
    }
    __syncthreads();
}
__device__ __forceinline__ float wave_sum(float v) {
#pragma unroll
    for (int o = 1; o < 64; o <<= 1) v += __shfl_xor(v, o);
    return v;
}
__device__ __forceinline__ void p0_transpose_item(const float* W, int K, int N, bf16* WT, int row_off, LAS float* scr, int item, int lane) {
    const int nblk = N / 32, kb = item / nblk, nb = item % nblk, k0 = 64 * kb, n0 = 32 * nb;
#pragma unroll 8
    for (int i = 0; i < 32; ++i) { const int kk = 2 * i + (lane >> 5); scr[kk * 33 + (lane & 31)] = W[(size_t)(k0 + kk) * N + n0 + (lane & 31)]; }
    LDS_WAIT(); asm volatile("" ::: "memory");
    const int c = lane & 7;
#pragma unroll
    for (int j = 0; j < 4; ++j) { const int n = (lane >> 3) + 8 * j; const LAS float* s = scr + (8 * c) * 33 + n;
        v4u o; o.x = pk2(s[0 * 33], s[1 * 33]); o.y = pk2(s[2 * 33], s[3 * 33]); o.z = pk2(s[4 * 33], s[5 * 33]); o.w = pk2(s[6 * 33], s[7 * 33]);
        *(GAS v4u*)(WT + (size_t)(row_off + n0 + n) * K + k0 + 8 * c) = o; }
    LDS_WAIT(); asm volatile("" ::: "memory");
}
struct Frame {
    LAS unsigned char* lds;
    volatile LAS unsigned* MISC;
    gu32* ctl;
    int tid, lane, wave;
    int vcu, G;
};
__device__ __forceinline__ float bf2f(bf16 b) { return __builtin_bit_cast(float, (unsigned)b << 16); }
__device__ __forceinline__ float wave_max(float v) {
#pragma unroll
    for (int o = 1; o < 64; o <<= 1) v = fmaxf(v, __shfl_xor(v, o));
    return v;
}
__device__ __forceinline__ float sigm(float x) { return 1.0f / (1.0f + __expf(-x)); }

__device__ __forceinline__ void p0_prologue(Frame& F, const float* x, const float* w_pre, const float* w_in, const float* w_br, const float* w_out,
                                            bf16* XN, bf16* WIN_T, bf16* WBA_T, bf16* WBB_T, bf16* WOUT_T) {
    LAS float* scr = (LAS float*)(F.lds + RING_OFF + F.wave * 16384);
    const int gw = F.vcu * NWAVES + F.wave, NGW = F.G * NWAVES;
    constexpr int I_IN = (D / 64) * (INC / 32), I_BR = (PW / 64) * (D / 32), I_OUT = (D / 64) * (D / 32);
    constexpr int NITEMS = I_IN + 2 * I_BR + I_OUT;
    for (int it = gw; it < NITEMS; it += NGW) {
        int r = it;
        if (r < I_IN) { p0_transpose_item(w_in, D, INC, WIN_T, 0, scr, r, F.lane); continue; } r -= I_IN;
        if (r < I_BR) { p0_transpose_item(w_br, PW, D, WBA_T, 0, scr, r, F.lane); continue; } r -= I_BR;
        if (r < I_BR) { p0_transpose_item(w_br + (size_t)PW * D, PW, D, WBB_T, 0, scr, r, F.lane); continue; } r -= I_BR;
        p0_transpose_item(w_out, D, D, WOUT_T, 0, scr, r, F.lane);
    }
    for (int m = gw; m < M; m += NGW) {
        const f32x4* xr = (const f32x4*)(x + (size_t)m * D) + F.lane;
        f32x4 v[8]; float s = 0.f;
#pragma unroll
        for (int j = 0; j < 8; ++j) { v[j] = xr[64 * j]; s += (v[j].x * v[j].x + v[j].y * v[j].y) + (v[j].z * v[j].z + v[j].w * v[j].w); }
        const float rstd = 1.0f / sqrtf(wave_sum(s) * (1.f / D) + EPS);
        unsigned long long* o8 = (unsigned long long*)(XN + (size_t)m * D) + F.lane;
#pragma unroll
        for (int j = 0; j < 8; ++j) { const f32x4 w = *((const f32x4*)w_pre + F.lane + 64 * j);
            o8[64 * j] = (unsigned long long)pk2(v[j].x * rstd * w.x, v[j].y * rstd * w.y) | ((unsigned long long)pk2(v[j].z * rstd * w.z, v[j].w * rstd * w.w) << 32); }
    }
}

__device__ __forceinline__ void na_naive(Frame& F, bf16* Q, const bf16* K, const bf16* V, const bf16* Z, const float* rpb) {
    const int gw = F.vcu * NWAVES + F.wave, NGW = F.G * NWAVES, lane = F.lane;
    for (int it = gw; it < M * NAH; it += NGW) {
        const int h = it & 15, tq = it >> 4, r = tq >> 6, c = tq & 63;
        int rs = r - 4; rs = rs < 0 ? 0 : (rs > GROWS - 8 ? GROWS - 8 : rs);
        int cs = c - 8; cs = cs < 0 ? 0 : (cs > GW - 16 ? GW - 16 : cs);
        const v4u* qp = (const v4u*)(Q + (size_t)tq * PW + h * NADH);
        v4u qv[8];
#pragma unroll
        for (int i = 0; i < 8; ++i) qv[i] = qp[i];
        float sc[2];
#pragma unroll
        for (int e = 0; e < 2; ++e) {
            const int j = lane + 64 * e, kr = rs + (j >> 4), kc = cs + (j & 15), tk = kr * GW + kc;
            const v4u* kp = (const v4u*)(K + (size_t)tk * PW + h * NADH);
            float a = 0.f;
#pragma unroll
            for (int i = 0; i < 8; ++i) { const v4u kv = kp[i];
                a += pg8::bf_lo(qv[i].x) * pg8::bf_lo(kv.x) + pg8::bf_hi(qv[i].x) * pg8::bf_hi(kv.x) + pg8::bf_lo(qv[i].y) * pg8::bf_lo(kv.y) + pg8::bf_hi(qv[i].y) * pg8::bf_hi(kv.y)
                   + pg8::bf_lo(qv[i].z) * pg8::bf_lo(kv.z) + pg8::bf_hi(qv[i].z) * pg8::bf_hi(kv.z) + pg8::bf_lo(qv[i].w) * pg8::bf_lo(kv.w) + pg8::bf_hi(qv[i].w) * pg8::bf_hi(kv.w); }
            sc[e] = a * 0.125f + rpb[(h * 15 + (kr - r + 7)) * 31 + (kc - c + 15)];
        }
        const float mx = wave_max(fmaxf(sc[0], sc[1]));
        const float e0 = __expf(sc[0] - mx), e1 = __expf(sc[1] - mx);
        const float inv = 1.0f / wave_sum(e0 + e1);
        const float p0 = e0 * inv, p1 = e1 * inv;
        float o = 0.f;
        for (int j = 0; j < 64; ++j) {
            const int kr = rs + (j >> 4), kc = cs + (j & 15), tk = kr * GW + kc;
            const float pa = __shfl(p0, j), pb = __shfl(p1, j);
            o += pa * bf2f(V[(size_t)tk * PW + h * NADH + lane]);
            o += pb * bf2f(V[(size_t)(tk + 4 * GW) * PW + h * NADH + lane]);
        }
        const float z = bf2f(Z[(size_t)tq * PW + h * NADH + lane]);
        o *= z * sigm(z);
        Q[(size_t)tq * PW + h * NADH + lane] = (bf16)f2bf(o);
    }
}

__device__ __forceinline__ void hg_naive(Frame& F, const bf16* HQ, const bf16* HFF, const bf16* HFB, const bf16* HI, const float* lb_logits, float* OFWD, float* OBWD) {
    LAS float* red = (LAS float*)(F.lds + RING_OFF);
    for (int u = blockIdx.x; u < 256; u += F.G) {
        const int hd = u >> 4, head = hd >> 1, dir = hd & 1, dv0 = (u & 15) * 8;
        const int dk = F.tid & 127, part = F.tid >> 7;
        const int ch = head * HGD + dk;
        const float lbv = sigm(lb_logits[dir * 1024 + ch] - lb_logits[2048 + dir * 1024 + ch]);
        const bf16* FL = dir ? HFB : HFF; float* OUT = dir ? OBWD : OFWD;
        const int cv = head * HGD + dv0 + part * 2;
        float S0 = 0.f, S1 = 0.f;
        for (int cb = 0; cb < M / 64; ++cb) {
            LAS float* rb = red + (cb & 1) * 1024;
#pragma unroll 8
            for (int s = 0; s < 64; ++s) {
                const int step = cb * 64 + s, t = dir ? (M - 1 - step) : step;
                const float fl = bf2f(FL[(size_t)t * PW + ch]), q = bf2f(HQ[(size_t)t * PW + ch]);
                const unsigned vv = *(const unsigned*)(HI + (size_t)t * PW + cv);
                const float v0 = pg8::bf_lo(vv), v1 = pg8::bf_hi(vv);
                const float sg = sigm(fl), f = lbv + (1.f - lbv) * sg, k = (1.f - lbv) * (1.f - sg);
                S0 = f * S0 + k * v0; S1 = f * S1 + k * v1;
                const float p0 = wave_sum(S0 * q), p1 = wave_sum(S1 * q);
                if (F.lane == 0) { rb[(s * 8 + F.wave) * 2] = p0; rb[(s * 8 + F.wave) * 2 + 1] = p1; }
            }
            __syncthreads();
            { const int s = F.tid >> 3, j = F.tid & 7, pp = j >> 1, e = j & 1;
              const int step = cb * 64 + s, t = dir ? (M - 1 - step) : step;
              OUT[(size_t)t * PW + head * HGD + dv0 + j] = rb[(s * 8 + 2 * pp) * 2 + e] + rb[(s * 8 + 2 * pp + 1) * 2 + e]; }
        }
        __syncthreads();
    }
}
constexpr int HG_IMQ = 0, HG_IMK = 16384, HG_IMV = 32768, HG_IMP = 49152, HG_PROW = 144, HG_IMS = HG_IMP + 64 * HG_PROW, HG_WTOT = HG_IMS + 8 * 4096, HG_EREF = HG_WTOT + 4096, HG_CSC = HG_EREF + 512, HG_LDS_END = HG_CSC + 512;
static_assert(HG_LDS_END <= RING_BYTES, "hg lds");
__device__ __forceinline__ unsigned off_b(unsigned row, unsigned ch) { return 256u * row + 16u * (ch ^ (((row & 3) << 2) | ((row >> 2) & 3))); }
typedef short s16x4 __attribute__((ext_vector_type(4)));
typedef float f32x2 __attribute__((ext_vector_type(2)));
__device__ __forceinline__ void tr_read4(unsigned a0, unsigned a1, unsigned a2, unsigned a3, s16x4& r0, s16x4& r1, s16x4& r2, s16x4& r3) {
    asm volatile("ds_read_b64_tr_b16 %0, %4\n\tds_read_b64_tr_b16 %1, %5\n\tds_read_b64_tr_b16 %2, %6\n\tds_read_b64_tr_b16 %3, %7\n\ts_waitcnt lgkmcnt(0)"
                 : "=&v"(r0), "=&v"(r1), "=&v"(r2), "=&v"(r3) : "v"(a0), "v"(a1), "v"(a2), "v"(a3) : "memory");
}
#define MFMA16(a, b, c) __builtin_amdgcn_mfma_f32_16x16x32_bf16((a), (b), (c), 0, 0, 0)
template <bool PRE>
__device__ __forceinline__ void hg_unit(Frame& F, int head, int dir, int c0, int nch, const bf16* HQ, const bf16* FL, const bf16* HI, const float* lb_logits,
                                        const float* S_in, float* S_out, float* Dseg_out, float* OUT) {
    LAS unsigned char* L = F.lds + RING_OFF;
    const unsigned lbase = (unsigned)(size_t)L;
    const int lane = F.lane, w = F.wave, n = lane & 15, g = lane >> 4, q4 = n >> 2, p4 = n & 3;
    const int chb = head * HGD;
    float lbv[2];
#pragma unroll
    for (int e = 0; e < 2; ++e) { const int ch = chb + 2 * lane + e; lbv[e] = sigm(lb_logits[dir * 1024 + ch] - lb_logits[2048 + dir * 1024 + ch]); }
    f32x4 S[8];
#pragma unroll
    for (int kt = 0; kt < 8; ++kt) {
        if (S_in) {
#pragma unroll
            for (int r = 0; r < 4; ++r) S[kt][r] = S_in[(size_t)(16 * kt + 4 * g + r) * HGD + 16 * w + n]; }
        else S[kt] = (f32x4){0.f, 0.f, 0.f, 0.f};
    }
    float dseg[2] = {0.f, 0.f};
    for (int ci = 0; ci < nch; ++ci) {
        const int c = dir ? (c0 + nch - 1 - ci) : (c0 + ci);
        float Aloc[8][2], kk[8][2], qq[8][2]; unsigned vraw[8];
        float run0 = 0.f, run1 = 0.f;
#pragma unroll
        for (int i = 0; i < 8; ++i) {
            const int tau = 8 * w + i, t = dir ? (64 * c + 63 - tau) : (64 * c + tau);
            const size_t o = (size_t)t * PW + chb + 2 * lane;
            const unsigned fw = *(const unsigned*)(FL + o), qw = *(const unsigned*)(HQ + o); vraw[i] = *(const unsigned*)(HI + o);
            const float f0 = pg8::bf_lo(fw), f1 = pg8::bf_hi(fw);
            const float s0 = pg8::sigmoidf_(f0), s1 = pg8::sigmoidf_(f1);
            const float g0 = __builtin_amdgcn_logf(lbv[0] + (1.f - lbv[0]) * s0), g1 = __builtin_amdgcn_logf(lbv[1] + (1.f - lbv[1]) * s1);
            kk[i][0] = (1.f - lbv[0]) * (1.f - s0); kk[i][1] = (1.f - lbv[1]) * (1.f - s1);
            qq[i][0] = pg8::bf_lo(qw); qq[i][1] = pg8::bf_hi(qw);
            run0 += g0; run1 += g1; Aloc[i][0] = run0; Aloc[i][1] = run1;
        }
        LAS float* WT = (LAS float*)(L + HG_WTOT);
        *(LAS f32x2*)(WT + w * 128 + 2 * lane) = (f32x2){run0, run1};
        __syncthreads();
        float pre0 = 0.f, pre1 = 0.f, ref0 = 0.f, ref1 = 0.f, tot0 = 0.f, tot1 = 0.f;
#pragma unroll
        for (int ww = 0; ww < 8; ++ww) { const f32x2 tv = *(LAS f32x2*)(WT + ww * 128 + 2 * lane);
            if (ww < w) { pre0 += tv.x; pre1 += tv.y; } if (ww < 4) { ref0 += tv.x; ref1 += tv.y; } tot0 += tv.x; tot1 += tv.y; }
        dseg[0] += tot0; dseg[1] += tot1;
#pragma unroll
        for (int i = 0; i < 8; ++i) {
            const int tau = 8 * w + i;
            const float d0 = pre0 + Aloc[i][0] - ref0, d1 = pre1 + Aloc[i][1] - ref1;
            const float qm0 = qq[i][0] * __builtin_amdgcn_exp2f(d0), qm1 = qq[i][1] * __builtin_amdgcn_exp2f(d1);
            const float km0 = kk[i][0] * __builtin_amdgcn_exp2f(fminf(-d0, 120.f)), km1 = kk[i][1] * __builtin_amdgcn_exp2f(fminf(-d1, 120.f));
            const unsigned ob = off_b(tau, lane >> 2) + (lane & 3) * 4;
            *(LAS unsigned*)(L + HG_IMQ + ob) = pk2(qm0, qm1);
            *(LAS unsigned*)(L + HG_IMK + ob) = pk2(km0, km1);
            *(LAS unsigned*)(L + HG_IMV + ob) = vraw[i];
        }
        if (w == 0) { *(LAS f32x2*)((LAS float*)(L + HG_EREF) + 2 * lane) = (f32x2){__builtin_amdgcn_exp2f(ref0), __builtin_amdgcn_exp2f(ref1)};
                      *(LAS f32x2*)((LAS float*)(L + HG_CSC) + 2 * lane) = (f32x2){__builtin_amdgcn_exp2f(tot0 - ref0), __builtin_amdgcn_exp2f(tot1 - ref1)}; }
        __syncthreads();
        if (!PRE) {
            const int tt = w >> 1;
            pg8::bf16x8 bq[4];
#pragma unroll
            for (int ks = 0; ks < 4; ++ks) bq[ks] = *(const LAS pg8::bf16x8*)(L + HG_IMQ + off_b(16 * tt + n, 4 * ks + g));
#pragma unroll
            for (int si = 0; si < 2; ++si) { const int st = 2 * (w & 1) + si;
                f32x4 pacc = (f32x4){0.f, 0.f, 0.f, 0.f};
#pragma unroll
                for (int ks = 0; ks < 4; ++ks) { const pg8::bf16x8 ak = *(const LAS pg8::bf16x8*)(L + HG_IMK + off_b(16 * st + n, 4 * ks + g)); pacc = MFMA16(ak, bq[ks], pacc); }
                const int tcol = 16 * tt + n, srow = 16 * st + 4 * g;
                float pv[4];
#pragma unroll
                for (int r = 0; r < 4; ++r) pv[r] = (srow + r <= tcol) ? pacc[r] : 0.f;
                *(LAS unsigned long long*)(L + HG_IMP + tcol * HG_PROW + srow * 2) = (unsigned long long)pk2(pv[0], pv[1]) | ((unsigned long long)pk2(pv[2], pv[3]) << 32);
            }
        }
#pragma unroll
        for (int kt = 0; kt < 8; ++kt) { const f32x4 e4 = *(const LAS f32x4*)((LAS float*)(L + HG_EREF) + 16 * kt + 4 * g);
            S[kt] = S[kt] * e4;
            if (!PRE) *(LAS unsigned long long*)(L + HG_IMS + w * 4096 + off_b(n, 2 * kt + (g >> 1)) + 8 * (g & 1)) = (unsigned long long)pk2(S[kt][0], S[kt][1]) | ((unsigned long long)pk2(S[kt][2], S[kt][3]) << 32);
        }
        pg8::bf16x8 vf[2];
        { s16x4 r0, r1, r2, r3;
          tr_read4(lbase + HG_IMV + off_b(8 * g + q4, 2 * w + (p4 >> 1)) + 8 * (p4 & 1), lbase + HG_IMV + off_b(8 * g + 4 + q4, 2 * w + (p4 >> 1)) + 8 * (p4 & 1),
                   lbase + HG_IMV + off_b(32 + 8 * g + q4, 2 * w + (p4 >> 1)) + 8 * (p4 & 1), lbase + HG_IMV + off_b(32 + 8 * g + 4 + q4, 2 * w + (p4 >> 1)) + 8 * (p4 & 1), r0, r1, r2, r3);
          vf[0] = __builtin_shufflevector(r0, r1, 0, 1, 2, 3, 4, 5, 6, 7); vf[1] = __builtin_shufflevector(r2, r3, 0, 1, 2, 3, 4, 5, 6, 7); }
        if (!PRE) {
            __syncthreads();
            pg8::bf16x8 sf[4];
#pragma unroll
            for (int ks = 0; ks < 4; ++ks) sf[ks] = *(const LAS pg8::bf16x8*)(L + HG_IMS + w * 4096 + off_b(n, 4 * ks + g));
#pragma unroll
            for (int tt = 0; tt < 4; ++tt) {
                f32x4 oacc = (f32x4){0.f, 0.f, 0.f, 0.f};
#pragma unroll
                for (int ks = 0; ks < 2; ++ks) { if (32 * ks > 16 * tt + 15) continue;
                    const pg8::bf16x8 pf = *(const LAS pg8::bf16x8*)(L + HG_IMP + (16 * tt + n) * HG_PROW + (32 * ks + 8 * g) * 2); oacc = MFMA16(pf, vf[ks], oacc); }
#pragma unroll
                for (int ks = 0; ks < 4; ++ks) { const pg8::bf16x8 qf = *(const LAS pg8::bf16x8*)(L + HG_IMQ + off_b(16 * tt + n, 4 * ks + g)); oacc = MFMA16(qf, sf[ks], oacc); }
#pragma unroll
                for (int r = 0; r < 4; ++r) { const int tau = 16 * tt + 4 * g + r, t = dir ? (64 * c + 63 - tau) : (64 * c + tau);
                    OUT[(size_t)t * PW + chb + 16 * w + n] = oacc[r]; }
            }
        }
#pragma unroll
        for (int kt = 0; kt < 8; ++kt) {
            s16x4 r0, r1, r2, r3;
            tr_read4(lbase + HG_IMK + off_b(8 * g + q4, 2 * kt + (p4 >> 1)) + 8 * (p4 & 1), lbase + HG_IMK + off_b(8 * g + 4 + q4, 2 * kt + (p4 >> 1)) + 8 * (p4 & 1),
                     lbase + HG_IMK + off_b(32 + 8 * g + q4, 2 * kt + (p4 >> 1)) + 8 * (p4 & 1), lbase + HG_IMK + off_b(32 + 8 * g + 4 + q4, 2 * kt + (p4 >> 1)) + 8 * (p4 & 1), r0, r1, r2, r3);
            const pg8::bf16x8 k0 = __builtin_shufflevector(r0, r1, 0, 1, 2, 3, 4, 5, 6, 7), k1 = __builtin_shufflevector(r2, r3, 0, 1, 2, 3, 4, 5, 6, 7);
            S[kt] = MFMA16(k0, vf[0], S[kt]); S[kt] = MFMA16(k1, vf[1], S[kt]);
            const f32x4 c4 = *(const LAS f32x4*)((LAS float*)(L + HG_CSC) + 16 * kt + 4 * g);
            S[kt] = S[kt] * c4;
        }
    }
    __syncthreads();
    if (S_out) {
#pragma unroll
        for (int kt = 0; kt < 8; ++kt)
#pragma unroll
            for (int r = 0; r < 4; ++r) S_out[(size_t)(16 * kt + 4 * g + r) * HGD + 16 * w + n] = S[kt][r];
    }
    if (Dseg_out && w == 0) { Dseg_out[2 * lane] = dseg[0]; Dseg_out[2 * lane + 1] = dseg[1]; }
}

__device__ __forceinline__ void hg_finish(Frame& F, const float* OFWD, const float* OBWD, const bf16* HZ, const float* w, bf16* OB) {
    const int gw = F.vcu * NWAVES + F.wave, NGW = F.G * NWAVES, lane = F.lane;
    for (int m = gw; m < M; m += NGW) {
        const f32x4* a = (const f32x4*)(OFWD + (size_t)m * PW) + lane * 4; const f32x4* b = (const f32x4*)(OBWD + (size_t)m * PW) + lane * 4;
        f32x4 o[4]; float ss = 0.f;
#pragma unroll
        for (int i = 0; i < 4; ++i) { o[i] = a[i] + b[i]; ss += (o[i].x * o[i].x + o[i].y * o[i].y) + (o[i].z * o[i].z + o[i].w * o[i].w); }
        ss += __shfl_xor(ss, 1); ss += __shfl_xor(ss, 2); ss += __shfl_xor(ss, 4);
        const float rstd = 1.0f / sqrtf(ss * (1.f / HGD) + EPS);
        const v4u* zp = (const v4u*)(HZ + (size_t)m * PW) + lane * 2; v4u* op = (v4u*)(OB + (size_t)m * PW) + lane * 2;
#pragma unroll
        for (int hh = 0; hh < 2; ++hh) { const v4u zz = zp[hh]; const f32x4 w0 = *((const f32x4*)w + lane * 4 + hh * 2), w1 = *((const f32x4*)w + lane * 4 + hh * 2 + 1);
            const f32x4 o0 = o[hh * 2], o1 = o[hh * 2 + 1];
            float zf[8] = {pg8::bf_lo(zz.x), pg8::bf_hi(zz.x), pg8::bf_lo(zz.y), pg8::bf_hi(zz.y), pg8::bf_lo(zz.z), pg8::bf_hi(zz.z), pg8::bf_lo(zz.w), pg8::bf_hi(zz.w)};
            float r[8] = {o0.x * w0.x, o0.y * w0.y, o0.z * w0.z, o0.w * w0.w, o1.x * w1.x, o1.y * w1.y, o1.z * w1.z, o1.w * w1.w};
#pragma unroll
            for (int i = 0; i < 8; ++i) r[i] = r[i] * rstd * zf[i] * sigm(zf[i]);
            v4u ow; ow.x = pk2(r[0], r[1]); ow.y = pk2(r[2], r[3]); ow.z = pk2(r[4], r[5]); ow.w = pk2(r[6], r[7]); op[hh] = ow; }
    }
}
__device__ __forceinline__ void final_phase(Frame& F, const float* x, const bf16* Zb, const float* ssq, const float* w, float* out) {
    const int gw = F.vcu * NWAVES + F.wave, NGW = F.G * NWAVES, lane = F.lane;
    for (int m = gw; m < M; m += NGW) {
        const float part = lane < 32 ? ssq[(size_t)m * 32 + lane] : 0.f;
        const float rstd = 1.0f / sqrtf(wave_sum(part) * (1.f / D) + EPS);
        const f32x4* xr = (const f32x4*)(x + (size_t)m * D) + lane; f32x4* orow = (f32x4*)(out + (size_t)m * D) + lane;
        const unsigned long long* zr = (const unsigned long long*)(Zb + (size_t)m * D) + lane;
#pragma unroll
        for (int j = 0; j < 8; ++j) { const f32x4 xv = xr[64 * j]; const unsigned long long zz = zr[64 * j]; const f32x4 wv = *((const f32x4*)w + lane + 64 * j);
            const unsigned lo = (unsigned)zz, hi = (unsigned)(zz >> 32);
            f32x4 o; o.x = xv.x + pg8::bf_lo(lo) * rstd * wv.x; o.y = xv.y + pg8::bf_hi(lo) * rstd * wv.y; o.z = xv.z + pg8::bf_lo(hi) * rstd * wv.z; o.w = xv.w + pg8::bf_hi(hi) * rstd * wv.w;
            orow[64 * j] = o; }
    }
}
struct Args { const float* in[10]; float* out; unsigned char* ws; int ph_lo, ph_hi, li, pad; };
constexpr int N_PHASES = 7;
__global__ void __launch_bounds__(NWAVES * 64, 2) fwd_kernel(Args args) {
    extern __shared__ __attribute__((aligned(16))) unsigned char lds[];
    Frame F;
    F.lds = (LAS unsigned char*)lds;
    F.MISC = (volatile LAS unsigned*)(F.lds + MISC_OFF);
    F.tid = threadIdx.x; F.lane = F.tid & 63; F.wave = __builtin_amdgcn_readfirstlane(F.tid >> 6);
    F.G = gridDim.x; { const int bx = blockIdx.x; F.vcu = (F.G % 8 == 0) ? (bx % 8) * (F.G / 8) + bx / 8 : bx; }
    unsigned char* ws = args.ws;
    F.ctl = (gu32*)(ws + WS_CTL);
    const float* x = args.in[0]; const float* w_pre = args.in[1]; const float* w_in = args.in[2]; const float* b_gate = args.in[3]; const float* rpb = args.in[4];
    const float* lb_logits = args.in[5]; const float* hg_norm_w = args.in[6]; const float* w_br = args.in[7]; const float* w_out = args.in[8]; const float* w_post = args.in[9];
    bf16* WIN_T = (bf16*)(ws + WS_WIN); bf16* WBA_T = (bf16*)(ws + WS_WBA); bf16* WBB_T = (bf16*)(ws + WS_WBB); bf16* WOUT_T = (bf16*)(ws + WS_WOUT);
    bf16* H = (bf16*)(ws + WS_H);
    float* SSQ = (float*)(ws + WS_SSQ);
    bf16* XN = (bf16*)args.out;
    float* OFWD = args.out; float* OBWD = args.out + (size_t)M * PW;
    bf16* OA = H + P_NQ * PIECE_ELEMS; bf16* OB = H + P_HQ * PIECE_ELEMS; bf16* YA = H + P_NK * PIECE_ELEMS; bf16* Y = H + P_HFF * PIECE_ELEMS; bf16* Zb = H + P_HI * PIECE_ELEMS;
    for (int u = F.tid; u < (LDS_BYTES - LDSCTL_OFF) / 4; u += NWAVES * 64) ((LAS unsigned*)(F.lds + LDSCTL_OFF))[u] = 0u;
    __syncthreads();
    XcdBarrier bar = xcd_barrier_post((unsigned*)(F.ctl + CW_BAR) + args.li * XCD_BAR_WORDS, F.MISC + 8);
    const int lo = args.ph_lo, hi = args.ph_hi;
#define IN(k) (lo <= (k) && (k) < hi)
#define BOTH(k) (IN(k) && IN((k) + 1))
#define GRID_BAR() xcd_barrier(bar)

    if (IN(0)) { p0_prologue(F, x, w_pre, w_in, w_br, w_out, XN, WIN_T, WBA_T, WBB_T, WOUT_T); if (BOTH(0)) GRID_BAR(); }
    if (IN(1)) {
        pg8::Gemm g{XN, WIN_T, M, INC, D}; pg8::StaticOrder S; S.init(M, INC, F.G, (int)blockIdx.x);
        pg8::EpiBf16 E{H, PW, PW, PIECE_ELEMS, 1.0f};
        pg8::gemm_phase<pg8::EpiBf16, pg8::StaticOrder, true, true>(F.lds + RING_OFF, g, S, E);
        if (BOTH(1)) GRID_BAR();
    }
    if (IN(2)) {
        for (int u = blockIdx.x; u < 16; u += F.G) { const int head = u >> 1, dir = u & 1;
            hg_unit<false>(F, head, dir, 0, M / 64, H + P_HQ * PIECE_ELEMS, H + (dir ? P_HFB : P_HFF) * PIECE_ELEMS, H + P_HI * PIECE_ELEMS, lb_logits, nullptr, nullptr, nullptr, dir ? OBWD : OFWD); }
        na_naive(F, H + P_NQ * PIECE_ELEMS, H + P_NK * PIECE_ELEMS, H + P_NV * PIECE_ELEMS, H + P_NZ * PIECE_ELEMS, rpb);
        if (BOTH(2)) GRID_BAR();
    }
    if (IN(3)) { hg_finish(F, OFWD, OBWD, H + P_HZ * PIECE_ELEMS, hg_norm_w, OB); if (BOTH(3)) GRID_BAR(); }
    if (IN(4)) {
        { pg8::Gemm g{OA, WBA_T, M, D, PW}; pg8::StaticOrder S; S.init(M, D, F.G, (int)blockIdx.x);
          pg8::EpiGate<false> E{H + P_GA * PIECE_ELEMS, PIECE_ELEMS, b_gate, nullptr, YA, D};
          pg8::gemm_phase<pg8::EpiGate<false>, pg8::StaticOrder, true, true>(F.lds + RING_OFF, g, S, E); }
        { pg8::Gemm g{OB, WBB_T, M, D, PW}; pg8::StaticOrder S; S.init(M, D, F.G, (int)blockIdx.x);
          pg8::EpiGate<true> E{H + P_GB * PIECE_ELEMS, PIECE_ELEMS, b_gate + D, YA, Y, D};
          pg8::gemm_phase<pg8::EpiGate<true>, pg8::StaticOrder, true, true>(F.lds + RING_OFF, g, S, E); }
        if (BOTH(4)) GRID_BAR();
    }
    if (IN(5)) {
        pg8::Gemm g{Y, WOUT_T, M, D, D}; pg8::StaticOrder S; S.init(M, D, F.G, (int)blockIdx.x);
        pg8::EpiSsq E{Zb, D, SSQ};
        pg8::gemm_phase<pg8::EpiSsq, pg8::StaticOrder, true, true>(F.lds + RING_OFF, g, S, E);
        if (BOTH(5)) GRID_BAR();
    }
    if (IN(6)) { final_phase(F, x, Zb, SSQ, w_post, args.out); }
#undef IN
#undef BOTH
}

#ifndef MK_N_LAUNCHES
#define MK_N_LAUNCHES 1
#endif
extern "C" void kernel_launch(void* const* d_in, const int* in_sizes, int n_in, void* d_out, int out_size, void* d_ws, size_t ws_size, hipStream_t stream) {
    static int grid = 0;
    if (grid == 0) {
        if (n_in != 10 || in_sizes[0] != M * D || out_size != M * D || ws_size < WS_END) { fprintf(stderr, "kernel_launch: unexpected shapes: n_in %d in0 %d out %d ws %zu (need %zu)\n", n_in, n_in > 0 ? in_sizes[0] : -1, out_size, ws_size, (size_t)WS_END); grid = -1; return; }
        int dev = 0, cus = 0, per_cu = 0;
        if (hipGetDevice(&dev) != hipSuccess || hipDeviceGetAttribute(&cus, hipDeviceAttributeMultiprocessorCount, dev) != hipSuccess) { fprintf(stderr, "kernel_launch: device query failed\n"); grid = -1; return; }
        if (hipFuncSetAttribute((const void*)fwd_kernel, hipFuncAttributeMaxDynamicSharedMemorySize, LDS_BYTES) != hipSuccess) { fprintf(stderr, "kernel_launch: hipFuncSetAttribute failed\n"); grid = -1; return; }
        if (hipOccupancyMaxActiveBlocksPerMultiprocessor(&per_cu, (const void*)fwd_kernel, NWAVES * 64, LDS_BYTES) != hipSuccess || per_cu < 1) { fprintf(stderr, "kernel_launch: occupancy query reports %d blocks/CU; nothing launched\n", per_cu); (void)hipGetLastError(); grid = -1; return; }
        grid = cus;
    }
    if (grid < 0) return;
    if (hipMemsetAsync((char*)d_ws + WS_CTL, 0, CTL_ZERO_BYTES, stream) != hipSuccess) { fprintf(stderr, "kernel_launch: memset failed\n"); return; }
    Args a{};
    for (int i = 0; i < 10; ++i) a.in[i] = (const float*)d_in[i];
    a.out = (float*)d_out; a.ws = (unsigned char*)d_ws;
#if MK_N_LAUNCHES == 1
    a.ph_lo = 0; a.ph_hi = N_PHASES; a.li = 0;
    hipLaunchKernelGGL(fwd_kernel, dim3(grid), dim3(NWAVES * 64), LDS_BYTES, stream, a);
#else
    for (int li = 0; li < N_PHASES; ++li) { a.ph_lo = li; a.ph_hi = li + 1; a.li = li;
        hipLaunchKernelGGL(fwd_kernel, dim3(grid), dim3(NWAVES * 64), LDS_BYTES, stream, a); }
#endif
    const hipError_t le = hipPeekAtLastError();
    if (le != hipSuccess) fprintf(stderr, "kernel_launch: launch failed: %s\n", hipGetErrorName(le));
}
```

```cpp
#include <hip/hip_runtime.h>
#include <cstdio>
#include <cstdint>
namespace pg8 {
#define PG8_LAS __attribute__((address_space(3)))
typedef unsigned short bf16_t;
typedef short bf16x8 __attribute__((ext_vector_type(8)));
typedef float f32x4 __attribute__((ext_vector_type(4)));
typedef unsigned u32x4 __attribute__((ext_vector_type(4)));
constexpr int BM = 256, BK = 64, HALF = 128, HTB = HALF * BK * 2  , STAGE_BYTES = 8 * HTB, NXCD = 8, WGM = 8;

__host__ __device__ __forceinline__ int lds_byte(int r, int c) { const int st = (r >> 4) * 2 + (c >> 5), rr = r & 15, cc = c & 31, ob = rr * 64 + cc * 2; return st * 1024 + (ob ^ (((ob >> 9) & 1) << 5)); }
__host__ __device__ __forceinline__ void stage_rc(int b, int& R, int& C) { const int st = b / 1024, sb = b % 1024, swz = sb ^ (((sb >> 9) & 1) << 5); R = (st >> 1) * 16 + swz / 64; C = (st & 1) * 32 + (swz % 64) / 2; }
__host__ __device__ __forceinline__ int perm32(int rho) { const int n = rho >> 4, i = rho & 15; return 8 * (i >> 2) + 4 * n + (i & 3); }

struct Unit { int pm, pn; };
struct Gemm { const bf16_t* A; const bf16_t* Bt; int M, N, K; };

struct StaticOrder {
    int nM, nN, nwg, G, c;
    __host__ __device__ void init(int M, int N, int G_, int c_) { nM = M / BM; nN = N / BM; nwg = nM * nN; G = G_; c = c_; }
    __host__ __device__ bool next(int i, Unit& u) const {
        const long L = (long)i * G + c; if (L >= nwg) return false;
        int wgid = (int)L; { const int q = nwg / NXCD, r = nwg % NXCD, xcd = wgid % NXCD, off = wgid / NXCD; wgid = (xcd < r ? xcd * (q + 1) : r * (q + 1) + (xcd - r) * q) + off; }
        const int nig = WGM * nN, gid = wgid / nig, fm = gid * WGM, gsz = (nM - fm) < WGM ? (nM - fm) : WGM;
        u.pm = fm + ((wgid % nig) % gsz); u.pn = (wgid % nig) / gsz; return true;
    }
    __device__ __forceinline__ void a_ready(const Unit&) const {}
    __device__ __forceinline__ void done(const Unit&) const {}
};

__device__ __forceinline__ unsigned cvt_pk_bf16(float lo, float hi) { unsigned r; asm volatile("v_cvt_pk_bf16_f32 %0, %1, %2" : "=v"(r) : "v"(lo), "v"(hi)); return r; }
typedef float f32x2 __attribute__((ext_vector_type(2)));
struct EpiBf16 {
    static constexpr bool PERM = true, AFTER_DRAIN = false;
    bf16_t* O; int ldc; int split_cols; size_t split_stride; float scale0;
    __device__ __forceinline__ void operator()(const f32x4 (&acc)[2][2][4][2], const Unit& u, int wr, int wc, int fr, int fq) const {
        const int row0 = u.pm * BM + wr * 64 + fr; int colt = u.pn * BM; bf16_t* base = O;
        float sc = 1.f; if (split_cols) { const int t = colt / split_cols; base += (size_t)t * split_stride; colt -= t * split_cols; if (t == 0) sc = scale0; }
        const int col0 = colt + wc * 32 + 8 * fq;
#pragma unroll
        for (int ai = 0; ai < 2; ++ai)
#pragma unroll
            for (int m = 0; m < 4; ++m) { bf16_t* rowp = base + (size_t)(row0 + ai * HALF + m * 16) * ldc + col0;
#pragma unroll
                for (int bj = 0; bj < 2; ++bj) { f32x4 v0 = acc[ai][bj][m][0] * sc, v1 = acc[ai][bj][m][1] * sc;
                    u32x4 w; w.x = cvt_pk_bf16(v0[0], v0[1]); w.y = cvt_pk_bf16(v0[2], v0[3]); w.z = cvt_pk_bf16(v1[0], v1[1]); w.w = cvt_pk_bf16(v1[2], v1[3]);
                    *(u32x4*)(rowp + bj * HALF) = w; } }
    }
};
__device__ __forceinline__ float bf_lo(unsigned w) { return __builtin_bit_cast(float, w << 16); }
__device__ __forceinline__ float bf_hi(unsigned w) { return __builtin_bit_cast(float, w & 0xffff0000u); }
__device__ __forceinline__ float sigmoidf_(float x) { return __builtin_amdgcn_rcpf(1.0f + __builtin_amdgcn_exp2f(-1.44269504089f * x)); }
template <bool ADD> struct EpiGate {
    static constexpr bool PERM = true, AFTER_DRAIN = false;
    const bf16_t* G; size_t piece_stride; const float* bg; const bf16_t* prev; bf16_t* O; int ldc;
    __device__ __forceinline__ void operator()(const f32x4 (&acc)[2][2][4][2], const Unit& u, int wr, int wc, int fr, int fq) const {
        const int row0 = u.pm * BM + wr * 64 + fr; const int col0 = u.pn * BM + wc * 32 + 8 * fq;
        f32x4 bv[2][2];
#pragma unroll
        for (int bj = 0; bj < 2; ++bj)
#pragma unroll
            for (int n = 0; n < 2; ++n) bv[bj][n] = *(const f32x4*)(bg + col0 + bj * HALF + 4 * n);
#pragma unroll
        for (int ai = 0; ai < 2; ++ai)
#pragma unroll
            for (int m = 0; m < 4; ++m) { const int row = row0 + ai * HALF + m * 16;
#pragma unroll
                for (int bj = 0; bj < 2; ++bj) { const int col = col0 + bj * HALF;
                    const u32x4 gw = *(const u32x4*)(G + (size_t)(col >> 10) * piece_stride + (size_t)row * 1024 + (col & 1023));
                    f32x4 v0 = acc[ai][bj][m][0], v1 = acc[ai][bj][m][1];
                    v0[0] *= sigmoidf_(bf_lo(gw.x) + bv[bj][0][0]); v0[1] *= sigmoidf_(bf_hi(gw.x) + bv[bj][0][1]);
                    v0[2] *= sigmoidf_(bf_lo(gw.y) + bv[bj][0][2]); v0[3] *= sigmoidf_(bf_hi(gw.y) + bv[bj][0][3]);
                    v1[0] *= sigmoidf_(bf_lo(gw.z) + bv[bj][1][0]); v1[1] *= sigmoidf_(bf_hi(gw.z) + bv[bj][1][1]);
                    v1[2] *= sigmoidf_(bf_lo(gw.w) + bv[bj][1][2]); v1[3] *= sigmoidf_(bf_hi(gw.w) + bv[bj][1][3]);
                    if (ADD) { const u32x4 pw = *(const u32x4*)(prev + (size_t)row * ldc + col);
                        v0[0] += bf_lo(pw.x); v0[1] += bf_hi(pw.x); v0[2] += bf_lo(pw.y); v0[3] += bf_hi(pw.y);
                        v1[0] += bf_lo(pw.z); v1[1] += bf_hi(pw.z); v1[2] += bf_lo(pw.w); v1[3] += bf_hi(pw.w); }
                    u32x4 w; w.x = cvt_pk_bf16(v0[0], v0[1]); w.y = cvt_pk_bf16(v0[2], v0[3]); w.z = cvt_pk_bf16(v1[0], v1[1]); w.w = cvt_pk_bf16(v1[2], v1[3]);
                    *(u32x4*)(O + (size_t)row * ldc + col) = w; }
                asm volatile("" ::: "memory"); }
    }
};
struct EpiSsq {
    static constexpr bool PERM = true, AFTER_DRAIN = false;
    bf16_t* O; int ldc; float* ssq;
    __device__ __forceinline__ void operator()(const f32x4 (&acc)[2][2][4][2], const Unit& u, int wr, int wc, int fr, int fq) const {
        const int row0 = u.pm * BM + wr * 64 + fr; const int col0 = u.pn * BM + wc * 32 + 8 * fq;
#pragma unroll
        for (int ai = 0; ai < 2; ++ai)
#pragma unroll
            for (int m = 0; m < 4; ++m) { const int row = row0 + ai * HALF + m * 16; float ss = 0.f;
#pragma unroll
                for (int bj = 0; bj < 2; ++bj) { const f32x4 v0 = acc[ai][bj][m][0], v1 = acc[ai][bj][m][1];
                    ss += (v0[0] * v0[0] + v0[1] * v0[1]) + (v0[2] * v0[2] + v0[3] * v0[3]) + (v1[0] * v1[0] + v1[1] * v1[1]) + (v1[2] * v1[2] + v1[3] * v1[3]);
                    u32x4 w; w.x = cvt_pk_bf16(v0[0], v0[1]); w.y = cvt_pk_bf16(v0[2], v0[3]); w.z = cvt_pk_bf16(v1[0], v1[1]); w.w = cvt_pk_bf16(v1[2], v1[3]);
                    *(u32x4*)(O + (size_t)row * ldc + col0 + bj * HALF) = w; }
                ss += __shfl_xor(ss, 16); ss += __shfl_xor(ss, 32);
                if (fq == 0) ssq[(size_t)row * 32 + u.pn * 4 + wc] = ss; }
    }
};

template <class Epi, class Sched, bool ALIGN_EPI = false, bool SP2 = false>
__device__ __forceinline__ void gemm_phase(PG8_LAS unsigned char* lds, const Gemm g, const Sched& S, const Epi& E) {
    const int tid = threadIdx.x, wid = __builtin_amdgcn_readfirstlane(tid >> 6), lane = tid & 63, wr = wid >> 2, wc = wid & 3, fr = lane & 15, fq = lane >> 4;
    const int K = g.K, nt = K / BK;
    unsigned voffA[2], voffB[2];
#pragma unroll
    for (int i = 0; i < 2; ++i) { int R, C; stage_rc(tid * 16 + i * 8192, R, C); const int Rb = Epi::PERM ? ((R & ~31) + perm32(R & 31)) : R;
        voffA[i] = (unsigned)(R * K + C) * 2u; voffB[i] = (unsigned)(Rb * K + C) * 2u; }
    const size_t kstep = (size_t)(BK * 2);
    const size_t hstep = (size_t)HALF * K * 2;
    const size_t tstep = 2 * hstep;
    const unsigned ldsw = (unsigned)wid * 1024u;
    const int aoff = lds_byte(wr * 64 + fr, fq * 8), boff = lds_byte(wc * 32 + fr, fq * 8);
#define PG8_SA(b, h) (((b) * 2 + (h)) * HTB)
#define PG8_SB(b, h) ((4 + (b) * 2 + (h)) * HTB)
#define PG8_STAGE(bufoff, gbase, voff) do { _Pragma("unroll") for (int _i = 0; _i < 2; ++_i) \
        __builtin_amdgcn_global_load_lds((const unsigned*)((const char*)(gbase) + (voff)[_i]), (PG8_LAS unsigned*)(lds + (bufoff) + ldsw + _i * 8192), 16, 0, 0); } while (0)
#define PG8_LDA(dst, b, h) do { _Pragma("unroll") for (int m = 0; m < 4; ++m) _Pragma("unroll") for (int k = 0; k < 2; ++k) dst[m][k] = *(const PG8_LAS bf16x8*)(lds + PG8_SA(b, h) + aoff + m * 2048 + k * 1024); } while (0)
#define PG8_LDB(dst, b, h) do { _Pragma("unroll") for (int n = 0; n < 2; ++n) _Pragma("unroll") for (int k = 0; k < 2; ++k) dst[n][k] = *(const PG8_LAS bf16x8*)(lds + PG8_SB(b, h) + boff + n * 2048 + k * 1024); } while (0)
#define PG8_MMA(ai, bj, At, Bt) do { __builtin_amdgcn_s_setprio(1); _Pragma("unroll") for (int m = 0; m < 4; ++m) _Pragma("unroll") for (int n = 0; n < 2; ++n) _Pragma("unroll") for (int k = 0; k < 2; ++k) \
        acc[ai][bj][m][n] = __builtin_amdgcn_mfma_f32_16x16x32_bf16(Bt[n][k], At[m][k], acc[ai][bj][m][n], 0, 0, 0); __builtin_amdgcn_s_setprio(0); } while (0)
#define PG8_WAIT_V(n) asm volatile("s_waitcnt vmcnt(" #n ")" ::: "memory")
#define PG8_WAIT_L(n) asm volatile("s_waitcnt lgkmcnt(" #n ")" ::: "memory")
#define PG8_BAR __builtin_amdgcn_s_barrier()
#define PG8_SCHED __builtin_amdgcn_sched_barrier(0)
    Unit cur, nxt; int ui = 0;
    if (!S.next(0, cur)) return;
    f32x4 acc[2][2][4][2];
#pragma unroll
    for (int a = 0; a < 2; ++a)
#pragma unroll
        for (int b = 0; b < 2; ++b)
#pragma unroll
            for (int m = 0; m < 4; ++m)
#pragma unroll
                for (int n = 0; n < 2; ++n) acc[a][b][m][n] = (f32x4){0.f, 0.f, 0.f, 0.f};
    bf16x8 At[4][2], B0[2][2], B1[2][2];
    const char* cA = (const char*)g.A + (size_t)cur.pm * tstep; const char* cB = (const char*)g.Bt + (size_t)cur.pn * tstep;
    S.a_ready(cur);
    if constexpr (SP2) {
        PG8_STAGE(PG8_SB(0, 0), cB, voffB); PG8_STAGE(PG8_SB(0, 1), cB + hstep, voffB); PG8_STAGE(PG8_SA(0, 0), cA, voffA); PG8_STAGE(PG8_SA(0, 1), cA + hstep, voffA);
        if (wr == 1) PG8_BAR;
        PG8_WAIT_V(2); PG8_BAR;
        PG8_STAGE(PG8_SB(1, 0), cB + kstep, voffB); PG8_STAGE(PG8_SA(1, 0), cA + kstep, voffA); PG8_STAGE(PG8_SB(1, 1), cB + hstep + kstep, voffB);
        PG8_WAIT_V(6); PG8_BAR;
    } else {
        PG8_STAGE(PG8_SB(0, 0), cB, voffB); PG8_STAGE(PG8_SA(0, 0), cA, voffA); PG8_STAGE(PG8_SB(0, 1), cB + hstep, voffB); PG8_STAGE(PG8_SA(0, 1), cA + hstep, voffA);
        if (wr == 1) PG8_BAR;
        PG8_WAIT_V(4); PG8_BAR;
        PG8_STAGE(PG8_SB(1, 0), cB + kstep, voffB); PG8_STAGE(PG8_SA(1, 0), cA + kstep, voffA); PG8_STAGE(PG8_SB(1, 1), cB + hstep + kstep, voffB);
        PG8_WAIT_V(6); PG8_BAR;
    }
    for (;;) {
        const bool has_next = S.next(ui + 1, nxt);
        const char* nA = has_next ? (const char*)g.A + (size_t)nxt.pm * tstep : cA; const char* nB = has_next ? (const char*)g.Bt + (size_t)nxt.pn * tstep : cB;
        for (int t = 0; t < nt; t += 2) {
            const bool last = (t == nt - 2);
            const char* a1 = cA + (size_t)(t + 1) * kstep;
            const char* a2 = last ? nA : cA + (size_t)(t + 2) * kstep; const char* b2 = last ? nB : cB + (size_t)(t + 2) * kstep;
            const char* a3 = a2 + kstep; const char* b3 = b2 + kstep;
            if (last && has_next) S.a_ready(nxt);
            if constexpr (SP2) {
            PG8_LDB(B0, 0, 0); PG8_LDB(B1, 0, 1); PG8_SCHED; PG8_LDA(At, 0, 0); PG8_STAGE(PG8_SA(1, 1), a1 + hstep, voffA);
            PG8_WAIT_V(8); PG8_WAIT_L(0); PG8_BAR; PG8_MMA(0, 0, At, B0); PG8_MMA(0, 1, At, B1); PG8_BAR; PG8_SCHED;
            PG8_LDA(At, 0, 1); PG8_STAGE(PG8_SB(0, 0), b2, voffB); PG8_STAGE(PG8_SB(0, 1), b2 + hstep, voffB); PG8_STAGE(PG8_SA(0, 0), a2, voffA);
            PG8_WAIT_V(8); PG8_WAIT_L(0); PG8_BAR; PG8_MMA(1, 0, At, B0); PG8_MMA(1, 1, At, B1); PG8_BAR; PG8_SCHED;
            PG8_LDB(B0, 1, 0); PG8_LDB(B1, 1, 1); PG8_SCHED; PG8_LDA(At, 1, 0); PG8_STAGE(PG8_SA(0, 1), a2 + hstep, voffA);
            PG8_WAIT_V(8); PG8_WAIT_L(0); PG8_BAR; PG8_MMA(0, 0, At, B0); PG8_MMA(0, 1, At, B1); PG8_BAR; PG8_SCHED;
            PG8_LDA(At, 1, 1); PG8_STAGE(PG8_SB(1, 0), b3, voffB); PG8_STAGE(PG8_SB(1, 1), b3 + hstep, voffB); PG8_STAGE(PG8_SA(1, 0), a3, voffA);
            PG8_WAIT_V(8); PG8_WAIT_L(0); PG8_BAR; PG8_MMA(1, 0, At, B0); PG8_MMA(1, 1, At, B1); PG8_BAR; PG8_SCHED;
            } else {
            PG8_LDB(B0, 0, 0); PG8_SCHED; PG8_LDA(At, 0, 0); PG8_STAGE(PG8_SA(1, 1), a1 + hstep, voffA);
            PG8_WAIT_L(8); PG8_BAR; PG8_WAIT_L(0); PG8_MMA(0, 0, At, B0); PG8_BAR; PG8_SCHED;
            PG8_LDB(B1, 0, 1); PG8_STAGE(PG8_SB(0, 0), b2, voffB);
            PG8_BAR; PG8_WAIT_L(0); PG8_MMA(0, 1, At, B1); PG8_BAR;
            PG8_LDA(At, 0, 1); PG8_STAGE(PG8_SA(0, 0), a2, voffA);
            PG8_BAR; PG8_WAIT_L(0); PG8_MMA(1, 0, At, B0); PG8_BAR; PG8_SCHED;
            PG8_STAGE(PG8_SB(0, 1), b2 + hstep, voffB);
            PG8_WAIT_V(6); PG8_BAR; PG8_MMA(1, 1, At, B1); PG8_BAR;
            PG8_LDB(B0, 1, 0); PG8_SCHED; PG8_LDA(At, 1, 0); PG8_STAGE(PG8_SA(0, 1), a2 + hstep, voffA);
            PG8_WAIT_L(8); PG8_BAR; PG8_WAIT_L(0); PG8_MMA(0, 0, At, B0); PG8_BAR; PG8_SCHED;
            PG8_LDB(B1, 1, 1); PG8_STAGE(PG8_SB(1, 0), b3, voffB);
            PG8_BAR; PG8_WAIT_L(0); PG8_MMA(0, 1, At, B1); PG8_BAR;
            PG8_LDA(At, 1, 1); PG8_STAGE(PG8_SA(1, 0), a3, voffA);
            PG8_BAR; PG8_WAIT_L(0); PG8_MMA(1, 0, At, B0); PG8_BAR; PG8_SCHED;
            PG8_STAGE(PG8_SB(1, 1), b3 + hstep, voffB);
            PG8_WAIT_V(6); PG8_BAR; PG8_MMA(1, 1, At, B1); PG8_BAR;
            }
        }
        if constexpr (ALIGN_EPI) { if (wr == 0) PG8_BAR; }
        if constexpr (!Epi::AFTER_DRAIN) { E(acc, cur, wr, wc, fr, fq); S.done(cur); }
        if (!has_next) break;
#pragma unroll
        for (int a = 0; a < 2; ++a)
#pragma unroll
            for (int b = 0; b < 2; ++b)
#pragma unroll
                for (int m = 0; m < 4; ++m)
#pragma unroll
                    for (int n = 0; n < 2; ++n) acc[a][b][m][n] = (f32x4){0.f, 0.f, 0.f, 0.f};
        cur = nxt; cA = nA; cB = nB; ++ui;
        if constexpr (ALIGN_EPI) { if (wr == 1) PG8_BAR; }
    }
    PG8_WAIT_V(0);
    if constexpr (!ALIGN_EPI) { if (wr == 0) PG8_BAR; }
    PG8_BAR;
    if constexpr (Epi::AFTER_DRAIN) { E.fused(acc, cur, wr, wc, fr, fq, lds, wid, lane); S.done(cur); }
#undef PG8_SA
#undef PG8_SB
#undef PG8_STAGE
#undef PG8_LDA
#undef PG8_LDB
#undef PG8_MMA
#undef PG8_WAIT_V
#undef PG8_WAIT_L
#undef PG8_BAR
#undef PG8_SCHED
}
}
constexpr int NWAVES = 8;
constexpr int M = 16384, D = 2048, INC = 13312, PW = 1024, NPIECE = 13;
constexpr int GW = 64, GROWS = 256;
constexpr int NAH = 16, NADH = 64, HGH = 8, HGD = 128;
constexpr float EPS = 1e-6f;
enum { P_NQ = 0, P_NK = 1, P_NV = 2, P_NZ = 3, P_HQ = 4, P_HFF = 5, P_HFB = 6, P_HI = 7, P_HZ = 8, P_GA = 9, P_GB = 11 };
constexpr size_t MiB = 1u << 20;
constexpr size_t WS_CTL = 0, CTL_ZERO_BYTES = 1 * MiB;
constexpr size_t WS_SSQ = 2 * MiB;
constexpr size_t WS_WIN = 4 * MiB;
constexpr size_t WS_WBA = 56 * MiB, WS_WBB = 60 * MiB;
constexpr size_t WS_WOUT = 64 * MiB;
constexpr size_t WS_H = 72 * MiB;
constexpr size_t PIECE_BYTES = (size_t)M * PW * 2, PIECE_ELEMS = (size_t)M * PW;
constexpr size_t WS_END = WS_H + NPIECE * PIECE_BYTES;
static_assert(WS_WIN + (size_t)INC * D * 2 <= WS_WBA && WS_WOUT + (size_t)D * D * 2 <= WS_H, "ws map");
constexpr size_t WS_SLOC = 4 * MiB, WS_DSEG = 36 * MiB;
constexpr int HG_SEGC = 8, HG_NSEG = 32;
constexpr int CW_BAR = 4096;
constexpr int RING_OFF = 0, RING_BYTES = 131072;
constexpr int LDSCTL_OFF = RING_BYTES, MISC_OFF = LDSCTL_OFF + 320;
constexpr int LDS_BYTES = 147456;
#define GAS __attribute__((address_space(1)))
#define LAS __attribute__((address_space(3)))
typedef unsigned short bf16;
typedef unsigned v4u __attribute__((ext_vector_type(4)));
typedef float f32x4 __attribute__((ext_vector_type(4)));
typedef short bf16x8 __attribute__((ext_vector_type(8)));
typedef GAS unsigned gu32;
typedef GAS unsigned long long gu64;
#define RLX_AGENT __ATOMIC_RELAXED, __HIP_MEMORY_SCOPE_AGENT
#define LDS_WAIT() asm volatile("s_waitcnt lgkmcnt(0)" ::: "memory")
#define VM_WAIT() asm volatile("s_waitcnt vmcnt(0)" ::: "memory")
__device__ __forceinline__ unsigned long long rt() { return __builtin_amdgcn_s_memrealtime(); }
__device__ __forceinline__ unsigned f2bf(float f) { unsigned u = __builtin_bit_cast(unsigned, f); return (u + 0x7fffu + ((u >> 16) & 1u)) >> 16; }
__device__ __forceinline__ unsigned pk2(float lo, float hi) { return f2bf(lo) | (f2bf(hi) << 16); }

#define XB_TMO      128
#define XB_XCNT(j)  (256  + 64 * (j))
#define XB_XSUB(j)  (1280 + 64 * (j))
#define XB_XGEN(j)  (2304 + 64 * (j))
#define XB_TOP      3328
#define XB_TOPGEN   3392
#define XCD_BAR_WORDS 3456
#define XB_SPIN_CAP (1u << 18)

__device__ __forceinline__ unsigned xb_ld(unsigned* p)              { return __hip_atomic_load(p, __ATOMIC_RELAXED, __HIP_MEMORY_SCOPE_AGENT); }
__device__ __forceinline__ unsigned xb_add(unsigned* p, unsigned v) { return __hip_atomic_fetch_add(p, v, __ATOMIC_RELAXED, __HIP_MEMORY_SCOPE_AGENT); }
__device__ __forceinline__ unsigned xb_xcc_id() { return (unsigned)__builtin_amdgcn_s_getreg((3 << 11) | 20) & 0xFu; }
#define XB_SPIN(cond, bar) do { unsigned _sp = 0; while (cond) { __builtin_amdgcn_s_sleep(1); \
    if ((++_sp & 255u) == 0u) { if (xb_ld(&(bar)[XB_TMO])) break; if (_sp > XB_SPIN_CAP) { atomicAdd(&(bar)[XB_TMO], 1u); break; } } } } while (0)

struct XcdBarrier {
    unsigned* bar; unsigned x;
    volatile LAS unsigned* st;
};

__device__ __forceinline__ XcdBarrier xcd_barrier_post(unsigned* bar, volatile LAS unsigned* st) {
    XcdBarrier b; b.bar = bar; b.x = xb_xcc_id(); b.st = st;
    if (threadIdx.x == 0) (void)xb_add(&bar[XB_XCNT(b.x)], 1u);
    return b;
}
__device__ __forceinline__ void xcd_barrier_complete(unsigned* bar, unsigned x, unsigned& nloc, unsigned& nx) {
    const unsigned G = gridDim.x * gridDim.y * gridDim.z;
    unsigned sum, cnt, mine, sp = 0u;
    for (;;) {
        sum = 0u; cnt = 0u; mine = 0u;
#pragma unroll
        for (unsigned j = 0; j < 16; ++j) { const unsigned c = xb_ld(&bar[XB_XCNT(j)]); sum += c; cnt += (c > 0u) ? 1u : 0u; mine = (j == x) ? c : mine; }
        if (sum == G) break;
        __builtin_amdgcn_s_sleep(1);
        if ((++sp & 255u) == 0u) { if (xb_ld(&bar[XB_TMO])) break; if (sp > XB_SPIN_CAP) { atomicAdd(&bar[XB_TMO], 1u); break; } }
    }
    nloc = mine > 0u ? mine : 1u; nx = cnt > 0u ? cnt : 1u;
}

__device__ __forceinline__ void xcd_barrier(const XcdBarrier& b) {
    asm volatile("s_waitcnt vmcnt(0)" ::: "memory");
    __syncthreads();
    if (threadIdx.x == 0) {
        unsigned* bar = b.bar;
        __builtin_amdgcn_s_waitcnt(0);
        unsigned nloc = b.st[0], nx = b.st[1];
        if (nloc == 0u) { xcd_barrier_complete(bar, b.x, nloc, nx); b.st[0] = nloc; b.st[1] = nx; }
        const unsigned old = xb_add(&bar[XB_XSUB(b.x)], 1u);
        const unsigned gen = old / nloc;
        if (old + 1u == (gen + 1u) * nloc) {
            __builtin_amdgcn_fence(__ATOMIC_RELEASE, "agent");
            asm volatile("s_waitcnt vmcnt(0)" ::: "memory");
            const unsigned og = xb_add(&bar[XB_TOP], 1u);
            const unsigned tg = og / nx;
            if (og + 1u == (tg + 1u) * nx) xb_add(&bar[XB_TOPGEN], 1u);
            else XB_SPIN(xb_ld(&bar[XB_TOPGEN]) == tg, bar);
            __builtin_amdgcn_fence(__ATOMIC_ACQUIRE, "agent");
            xb_add(&bar[XB_XGEN(b.x)], 1u);
            asm volatile("s_waitcnt vmcnt(0)" ::: "memory");
        } else {
            XB_SPIN(xb_ld(&bar[XB_XGEN(b.x)]) == gen, bar);
            __builtin_amdgcn_fence(__ATOMIC_ACQUIRE, "agent");
            asm volatile("s_waitcnt vmcnt(0)" ::: "memory");
        }
    }
    __syncthreads();
}
__device__ __forceinline__ float wave_sum(float v) {
#pragma unroll
    for (int o = 1; o < 64; o <<= 1) v += __shfl_xor(v, o);
    return v;
}
__device__ __forceinline__ void p0_transpose_item(const float* W, int K, int N, bf16* WT, int row_off, LAS float* scr, int item, int lane) {
    const int nblk = N / 32, kb = item / nblk, nb = item % nblk, k0 = 64 * kb, n0 = 32 * nb;
#pragma unroll 8
    for (int i = 0; i < 32; ++i) { const int kk = 2 * i + (lane >> 5); scr[kk * 33 + (lane & 31)] = W[(size_t)(k0 + kk) * N + n0 + (lane & 31)]; }
    LDS_WAIT(); asm volatile("" ::: "memory");
    const int c = lane & 7;
#pragma unroll
    for (int j = 0; j < 4; ++j) { const int n = (lane >> 3) + 8 * j; const LAS float* s = scr + (8 * c) * 33 + n;
        v4u o; o.x = pk2(s[0 * 33], s[1 * 33]); o.y = pk2(s[2 * 33], s[3 * 33]); o.z = pk2(s[4 * 33], s[5 * 33]); o.w = pk2(s[6 * 33], s[7 * 33]);
        *(GAS v4u*)(WT + (size_t)(row_off + n0 + n) * K + k0 + 8 * c) = o; }
    LDS_WAIT(); asm volatile("" ::: "memory");
}
struct Frame {
    LAS unsigned char* lds;
    volatile LAS unsigned* MISC;
    gu32* ctl;
    int tid, lane, wave;
    int vcu, G;
};
__device__ __forceinline__ float bf2f(bf16 b) { return __builtin_bit_cast(float, (unsigned)b << 16); }
__device__ __forceinline__ float wave_max(float v) {
#pragma unroll
    for (int o = 1; o < 64; o <<= 1) v = fmaxf(v, __shfl_xor(v, o));
    return v;
}
__device__ __forceinline__ float sigm(float x) { return 1.0f / (1.0f + __expf(-x)); }

__device__ __forceinline__ void p0_prologue(Frame& F, const float* x, const float* w_pre, const float* w_in, const float* w_br, const float* w_out,
                                            bf16* XN, bf16* WIN_T, bf16* WBA_T, bf16* WBB_T, bf16* WOUT_T) {
    LAS float* scr = (LAS float*)(F.lds + RING_OFF + F.wave * 16384);
    const int gw = F.vcu * NWAVES + F.wave, NGW = F.G * NWAVES;
    constexpr int I_IN = (D / 64) * (INC / 32), I_BR = (PW / 64) * (D / 32), I_OUT = (D / 64) * (D / 32);
    constexpr int NITEMS = I_IN + 2 * I_BR + I_OUT;
    for (int it = gw; it < NITEMS; it += NGW) {
        int r = it;
        if (r < I_IN) { p0_transpose_item(w_in, D, INC, WIN_T, 0, scr, r, F.lane); continue; } r -= I_IN;
        if (r < I_BR) { p0_transpose_item(w_br, PW, D, WBA_T, 0, scr, r, F.lane); continue; } r -= I_BR;
        if (r < I_BR) { p0_transpose_item(w_br + (size_t)PW * D, PW, D, WBB_T, 0, scr, r, F.lane); continue; } r -= I_BR;
        p0_transpose_item(w_out, D, D, WOUT_T, 0, scr, r, F.lane);
    }
    for (int m = gw; m < M; m += NGW) {
        const f32x4* xr = (const f32x4*)(x + (size_t)m * D) + F.lane;
        f32x4 v[8]; float s = 0.f;
#pragma unroll
        for (int j = 0; j < 8; ++j) { v[j] = xr[64 * j]; s += (v[j].x * v[j].x + v[j].y * v[j].y) + (v[j].z * v[j].z + v[j].w * v[j].w); }
        const float rstd = 1.0f / sqrtf(wave_sum(s) * (1.f / D) + EPS);
        unsigned long long* o8 = (unsigned long long*)(XN + (size_t)m * D) + F.lane;
#pragma unroll
        for (int j = 0; j < 8; ++j) { const f32x4 w = *((const f32x4*)w_pre + F.lane + 64 * j);
            o8[64 * j] = (unsigned long long)pk2(v[j].x * rstd * w.x, v[j].y * rstd * w.y) | ((unsigned long long)pk2(v[j].z * rstd * w.z, v[j].w * rstd * w.w) << 32); }
    }
}

__device__ __forceinline__ void na_naive(Frame& F, bf16* Q, const bf16* K, const bf16* V, const bf16* Z, const float* rpb) {
    const int gw = F.vcu * NWAVES + F.wave, NGW = F.G * NWAVES, lane = F.lane;
    for (int it = gw; it < M * NAH; it += NGW) {
        const int h = it & 15, tq = it >> 4, r = tq >> 6, c = tq & 63;
        int rs = r - 4; rs = rs < 0 ? 0 : (rs > GROWS - 8 ? GROWS - 8 : rs);
        int cs = c - 8; cs = cs < 0 ? 0 : (cs > GW - 16 ? GW - 16 : cs);
        const v4u* qp = (const v4u*)(Q + (size_t)tq * PW + h * NADH);
        v4u qv[8];
#pragma unroll
        for (int i = 0; i < 8; ++i) qv[i] = qp[i];
        float sc[2];
#pragma unroll
        for (int e = 0; e < 2; ++e) {
            const int j = lane + 64 * e, kr = rs + (j >> 4), kc = cs + (j & 15), tk = kr * GW + kc;
            const v4u* kp = (const v4u*)(K + (size_t)tk * PW + h * NADH);
            float a = 0.f;
#pragma unroll
            for (int i = 0; i < 8; ++i) { const v4u kv = kp[i];
                a += pg8::bf_lo(qv[i].x) * pg8::bf_lo(kv.x) + pg8::bf_hi(qv[i].x) * pg8::bf_hi(kv.x) + pg8::bf_lo(qv[i].y) * pg8::bf_lo(kv.y) + pg8::bf_hi(qv[i].y) * pg8::bf_hi(kv.y)
                   + pg8::bf_lo(qv[i].z) * pg8::bf_lo(kv.z) + pg8::bf_hi(qv[i].z) * pg8::bf_hi(kv.z) + pg8::bf_lo(qv[i].w) * pg8::bf_lo(kv.w) + pg8::bf_hi(qv[i].w) * pg8::bf_hi(kv.w); }
            sc[e] = a * 0.125f + rpb[(h * 15 + (kr - r + 7)) * 31 + (kc - c + 15)];
        }
        const float mx = wave_max(fmaxf(sc[0], sc[1]));
        const float e0 = __expf(sc[0] - mx), e1 = __expf(sc[1] - mx);
        const float inv = 1.0f / wave_sum(e0 + e1);
        const float p0 = e0 * inv, p1 = e1 * inv;
        float o = 0.f;
        for (int j = 0; j < 64; ++j) {
            const int kr = rs + (j >> 4), kc = cs + (j & 15), tk = kr * GW + kc;
            const float pa = __shfl(p0, j), pb = __shfl(p1, j);
            o += pa * bf2f(V[(size_t)tk * PW + h * NADH + lane]);
            o += pb * bf2f(V[(size_t)(tk + 4 * GW) * PW + h * NADH + lane]);
        }
        const float z = bf2f(Z[(size_t)tq * PW + h * NADH + lane]);
        o *= z * sigm(z);
        Q[(size_t)tq * PW + h * NADH + lane] = (bf16)f2bf(o);
    }
}

__device__ __forceinline__ void hg_naive(Frame& F, const bf16* HQ, const bf16* HFF, const bf16* HFB, const bf16* HI, const float* lb_logits, float* OFWD, float* OBWD) {
    LAS float* red = (LAS float*)(F.lds + RING_OFF);
    for (int u = blockIdx.x; u < 256; u += F.G) {
        const int hd = u >> 4, head = hd >> 1, dir = hd & 1, dv0 = (u & 15) * 8;
        const int dk = F.tid & 127, part = F.tid >> 7;
        const int ch = head * HGD + dk;
        const float lbv = sigm(lb_logits[dir * 1024 + ch] - lb_logits[2048 + dir * 1024 + ch]);
        const bf16* FL = dir ? HFB : HFF; float* OUT = dir ? OBWD : OFWD;
        const int cv = head * HGD + dv0 + part * 2;
        float S0 = 0.f, S1 = 0.f;
        for (int cb = 0; cb < M / 64; ++cb) {
            LAS float* rb = red + (cb & 1) * 1024;
#pragma unroll 8
            for (int s = 0; s < 64; ++s) {
                const int step = cb * 64 + s, t = dir ? (M - 1 - step) : step;
                const float fl = bf2f(FL[(size_t)t * PW + ch]), q = bf2f(HQ[(size_t)t * PW + ch]);
                const unsigned vv = *(const unsigned*)(HI + (size_t)t * PW + cv);
                const float v0 = pg8::bf_lo(vv), v1 = pg8::bf_hi(vv);
                const float sg = sigm(fl), f = lbv + (1.f - lbv) * sg, k = (1.f - lbv) * (1.f - sg);
                S0 = f * S0 + k * v0; S1 = f * S1 + k * v1;
                const float p0 = wave_sum(S0 * q), p1 = wave_sum(S1 * q);
                if (F.lane == 0) { rb[(s * 8 + F.wave) * 2] = p0; rb[(s * 8 + F.wave) * 2 + 1] = p1; }
            }
            __syncthreads();
            { const int s = F.tid >> 3, j = F.tid & 7, pp = j >> 1, e = j & 1;
              const int step = cb * 64 + s, t = dir ? (M - 1 - step) : step;
              OUT[(size_t)t * PW + head * HGD + dv0 + j] = rb[(s * 8 + 2 * pp) * 2 + e] + rb[(s * 8 + 2 * pp + 1) * 2 + e]; }
        }
        __syncthreads();
    }
}
constexpr int HG_IMQ = 0, HG_IMK = 16384, HG_IMV = 32768, HG_IMP = 49152, HG_PROW = 144, HG_IMS = HG_IMP + 64 * HG_PROW, HG_WTOT = HG_IMS + 8 * 4096, HG_EREF = HG_WTOT + 4096, HG_CSC = HG_EREF + 512, HG_LDS_END = HG_CSC + 512;
static_assert(HG_LDS_END <= RING_BYTES, "hg lds");
__device__ __forceinline__ unsigned off_b(unsigned row, unsigned ch) { return 256u * row + 16u * (ch ^ (((row & 3) << 2) | ((row >> 2) & 3))); }
typedef short s16x4 __attribute__((ext_vector_type(4)));
typedef float f32x2 __attribute__((ext_vector_type(2)));
__device__ __forceinline__ void tr_read4(unsigned a0, unsigned a1, unsigned a2, unsigned a3, s16x4& r0, s16x4& r1, s16x4& r2, s16x4& r3) {
    asm volatile("ds_read_b64_tr_b16 %0, %4\n\tds_read_b64_tr_b16 %1, %5\n\tds_read_b64_tr_b16 %2, %6\n\tds_read_b64_tr_b16 %3, %7\n\ts_waitcnt lgkmcnt(0)"
                 : "=&v"(r0), "=&v"(r1), "=&v"(r2), "=&v"(r3) : "v"(a0), "v"(a1), "v"(a2), "v"(a3) : "memory");
}
#define MFMA16(a, b, c) __builtin_amdgcn_mfma_f32_16x16x32_bf16((a), (b), (c), 0, 0, 0)
template <bool PRE>
__device__ __forceinline__ void hg_unit(Frame& F, int head, int dir, int c0, int nch, const bf16* HQ, const bf16* FL, const bf16* HI, const float* lb_logits,
                                        const float* S_in, float* S_out, float* Dseg_out, float* OUT) {
    LAS unsigned char* L = F.lds + RING_OFF;
    const unsigned lbase = (unsigned)(size_t)L;
    const int lane = F.lane, w = F.wave, n = lane & 15, g = lane >> 4, q4 = n >> 2, p4 = n & 3;
    const int chb = head * HGD;
    float lbv[2];
#pragma unroll
    for (int e = 0; e < 2; ++e) { const int ch = chb + 2 * lane + e; lbv[e] = sigm(lb_logits[dir * 1024 + ch] - lb_logits[2048 + dir * 1024 + ch]); }
    f32x4 S[8];
#pragma unroll
    for (int kt = 0; kt < 8; ++kt) {
        if (S_in) {
#pragma unroll
            for (int r = 0; r < 4; ++r) S[kt][r] = S_in[(size_t)(16 * kt + 4 * g + r) * HGD + 16 * w + n]; }
        else S[kt] = (f32x4){0.f, 0.f, 0.f, 0.f};
    }
    float dseg[2] = {0.f, 0.f};
    for (int ci = 0; ci < nch; ++ci) {
        const int c = dir ? (c0 + nch - 1 - ci) : (c0 + ci);
        float Aloc[8][2], kk[8][2], qq[8][2]; unsigned vraw[8];
        float run0 = 0.f, run1 = 0.f;
#pragma unroll
        for (int i = 0; i < 8; ++i) {
            const int tau = 8 * w + i, t = dir ? (64 * c + 63 - tau) : (64 * c + tau);
            const size_t o = (size_t)t * PW + chb + 2 * lane;
            const unsigned fw = *(const unsigned*)(FL + o), qw = *(const unsigned*)(HQ + o); vraw[i] = *(const unsigned*)(HI + o);
            const float f0 = pg8::bf_lo(fw), f1 = pg8::bf_hi(fw);
            const float s0 = pg8::sigmoidf_(f0), s1 = pg8::sigmoidf_(f1);
            const float g0 = __builtin_amdgcn_logf(lbv[0] + (1.f - lbv[0]) * s0), g1 = __builtin_amdgcn_logf(lbv[1] + (1.f - lbv[1]) * s1);
            kk[i][0] = (1.f - lbv[0]) * (1.f - s0); kk[i][1] = (1.f - lbv[1]) * (1.f - s1);
            qq[i][0] = pg8::bf_lo(qw); qq[i][1] = pg8::bf_hi(qw);
            run0 += g0; run1 += g1; Aloc[i][0] = run0; Aloc[i][1] = run1;
        }
        LAS float* WT = (LAS float*)(L + HG_WTOT);
        *(LAS f32x2*)(WT + w * 128 + 2 * lane) = (f32x2){run0, run1};
        __syncthreads();
        float pre0 = 0.f, pre1 = 0.f, ref0 = 0.f, ref1 = 0.f, tot0 = 0.f, tot1 = 0.f;
#pragma unroll
        for (int ww = 0; ww < 8; ++ww) { const f32x2 tv = *(LAS f32x2*)(WT + ww * 128 + 2 * lane);
            if (ww < w) { pre0 += tv.x; pre1 += tv.y; } if (ww < 4) { ref0 += tv.x; ref1 += tv.y; } tot0 += tv.x; tot1 += tv.y; }
        dseg[0] += tot0; dseg[1] += tot1;
#pragma unroll
        for (int i = 0; i < 8; ++i) {
            const int tau = 8 * w + i;
            const float d0 = pre0 + Aloc[i][0] - ref0, d1 = pre1 + Aloc[i][1] - ref1;
            const float qm0 = qq[i][0] * __builtin_amdgcn_exp2f(d0), qm1 = qq[i][1] * __builtin_amdgcn_exp2f(d1);
            const float km0 = kk[i][0] * __builtin_amdgcn_exp2f(fminf(-d0, 120.f)), km1 = kk[i][1] * __builtin_amdgcn_exp2f(fminf(-d1, 120.f));
            const unsigned ob = off_b(tau, lane >> 2) + (lane & 3) * 4;
            *(LAS unsigned*)(L + HG_IMQ + ob) = pk2(qm0, qm1);
            *(LAS unsigned*)(L + HG_IMK + ob) = pk2(km0, km1);
            *(LAS unsigned*)(L + HG_IMV + ob) = vraw[i];
        }
        if (w == 0) { *(LAS f32x2*)((LAS float*)(L + HG_EREF) + 2 * lane) = (f32x2){__builtin_amdgcn_exp2f(ref0), __builtin_amdgcn_exp2f(ref1)};
                      *(LAS f32x2*)((LAS float*)(L + HG_CSC) + 2 * lane) = (f32x2){__builtin_amdgcn_exp2f(tot0 - ref0), __builtin_amdgcn_exp2f(tot1 - ref1)}; }
        __syncthreads();
        if (!PRE) {
            const int tt = w >> 1;
            pg8::bf16x8 bq[4];
#pragma unroll
            for (int ks = 0; ks < 4; ++ks) bq[ks] = *(const LAS pg8::bf16x8*)(L + HG_IMQ + off_b(16 * tt + n, 4 * ks + g));
#pragma unroll
            for (int si = 0; si < 2; ++si) { const int st = 2 * (w & 1) + si;
                f32x4 pacc = (f32x4){0.f, 0.f, 0.f, 0.f};
#pragma unroll
                for (int ks = 0; ks < 4; ++ks) { const pg8::bf16x8 ak = *(const LAS pg8::bf16x8*)(L + HG_IMK + off_b(16 * st + n, 4 * ks + g)); pacc = MFMA16(ak, bq[ks], pacc); }
                const int tcol = 16 * tt + n, srow = 16 * st + 4 * g;
                float pv[4];
#pragma unroll
                for (int r = 0; r < 4; ++r) pv[r] = (srow + r <= tcol) ? pacc[r] : 0.f;
                *(LAS unsigned long long*)(L + HG_IMP + tcol * HG_PROW + srow * 2) = (unsigned long long)pk2(pv[0], pv[1]) | ((unsigned long long)pk2(pv[2], pv[3]) << 32);
            }
        }
#pragma unroll
        for (int kt = 0; kt < 8; ++kt) { const f32x4 e4 = *(const LAS f32x4*)((LAS float*)(L + HG_EREF) + 16 * kt + 4 * g);
            S[kt] = S[kt] * e4;
            if (!PRE) *(LAS unsigned long long*)(L + HG_IMS + w * 4096 + off_b(n, 2 * kt + (g >> 1)) + 8 * (g & 1)) = (unsigned long long)pk2(S[kt][0], S[kt][1]) | ((unsigned long long)pk2(S[kt][2], S[kt][3]) << 32);
        }
        pg8::bf16x8 vf[2];
        { s16x4 r0, r1, r2, r3;
          tr_read4(lbase + HG_IMV + off_b(8 * g + q4, 2 * w + (p4 >> 1)) + 8 * (p4 & 1), lbase + HG_IMV + off_b(8 * g + 4 + q4, 2 * w + (p4 >> 1)) + 8 * (p4 & 1),
                   lbase + HG_IMV + off_b(32 + 8 * g + q4, 2 * w + (p4 >> 1)) + 8 * (p4 & 1), lbase + HG_IMV + off_b(32 + 8 * g + 4 + q4, 2 * w + (p4 >> 1)) + 8 * (p4 & 1), r0, r1, r2, r3);
          vf[0] = __builtin_shufflevector(r0, r1, 0, 1, 2, 3, 4, 5, 6, 7); vf[1] = __builtin_shufflevector(r2, r3, 0, 1, 2, 3, 4, 5, 6, 7); }
        if (!PRE) {
            __syncthreads();
            pg8::bf16x8 sf[4];
#pragma unroll
            for (int ks = 0; ks < 4; ++ks) sf[ks] = *(const LAS pg8::bf16x8*)(L + HG_IMS + w * 4096 + off_b(n, 4 * ks + g));
#pragma unroll
            for (int tt = 0; tt < 4; ++tt) {
                f32x4 oacc = (f32x4){0.f, 0.f, 0.f, 0.f};
#pragma unroll
                for (int ks = 0; ks < 2; ++ks) { if (32 * ks > 16 * tt + 15) continue;
                    const pg8::bf16x8 pf = *(const LAS pg8::bf16x8*)(L + HG_IMP + (16 * tt + n) * HG_PROW + (32 * ks + 8 * g) * 2); oacc = MFMA16(pf, vf[ks], oacc); }
#pragma unroll
                for (int ks = 0; ks < 4; ++ks) { const pg8::bf16x8 qf = *(const LAS pg8::bf16x8*)(L + HG_IMQ + off_b(16 * tt + n, 4 * ks + g)); oacc = MFMA16(qf, sf[ks], oacc); }
#pragma unroll
                for (int r = 0; r < 4; ++r) { const int tau = 16 * tt + 4 * g + r, t = dir ? (64 * c + 63 - tau) : (64 * c + tau);
                    OUT[(size_t)t * PW + chb + 16 * w + n] = oacc[r]; }
            }
        }
#pragma unroll
        for (int kt = 0; kt < 8; ++kt) {
            s16x4 r0, r1, r2, r3;
            tr_read4(lbase + HG_IMK + off_b(8 * g + q4, 2 * kt + (p4 >> 1)) + 8 * (p4 & 1), lbase + HG_IMK + off_b(8 * g + 4 + q4, 2 * kt + (p4 >> 1)) + 8 * (p4 & 1),
                     lbase + HG_IMK + off_b(32 + 8 * g + q4, 2 * kt + (p4 >> 1)) + 8 * (p4 & 1), lbase + HG_IMK + off_b(32 + 8 * g + 4 + q4, 2 * kt + (p4 >> 1)) + 8 * (p4 & 1), r0, r1, r2, r3);
            const pg8::bf16x8 k0 = __builtin_shufflevector(r0, r1, 0, 1, 2, 3, 4, 5, 6, 7), k1 = __builtin_shufflevector(r2, r3, 0, 1, 2, 3, 4, 5, 6, 7);
            S[kt] = MFMA16(k0, vf[0], S[kt]); S[kt] = MFMA16(k1, vf[1], S[kt]);
            const f32x4 c4 = *(const LAS f32x4*)((LAS float*)(L + HG_CSC) + 16 * kt + 4 * g);
            S[kt] = S[kt] * c4;
        }
    }
    __syncthreads();
    if (S_out) {
#pragma unroll
        for (int kt = 0; kt < 8; ++kt)
#pragma unroll
            for (int r = 0; r < 4; ++r) S_out[(size_t)(16 * kt + 4 * g + r) * HGD + 16 * w + n] = S[kt][r];
    }
    if (Dseg_out && w == 0) { Dseg_out[2 * lane] = dseg[0]; Dseg_out[2 * lane + 1] = dseg[1]; }
}

__device__ __forceinline__ void hg_finish(Frame& F, const float* OFWD, const float* OBWD, const bf16* HZ, const float* w, bf16* OB) {
    const int gw = F.vcu * NWAVES + F.wave, NGW = F.G * NWAVES, lane = F.lane;
    for (int m = gw; m < M; m += NGW) {
        const f32x4* a = (const f32x4*)(OFWD + (size_t)m * PW) + lane * 4; const f32x4* b = (const f32x4*)(OBWD + (size_t)m * PW) + lane * 4;
        f32x4 o[4]; float ss = 0.f;
#pragma unroll
        for (int i = 0; i < 4; ++i) { o[i] = a[i] + b[i]; ss += (o[i].x * o[i].x + o[i].y * o[i].y) + (o[i].z * o[i].z + o[i].w * o[i].w); }
        ss += __shfl_xor(ss, 1); ss += __shfl_xor(ss, 2); ss += __shfl_xor(ss, 4);
        const float rstd = 1.0f / sqrtf(ss * (1.f / HGD) + EPS);
        const v4u* zp = (const v4u*)(HZ + (size_t)m * PW) + lane * 2; v4u* op = (v4u*)(OB + (size_t)m * PW) + lane * 2;
#pragma unroll
        for (int hh = 0; hh < 2; ++hh) { const v4u zz = zp[hh]; const f32x4 w0 = *((const f32x4*)w + lane * 4 + hh * 2), w1 = *((const f32x4*)w + lane * 4 + hh * 2 + 1);
            const f32x4 o0 = o[hh * 2], o1 = o[hh * 2 + 1];
            float zf[8] = {pg8::bf_lo(zz.x), pg8::bf_hi(zz.x), pg8::bf_lo(zz.y), pg8::bf_hi(zz.y), pg8::bf_lo(zz.z), pg8::bf_hi(zz.z), pg8::bf_lo(zz.w), pg8::bf_hi(zz.w)};
            float r[8] = {o0.x * w0.x, o0.y * w0.y, o0.z * w0.z, o0.w * w0.w, o1.x * w1.x, o1.y * w1.y, o1.z * w1.z, o1.w * w1.w};
#pragma unroll
            for (int i = 0; i < 8; ++i) r[i] = r[i] * rstd * zf[i] * sigm(zf[i]);
            v4u ow; ow.x = pk2(r[0], r[1]); ow.y = pk2(r[2], r[3]); ow.z = pk2(r[4], r[5]); ow.w = pk2(r[6], r[7]); op[hh] = ow; }
    }
}
__device__ __forceinline__ void final_phase(Frame& F, const float* x, const bf16* Zb, const float* ssq, const float* w, float* out) {
    const int gw = F.vcu * NWAVES + F.wave, NGW = F.G * NWAVES, lane = F.lane;
    for (int m = gw; m < M; m += NGW) {
        const float part = lane < 32 ? ssq[(size_t)m * 32 + lane] : 0.f;
        const float rstd = 1.0f / sqrtf(wave_sum(part) * (1.f / D) + EPS);
        const f32x4* xr = (const f32x4*)(x + (size_t)m * D) + lane; f32x4* orow = (f32x4*)(out + (size_t)m * D) + lane;
        const unsigned long long* zr = (const unsigned long long*)(Zb + (size_t)m * D) + lane;
#pragma unroll
        for (int j = 0; j < 8; ++j) { const f32x4 xv = xr[64 * j]; const unsigned long long zz = zr[64 * j]; const f32x4 wv = *((const f32x4*)w + lane + 64 * j);
            const unsigned lo = (unsigned)zz, hi = (unsigned)(zz >> 32);
            f32x4 o; o.x = xv.x + pg8::bf_lo(lo) * rstd * wv.x; o.y = xv.y + pg8::bf_hi(lo) * rstd * wv.y; o.z = xv.z + pg8::bf_lo(hi) * rstd * wv.z; o.w = xv.w + pg8::bf_hi(hi) * rstd * wv.w;
            orow[64 * j] = o; }
    }
}
struct Args { const float* in[10]; float* out; unsigned char* ws; int ph_lo, ph_hi, li, pad; };
constexpr int N_PHASES = 9;
__global__ void __launch_bounds__(NWAVES * 64, 2) fwd_kernel(Args args) {
    extern __shared__ __attribute__((aligned(16))) unsigned char lds[];
    Frame F;
    F.lds = (LAS unsigned char*)lds;
    F.MISC = (volatile LAS unsigned*)(F.lds + MISC_OFF);
    F.tid = threadIdx.x; F.lane = F.tid & 63; F.wave = __builtin_amdgcn_readfirstlane(F.tid >> 6);
    F.G = gridDim.x; { const int bx = blockIdx.x; F.vcu = (F.G % 8 == 0) ? (bx % 8) * (F.G / 8) + bx / 8 : bx; }
    unsigned char* ws = args.ws;
    F.ctl = (gu32*)(ws + WS_CTL);
    const float* x = args.in[0]; const float* w_pre = args.in[1]; const float* w_in = args.in[2]; const float* b_gate = args.in[3]; const float* rpb = args.in[4];
    const float* lb_logits = args.in[5]; const float* hg_norm_w = args.in[6]; const float* w_br = args.in[7]; const float* w_out = args.in[8]; const float* w_post = args.in[9];
    bf16* WIN_T = (bf16*)(ws + WS_WIN); bf16* WBA_T = (bf16*)(ws + WS_WBA); bf16* WBB_T = (bf16*)(ws + WS_WBB); bf16* WOUT_T = (bf16*)(ws + WS_WOUT);
    bf16* H = (bf16*)(ws + WS_H);
    float* SSQ = (float*)(ws + WS_SSQ);
    bf16* XN = (bf16*)args.out;
    float* OFWD = args.out; float* OBWD = args.out + (size_t)M * PW;
    bf16* OA = H + P_NQ * PIECE_ELEMS; bf16* OB = H + P_HQ * PIECE_ELEMS; bf16* YA = H + P_NK * PIECE_ELEMS; bf16* Y = H + P_HFF * PIECE_ELEMS; bf16* Zb = H + P_HI * PIECE_ELEMS;
    for (int u = F.tid; u < (LDS_BYTES - LDSCTL_OFF) / 4; u += NWAVES * 64) ((LAS unsigned*)(F.lds + LDSCTL_OFF))[u] = 0u;
    __syncthreads();
    XcdBarrier bar = xcd_barrier_post((unsigned*)(F.ctl + CW_BAR) + args.li * XCD_BAR_WORDS, F.MISC + 8);
    const int lo = args.ph_lo, hi = args.ph_hi;
#define IN(k) (lo <= (k) && (k) < hi)
#define BOTH(k) (IN(k) && IN((k) + 1))
#define GRID_BAR() xcd_barrier(bar)

    if (IN(0)) { p0_prologue(F, x, w_pre, w_in, w_br, w_out, XN, WIN_T, WBA_T, WBB_T, WOUT_T); if (BOTH(0)) GRID_BAR(); }
    if (IN(1)) {
        pg8::Gemm g{XN, WIN_T, M, INC, D}; pg8::StaticOrder S; S.init(M, INC, F.G, (int)blockIdx.x);
        pg8::EpiBf16 E{H, PW, PW, PIECE_ELEMS, 1.0f};
        pg8::gemm_phase<pg8::EpiBf16, pg8::StaticOrder, true, true>(F.lds + RING_OFF, g, S, E);
        if (BOTH(1)) GRID_BAR();
    }
    float* SLOC = (float*)(ws + WS_SLOC); float* DSEG = (float*)(ws + WS_DSEG);
    if (IN(2)) {
        for (int u = blockIdx.x; u < 16 * HG_NSEG; u += F.G) { const int hd = u / HG_NSEG, j = u % HG_NSEG, head = hd >> 1, dir = hd & 1;
            const int c0 = dir ? (M / 64 - HG_SEGC * (j + 1)) : HG_SEGC * j;
            hg_unit<true>(F, head, dir, c0, HG_SEGC, H + P_HQ * PIECE_ELEMS, H + (dir ? P_HFB : P_HFF) * PIECE_ELEMS, H + P_HI * PIECE_ELEMS, lb_logits, nullptr,
                          SLOC + (size_t)u * HGD * HGD, DSEG + (size_t)u * HGD, nullptr); }
        na_naive(F, H + P_NQ * PIECE_ELEMS, H + P_NK * PIECE_ELEMS, H + P_NV * PIECE_ELEMS, H + P_NZ * PIECE_ELEMS, rpb);
        if (BOTH(2)) GRID_BAR();
    }
    if (IN(3)) {
        for (int e = F.vcu * NWAVES * 64 + F.tid; e < 16 * HGD * HGD; e += F.G * NWAVES * 64) { const int hd = e / (HGD * HGD), el = e % (HGD * HGD), dk = el / HGD;
            float* sp = SLOC + (size_t)hd * HG_NSEG * HGD * HGD + el; const float* dp = DSEG + (size_t)hd * HG_NSEG * HGD + dk; float S = 0.f;
#pragma unroll 8
            for (int j = 0; j < HG_NSEG; ++j) { const float Lc = sp[(size_t)j * HGD * HGD]; sp[(size_t)j * HGD * HGD] = S; S = __builtin_amdgcn_exp2f(dp[j * HGD]) * S + Lc; } }
        if (BOTH(3)) GRID_BAR();
    }
    if (IN(4)) {
        for (int u = blockIdx.x; u < 16 * HG_NSEG; u += F.G) { const int hd = u / HG_NSEG, j = u % HG_NSEG, head = hd >> 1, dir = hd & 1;
            const int c0 = dir ? (M / 64 - HG_SEGC * (j + 1)) : HG_SEGC * j;
            hg_unit<false>(F, head, dir, c0, HG_SEGC, H + P_HQ * PIECE_ELEMS, H + (dir ? P_HFB : P_HFF) * PIECE_ELEMS, H + P_HI * PIECE_ELEMS, lb_logits,
                           SLOC + (size_t)u * HGD * HGD, nullptr, nullptr, dir ? OBWD : OFWD); }
        if (BOTH(4)) GRID_BAR();
    }
    if (IN(5)) { hg_finish(F, OFWD, OBWD, H + P_HZ * PIECE_ELEMS, hg_norm_w, OB); if (BOTH(5)) GRID_BAR(); }
    if (IN(6)) {
        { pg8::Gemm g{OA, WBA_T, M, D, PW}; pg8::StaticOrder S; S.init(M, D, F.G, (int)blockIdx.x);
          pg8::EpiGate<false> E{H + P_GA * PIECE_ELEMS, PIECE_ELEMS, b_gate, nullptr, YA, D};
          pg8::gemm_phase<pg8::EpiGate<false>, pg8::StaticOrder, true, true>(F.lds + RING_OFF, g, S, E); }
        { pg8::Gemm g{OB, WBB_T, M, D, PW}; pg8::StaticOrder S; S.init(M, D, F.G, (int)blockIdx.x);
          pg8::EpiGate<true> E{H + P_GB * PIECE_ELEMS, PIECE_ELEMS, b_gate + D, YA, Y, D};
          pg8::gemm_phase<pg8::EpiGate<true>, pg8::StaticOrder, true, true>(F.lds + RING_OFF, g, S, E); }
        if (BOTH(6)) GRID_BAR();
    }
    if (IN(7)) {
        pg8::Gemm g{Y, WOUT_T, M, D, D}; pg8::StaticOrder S; S.init(M, D, F.G, (int)blockIdx.x);
        pg8::EpiSsq E{Zb, D, SSQ};
        pg8::gemm_phase<pg8::EpiSsq, pg8::StaticOrder, true, true>(F.lds + RING_OFF, g, S, E);
        if (BOTH(7)) GRID_BAR();
    }
    if (IN(8)) { final_phase(F, x, Zb, SSQ, w_post, args.out); }
#undef IN
#undef BOTH
}

#ifndef MK_N_LAUNCHES
#define MK_N_LAUNCHES 1
#endif
extern "C" void kernel_launch(void* const* d_in, const int* in_sizes, int n_in, void* d_out, int out_size, void* d_ws, size_t ws_size, hipStream_t stream) {
    static int grid = 0;
    if (grid == 0) {
        if (n_in != 10 || in_sizes[0] != M * D || out_size != M * D || ws_size < WS_END) { fprintf(stderr, "kernel_launch: unexpected shapes: n_in %d in0 %d out %d ws %zu (need %zu)\n", n_in, n_in > 0 ? in_sizes[0] : -1, out_size, ws_size, (size_t)WS_END); grid = -1; return; }
        int dev = 0, cus = 0, per_cu = 0;
        if (hipGetDevice(&dev) != hipSuccess || hipDeviceGetAttribute(&cus, hipDeviceAttributeMultiprocessorCount, dev) != hipSuccess) { fprintf(stderr, "kernel_launch: device query failed\n"); grid = -1; return; }
        if (hipFuncSetAttribute((const void*)fwd_kernel, hipFuncAttributeMaxDynamicSharedMemorySize, LDS_BYTES) != hipSuccess) { fprintf(stderr, "kernel_launch: hipFuncSetAttribute failed\n"); grid = -1; return; }
        if (hipOccupancyMaxActiveBlocksPerMultiprocessor(&per_cu, (const void*)fwd_kernel, NWAVES * 64, LDS_BYTES) != hipSuccess || per_cu < 1) { fprintf(stderr, "kernel_launch: occupancy query reports %d blocks/CU; nothing launched\n", per_cu); (void)hipGetLastError(); grid = -1; return; }
        grid = cus;
    }
    if (grid < 0) return;
    if (hipMemsetAsync((char*)d_ws + WS_CTL, 0, CTL_ZERO_BYTES, stream) != hipSuccess) { fprintf(stderr, "kernel_launch: memset failed\n"); return; }
    Args a{};
    for (int i = 0; i < 10; ++i) a.in[i] = (const float*)d_in[i];
    a.out = (float*)d_out; a.ws = (unsigned char*)d_ws;
#if MK_N_LAUNCHES == 1
    a.ph_lo = 0; a.ph_hi = N_PHASES; a.li = 0;
    hipLaunchKernelGGL(fwd_kernel, dim3(grid), dim3(NWAVES * 64), LDS_BYTES, stream, a);
#else
    for (int li = 0; li < N_PHASES; ++li) { a.ph_lo = li; a.ph_hi = li + 1; a.li = li;
        hipLaunchKernelGGL(fwd_kernel, dim3(grid), dim3(NWAVES * 64), LDS_BYTES, stream, a); }
#endif
    const hipError_t le = hipPeekAtLastError();
    if (le != hipSuccess) fprintf(stderr, "kernel_launch: launch failed: %s\n", hipGetErrorName(le));
}
```

```cpp
#include <hip/hip_runtime.h>
#include <cstdio>
#include <cstdint>
namespace pg8 {
#define PG8_LAS __attribute__((address_space(3)))
typedef unsigned short bf16_t;
typedef short bf16x8 __attribute__((ext_vector_type(8)));
typedef float f32x4 __attribute__((ext_vector_type(4)));
typedef unsigned u32x4 __attribute__((ext_vector_type(4)));
constexpr int BM = 256, BK = 64, HALF = 128, HTB = HALF * BK * 2  , STAGE_BYTES = 8 * HTB, NXCD = 8, WGM = 8;

__host__ __device__ __forceinline__ int lds_byte(int r, int c) { const int st = (r >> 4) * 2 + (c >> 5), rr = r & 15, cc = c & 31, ob = rr * 64 + cc * 2; return st * 1024 + (ob ^ (((ob >> 9) & 1) << 5)); }
__host__ __device__ __forceinline__ void stage_rc(int b, int& R, int& C) { const int st = b / 1024, sb = b % 1024, swz = sb ^ (((sb >> 9) & 1) << 5); R = (st >> 1) * 16 + swz / 64; C = (st & 1) * 32 + (swz % 64) / 2; }
__host__ __device__ __forceinline__ int perm32(int rho) { const int n = rho >> 4, i = rho & 15; return 8 * (i >> 2) + 4 * n + (i & 3); }

struct Unit { int pm, pn; };
struct Gemm { const bf16_t* A; const bf16_t* Bt; int M, N, K; };

struct StaticOrder {
    int nM, nN, nwg, G, c;
    __host__ __device__ void init(int M, int N, int G_, int c_) { nM = M / BM; nN = N / BM; nwg = nM * nN; G = G_; c = c_; }
    __host__ __device__ bool next(int i, Unit& u) const {
        const long L = (long)i * G + c; if (L >= nwg) return false;
        int wgid = (int)L; { const int q = nwg / NXCD, r = nwg % NXCD, xcd = wgid % NXCD, off = wgid / NXCD; wgid = (xcd < r ? xcd * (q + 1) : r * (q + 1) + (xcd - r) * q) + off; }
        const int nig = WGM * nN, gid = wgid / nig, fm = gid * WGM, gsz = (nM - fm) < WGM ? (nM - fm) : WGM;
        u.pm = fm + ((wgid % nig) % gsz); u.pn = (wgid % nig) / gsz; return true;
    }
    __device__ __forceinline__ void a_ready(const Unit&) const {}
    __device__ __forceinline__ void done(const Unit&) const {}
};

__device__ __forceinline__ unsigned cvt_pk_bf16(float lo, float hi) { unsigned r; asm volatile("v_cvt_pk_bf16_f32 %0, %1, %2" : "=v"(r) : "v"(lo), "v"(hi)); return r; }
typedef float f32x2 __attribute__((ext_vector_type(2)));
struct EpiBf16 {
    static constexpr bool PERM = true, AFTER_DRAIN = false;
    bf16_t* O; int ldc; int split_cols; size_t split_stride; float scale0;
    __device__ __forceinline__ void operator()(const f32x4 (&acc)[2][2][4][2], const Unit& u, int wr, int wc, int fr, int fq) const {
        const int row0 = u.pm * BM + wr * 64 + fr; int colt = u.pn * BM; bf16_t* base = O;
        float sc = 1.f; if (split_cols) { const int t = colt / split_cols; base += (size_t)t * split_stride; colt -= t * split_cols; if (t == 0) sc = scale0; }
        const int col0 = colt + wc * 32 + 8 * fq;
#pragma unroll
        for (int ai = 0; ai < 2; ++ai)
#pragma unroll
            for (int m = 0; m < 4; ++m) { bf16_t* rowp = base + (size_t)(row0 + ai * HALF + m * 16) * ldc + col0;
#pragma unroll
                for (int bj = 0; bj < 2; ++bj) { f32x4 v0 = acc[ai][bj][m][0] * sc, v1 = acc[ai][bj][m][1] * sc;
                    u32x4 w; w.x = cvt_pk_bf16(v0[0], v0[1]); w.y = cvt_pk_bf16(v0[2], v0[3]); w.z = cvt_pk_bf16(v1[0], v1[1]); w.w = cvt_pk_bf16(v1[2], v1[3]);
                    *(u32x4*)(rowp + bj * HALF) = w; } }
    }
};
__device__ __forceinline__ float bf_lo(unsigned w) { return __builtin_bit_cast(float, w << 16); }
__device__ __forceinline__ float bf_hi(unsigned w) { return __builtin_bit_cast(float, w & 0xffff0000u); }
__device__ __forceinline__ float sigmoidf_(float x) { return __builtin_amdgcn_rcpf(1.0f + __builtin_amdgcn_exp2f(-1.44269504089f * x)); }
template <bool ADD> struct EpiGate {
    static constexpr bool PERM = true, AFTER_DRAIN = false;
    const bf16_t* G; size_t piece_stride; const float* bg; const bf16_t* prev; bf16_t* O; int ldc;
    __device__ __forceinline__ void operator()(const f32x4 (&acc)[2][2][4][2], const Unit& u, int wr, int wc, int fr, int fq) const {
        const int row0 = u.pm * BM + wr * 64 + fr; const int col0 = u.pn * BM + wc * 32 + 8 * fq;
        f32x4 bv[2][2];
#pragma unroll
        for (int bj = 0; bj < 2; ++bj)
#pragma unroll
            for (int n = 0; n < 2; ++n) bv[bj][n] = *(const f32x4*)(bg + col0 + bj * HALF + 4 * n);
#pragma unroll
        for (int ai = 0; ai < 2; ++ai)
#pragma unroll
            for (int m = 0; m < 4; ++m) { const int row = row0 + ai * HALF + m * 16;
#pragma unroll
                for (int bj = 0; bj < 2; ++bj) { const int col = col0 + bj * HALF;
                    const u32x4 gw = *(const u32x4*)(G + (size_t)(col >> 10) * piece_stride + (size_t)row * 1024 + (col & 1023));
                    f32x4 v0 = acc[ai][bj][m][0], v1 = acc[ai][bj][m][1];
                    v0[0] *= sigmoidf_(bf_lo(gw.x) + bv[bj][0][0]); v0[1] *= sigmoidf_(bf_hi(gw.x) + bv[bj][0][1]);
                    v0[2] *= sigmoidf_(bf_lo(gw.y) + bv[bj][0][2]); v0[3] *= sigmoidf_(bf_hi(gw.y) + bv[bj][0][3]);
                    v1[0] *= sigmoidf_(bf_lo(gw.z) + bv[bj][1][0]); v1[1] *= sigmoidf_(bf_hi(gw.z) + bv[bj][1][1]);
                    v1[2] *= sigmoidf_(bf_lo(gw.w) + bv[bj][1][2]); v1[3] *= sigmoidf_(bf_hi(gw.w) + bv[bj][1][3]);
                    if (ADD) { const u32x4 pw = *(const u32x4*)(prev + (size_t)row * ldc + col);
                        v0[0] += bf_lo(pw.x); v0[1] += bf_hi(pw.x); v0[2] += bf_lo(pw.y); v0[3] += bf_hi(pw.y);
                        v1[0] += bf_lo(pw.z); v1[1] += bf_hi(pw.z); v1[2] += bf_lo(pw.w); v1[3] += bf_hi(pw.w); }
                    u32x4 w; w.x = cvt_pk_bf16(v0[0], v0[1]); w.y = cvt_pk_bf16(v0[2], v0[3]); w.z = cvt_pk_bf16(v1[0], v1[1]); w.w = cvt_pk_bf16(v1[2], v1[3]);
                    *(u32x4*)(O + (size_t)row * ldc + col) = w; }
                asm volatile("" ::: "memory"); }
    }
};
struct EpiSsq {
    static constexpr bool PERM = true, AFTER_DRAIN = false;
    bf16_t* O; int ldc; float* ssq;
    __device__ __forceinline__ void operator()(const f32x4 (&acc)[2][2][4][2], const Unit& u, int wr, int wc, int fr, int fq) const {
        const int row0 = u.pm * BM + wr * 64 + fr; const int col0 = u.pn * BM + wc * 32 + 8 * fq;
#pragma unroll
        for (int ai = 0; ai < 2; ++ai)
#pragma unroll
            for (int m = 0; m < 4; ++m) { const int row = row0 + ai * HALF + m * 16; float ss = 0.f;
#pragma unroll
                for (int bj = 0; bj < 2; ++bj) { const f32x4 v0 = acc[ai][bj][m][0], v1 = acc[ai][bj][m][1];
                    ss += (v0[0] * v0[0] + v0[1] * v0[1]) + (v0[2] * v0[2] + v0[3] * v0[3]) + (v1[0] * v1[0] + v1[1] * v1[1]) + (v1[2] * v1[2] + v1[3] * v1[3]);
                    u32x4 w; w.x = cvt_pk_bf16(v0[0], v0[1]); w.y = cvt_pk_bf16(v0[2], v0[3]); w.z = cvt_pk_bf16(v1[0], v1[1]); w.w = cvt_pk_bf16(v1[2], v1[3]);
                    *(u32x4*)(O + (size_t)row * ldc + col0 + bj * HALF) = w; }
                ss += __shfl_xor(ss, 16); ss += __shfl_xor(ss, 32);
                if (fq == 0) ssq[(size_t)row * 32 + u.pn * 4 + wc] = ss; }
    }
};

template <class Epi, class Sched, bool ALIGN_EPI = false, bool SP2 = false>
__device__ __forceinline__ void gemm_phase(PG8_LAS unsigned char* lds, const Gemm g, const Sched& S, const Epi& E) {
    const int tid = threadIdx.x, wid = __builtin_amdgcn_readfirstlane(tid >> 6), lane = tid & 63, wr = wid >> 2, wc = wid & 3, fr = lane & 15, fq = lane >> 4;
    const int K = g.K, nt = K / BK;
    unsigned voffA[2], voffB[2];
#pragma unroll
    for (int i = 0; i < 2; ++i) { int R, C; stage_rc(tid * 16 + i * 8192, R, C); const int Rb = Epi::PERM ? ((R & ~31) + perm32(R & 31)) : R;
        voffA[i] = (unsigned)(R * K + C) * 2u; voffB[i] = (unsigned)(Rb * K + C) * 2u; }
    const size_t kstep = (size_t)(BK * 2);
    const size_t hstep = (size_t)HALF * K * 2;
    const size_t tstep = 2 * hstep;
    const unsigned ldsw = (unsigned)wid * 1024u;
    const int aoff = lds_byte(wr * 64 + fr, fq * 8), boff = lds_byte(wc * 32 + fr, fq * 8);
#define PG8_SA(b, h) (((b) * 2 + (h)) * HTB)
#define PG8_SB(b, h) ((4 + (b) * 2 + (h)) * HTB)
#define PG8_STAGE(bufoff, gbase, voff) do { _Pragma("unroll") for (int _i = 0; _i < 2; ++_i) \
        __builtin_amdgcn_global_load_lds((const unsigned*)((const char*)(gbase) + (voff)[_i]), (PG8_LAS unsigned*)(lds + (bufoff) + ldsw + _i * 8192), 16, 0, 0); } while (0)
#define PG8_LDA(dst, b, h) do { _Pragma("unroll") for (int m = 0; m < 4; ++m) _Pragma("unroll") for (int k = 0; k < 2; ++k) dst[m][k] = *(const PG8_LAS bf16x8*)(lds + PG8_SA(b, h) + aoff + m * 2048 + k * 1024); } while (0)
#define PG8_LDB(dst, b, h) do { _Pragma("unroll") for (int n = 0; n < 2; ++n) _Pragma("unroll") for (int k = 0; k < 2; ++k) dst[n][k] = *(const PG8_LAS bf16x8*)(lds + PG8_SB(b, h) + boff + n * 2048 + k * 1024); } while (0)
#define PG8_MMA(ai, bj, At, Bt) do { __builtin_amdgcn_s_setprio(1); _Pragma("unroll") for (int m = 0; m < 4; ++m) _Pragma("unroll") for (int n = 0; n < 2; ++n) _Pragma("unroll") for (int k = 0; k < 2; ++k) \
        acc[ai][bj][m][n] = __builtin_amdgcn_mfma_f32_16x16x32_bf16(Bt[n][k], At[m][k], acc[ai][bj][m][n], 0, 0, 0); __builtin_amdgcn_s_setprio(0); } while (0)
#define PG8_WAIT_V(n) asm volatile("s_waitcnt vmcnt(" #n ")" ::: "memory")
#define PG8_WAIT_L(n) asm volatile("s_waitcnt lgkmcnt(" #n ")" ::: "memory")
#define PG8_BAR __builtin_amdgcn_s_barrier()
#define PG8_SCHED __builtin_amdgcn_sched_barrier(0)
    Unit cur, nxt; int ui = 0;
    if (!S.next(0, cur)) return;
    f32x4 acc[2][2][4][2];
#pragma unroll
    for (int a = 0; a < 2; ++a)
#pragma unroll
        for (int b = 0; b < 2; ++b)
#pragma unroll
            for (int m = 0; m < 4; ++m)
#pragma unroll
                for (int n = 0; n < 2; ++n) acc[a][b][m][n] = (f32x4){0.f, 0.f, 0.f, 0.f};
    bf16x8 At[4][2], B0[2][2], B1[2][2];
    const char* cA = (const char*)g.A + (size_t)cur.pm * tstep; const char* cB = (const char*)g.Bt + (size_t)cur.pn * tstep;
    S.a_ready(cur);
    if constexpr (SP2) {
        PG8_STAGE(PG8_SB(0, 0), cB, voffB); PG8_STAGE(PG8_SB(0, 1), cB + hstep, voffB); PG8_STAGE(PG8_SA(0, 0), cA, voffA); PG8_STAGE(PG8_SA(0, 1), cA + hstep, voffA);
        if (wr == 1) PG8_BAR;
        PG8_WAIT_V(2); PG8_BAR;
        PG8_STAGE(PG8_SB(1, 0), cB + kstep, voffB); PG8_STAGE(PG8_SA(1, 0), cA + kstep, voffA); PG8_STAGE(PG8_SB(1, 1), cB + hstep + kstep, voffB);
        PG8_WAIT_V(6); PG8_BAR;
    } else {
        PG8_STAGE(PG8_SB(0, 0), cB, voffB); PG8_STAGE(PG8_SA(0, 0), cA, voffA); PG8_STAGE(PG8_SB(0, 1), cB + hstep, voffB); PG8_STAGE(PG8_SA(0, 1), cA + hstep, voffA);
        if (wr == 1) PG8_BAR;
        PG8_WAIT_V(4); PG8_BAR;
        PG8_STAGE(PG8_SB(1, 0), cB + kstep, voffB); PG8_STAGE(PG8_SA(1, 0), cA + kstep, voffA); PG8_STAGE(PG8_SB(1, 1), cB + hstep + kstep, voffB);
        PG8_WAIT_V(6); PG8_BAR;
    }
    for (;;) {
        const bool has_next = S.next(ui + 1, nxt);
        const char* nA = has_next ? (const char*)g.A + (size_t)nxt.pm * tstep : cA; const char* nB = has_next ? (const char*)g.Bt + (size_t)nxt.pn * tstep : cB;
        for (int t = 0; t < nt; t += 2) {
            const bool last = (t == nt - 2);
            const char* a1 = cA + (size_t)(t + 1) * kstep;
            const char* a2 = last ? nA : cA + (size_t)(t + 2) * kstep; const char* b2 = last ? nB : cB + (size_t)(t + 2) * kstep;
            const char* a3 = a2 + kstep; const char* b3 = b2 + kstep;
            if (last && has_next) S.a_ready(nxt);
            if constexpr (SP2) {
            PG8_LDB(B0, 0, 0); PG8_LDB(B1, 0, 1); PG8_SCHED; PG8_LDA(At, 0, 0); PG8_STAGE(PG8_SA(1, 1), a1 + hstep, voffA);
            PG8_WAIT_V(8); PG8_WAIT_L(0); PG8_BAR; PG8_MMA(0, 0, At, B0); PG8_MMA(0, 1, At, B1); PG8_BAR; PG8_SCHED;
            PG8_LDA(At, 0, 1); PG8_STAGE(PG8_SB(0, 0), b2, voffB); PG8_STAGE(PG8_SB(0, 1), b2 + hstep, voffB); PG8_STAGE(PG8_SA(0, 0), a2, voffA);
            PG8_WAIT_V(8); PG8_WAIT_L(0); PG8_BAR; PG8_MMA(1, 0, At, B0); PG8_MMA(1, 1, At, B1); PG8_BAR; PG8_SCHED;
            PG8_LDB(B0, 1, 0); PG8_LDB(B1, 1, 1); PG8_SCHED; PG8_LDA(At, 1, 0); PG8_STAGE(PG8_SA(0, 1), a2 + hstep, voffA);
            PG8_WAIT_V(8); PG8_WAIT_L(0); PG8_BAR; PG8_MMA(0, 0, At, B0); PG8_MMA(0, 1, At, B1); PG8_BAR; PG8_SCHED;
            PG8_LDA(At, 1, 1); PG8_STAGE(PG8_SB(1, 0), b3, voffB); PG8_STAGE(PG8_SB(1, 1), b3 + hstep, voffB); PG8_STAGE(PG8_SA(1, 0), a3, voffA);
            PG8_WAIT_V(8); PG8_WAIT_L(0); PG8_BAR; PG8_MMA(1, 0, At, B0); PG8_MMA(1, 1, At, B1); PG8_BAR; PG8_SCHED;
            } else {
            PG8_LDB(B0, 0, 0); PG8_SCHED; PG8_LDA(At, 0, 0); PG8_STAGE(PG8_SA(1, 1), a1 + hstep, voffA);
            PG8_WAIT_L(8); PG8_BAR; PG8_WAIT_L(0); PG8_MMA(0, 0, At, B0); PG8_BAR; PG8_SCHED;
            PG8_LDB(B1, 0, 1); PG8_STAGE(PG8_SB(0, 0), b2, voffB);
            PG8_BAR; PG8_WAIT_L(0); PG8_MMA(0, 1, At, B1); PG8_BAR;
            PG8_LDA(At, 0, 1); PG8_STAGE(PG8_SA(0, 0), a2, voffA);
            PG8_BAR; PG8_WAIT_L(0); PG8_MMA(1, 0, At, B0); PG8_BAR; PG8_SCHED;
            PG8_STAGE(PG8_SB(0, 1), b2 + hstep, voffB);
            PG8_WAIT_V(6); PG8_BAR; PG8_MMA(1, 1, At, B1); PG8_BAR;
            PG8_LDB(B0, 1, 0); PG8_SCHED; PG8_LDA(At, 1, 0); PG8_STAGE(PG8_SA(0, 1), a2 + hstep, voffA);
            PG8_WAIT_L(8); PG8_BAR; PG8_WAIT_L(0); PG8_MMA(0, 0, At, B0); PG8_BAR; PG8_SCHED;
            PG8_LDB(B1, 1, 1); PG8_STAGE(PG8_SB(1, 0), b3, voffB);
            PG8_BAR; PG8_WAIT_L(0); PG8_MMA(0, 1, At, B1); PG8_BAR;
            PG8_LDA(At, 1, 1); PG8_STAGE(PG8_SA(1, 0), a3, voffA);
            PG8_BAR; PG8_WAIT_L(0); PG8_MMA(1, 0, At, B0); PG8_BAR; PG8_SCHED;
            PG8_STAGE(PG8_SB(1, 1), b3 + hstep, voffB);
            PG8_WAIT_V(6); PG8_BAR; PG8_MMA(1, 1, At, B1); PG8_BAR;
            }
        }
        if constexpr (ALIGN_EPI) { if (wr == 0) PG8_BAR; }
        if constexpr (!Epi::AFTER_DRAIN) { E(acc, cur, wr, wc, fr, fq); S.done(cur); }
        if (!has_next) break;
#pragma unroll
        for (int a = 0; a < 2; ++a)
#pragma unroll
            for (int b = 0; b < 2; ++b)
#pragma unroll
                for (int m = 0; m < 4; ++m)
#pragma unroll
                    for (int n = 0; n < 2; ++n) acc[a][b][m][n] = (f32x4){0.f, 0.f, 0.f, 0.f};
        cur = nxt; cA = nA; cB = nB; ++ui;
        if constexpr (ALIGN_EPI) { if (wr == 1) PG8_BAR; }
    }
    PG8_WAIT_V(0);
    if constexpr (!ALIGN_EPI) { if (wr == 0) PG8_BAR; }
    PG8_BAR;
    if constexpr (Epi::AFTER_DRAIN) { E.fused(acc, cur, wr, wc, fr, fq, lds, wid, lane); S.done(cur); }
#undef PG8_SA
#undef PG8_SB
#undef PG8_STAGE
#undef PG8_LDA
#undef PG8_LDB
#undef PG8_MMA
#undef PG8_WAIT_V
#undef PG8_WAIT_L
#undef PG8_BAR
#undef PG8_SCHED
}
}
constexpr int NWAVES = 8;
constexpr int M = 16384, D = 2048, INC = 13312, PW = 1024, NPIECE = 13;
constexpr int GW = 64, GROWS = 256;
constexpr int NAH = 16, NADH = 64, HGH = 8, HGD = 128;
constexpr float EPS = 1e-6f;
enum { P_NQ = 0, P_NK = 1, P_NV = 2, P_NZ = 3, P_HQ = 4, P_HFF = 5, P_HFB = 6, P_HI = 7, P_HZ = 8, P_GA = 9, P_GB = 11 };
constexpr size_t MiB = 1u << 20;
constexpr size_t WS_CTL = 0, CTL_ZERO_BYTES = 1 * MiB;
constexpr size_t WS_SSQ = 2 * MiB;
constexpr size_t WS_WIN = 4 * MiB;
constexpr size_t WS_WBA = 56 * MiB, WS_WBB = 60 * MiB;
constexpr size_t WS_WOUT = 64 * MiB;
constexpr size_t WS_H = 72 * MiB;
constexpr size_t PIECE_BYTES = (size_t)M * PW * 2, PIECE_ELEMS = (size_t)M * PW;
constexpr size_t WS_END = WS_H + NPIECE * PIECE_BYTES;
static_assert(WS_WIN + (size_t)INC * D * 2 <= WS_WBA && WS_WOUT + (size_t)D * D * 2 <= WS_H, "ws map");
constexpr size_t WS_SLOC = 4 * MiB, WS_DSEG = 36 * MiB;
constexpr int HG_SEGC = 8, HG_NSEG = 32;
constexpr int CW_BAR = 4096;
constexpr int RING_OFF = 0, RING_BYTES = 150528;
constexpr int LDSCTL_OFF = RING_BYTES, MISC_OFF = LDSCTL_OFF + 320;
constexpr int LDS_BYTES = 152576;
#define GAS __attribute__((address_space(1)))
#define LAS __attribute__((address_space(3)))
typedef unsigned short bf16;
typedef unsigned v4u __attribute__((ext_vector_type(4)));
typedef float f32x4 __attribute__((ext_vector_type(4)));
typedef short bf16x8 __attribute__((ext_vector_type(8)));
typedef GAS unsigned gu32;
typedef GAS unsigned long long gu64;
#define RLX_AGENT __ATOMIC_RELAXED, __HIP_MEMORY_SCOPE_AGENT
#define LDS_WAIT() asm volatile("s_waitcnt lgkmcnt(0)" ::: "memory")
#define VM_WAIT() asm volatile("s_waitcnt vmcnt(0)" ::: "memory")
__device__ __forceinline__ unsigned long long rt() { return __builtin_amdgcn_s_memrealtime(); }
__device__ __forceinline__ unsigned f2bf(float f) { unsigned u = __builtin_bit_cast(unsigned, f); return (u + 0x7fffu + ((u >> 16) & 1u)) >> 16; }
__device__ __forceinline__ unsigned pk2(float lo, float hi) { return f2bf(lo) | (f2bf(hi) << 16); }

#define XB_TMO      128
#define XB_XCNT(j)  (256  + 64 * (j))
#define XB_XSUB(j)  (1280 + 64 * (j))
#define XB_XGEN(j)  (2304 + 64 * (j))
#define XB_TOP      3328
#define XB_TOPGEN   3392
#define XCD_BAR_WORDS 3456
#define XB_SPIN_CAP (1u << 18)

__device__ __forceinline__ unsigned xb_ld(unsigned* p)              { return __hip_atomic_load(p, __ATOMIC_RELAXED, __HIP_MEMORY_SCOPE_AGENT); }
__device__ __forceinline__ unsigned xb_add(unsigned* p, unsigned v) { return __hip_atomic_fetch_add(p, v, __ATOMIC_RELAXED, __HIP_MEMORY_SCOPE_AGENT); }
__device__ __forceinline__ unsigned xb_xcc_id() { return (unsigned)__builtin_amdgcn_s_getreg((3 << 11) | 20) & 0xFu; }
#define XB_SPIN(cond, bar) do { unsigned _sp = 0; while (cond) { __builtin_amdgcn_s_sleep(1); \
    if ((++_sp & 255u) == 0u) { if (xb_ld(&(bar)[XB_TMO])) break; if (_sp > XB_SPIN_CAP) { atomicAdd(&(bar)[XB_TMO], 1u); break; } } } } while (0)

struct XcdBarrier {
    unsigned* bar; unsigned x;
    volatile LAS unsigned* st;
};

__device__ __forceinline__ XcdBarrier xcd_barrier_post(unsigned* bar, volatile LAS unsigned* st) {
    XcdBarrier b; b.bar = bar; b.x = xb_xcc_id(); b.st = st;
    if (threadIdx.x == 0) (void)xb_add(&bar[XB_XCNT(b.x)], 1u);
    return b;
}
__device__ __forceinline__ void xcd_barrier_complete(unsigned* bar, unsigned x, unsigned& nloc, unsigned& nx) {
    const unsigned G = gridDim.x * gridDim.y * gridDim.z;
    unsigned sum, cnt, mine, sp = 0u;
    for (;;) {
        sum = 0u; cnt = 0u; mine = 0u;
#pragma unroll
        for (unsigned j = 0; j < 16; ++j) { const unsigned c = xb_ld(&bar[XB_XCNT(j)]); sum += c; cnt += (c > 0u) ? 1u : 0u; mine = (j == x) ? c : mine; }
        if (sum == G) break;
        __builtin_amdgcn_s_sleep(1);
        if ((++sp & 255u) == 0u) { if (xb_ld(&bar[XB_TMO])) break; if (sp > XB_SPIN_CAP) { atomicAdd(&bar[XB_TMO], 1u); break; } }
    }
    nloc = mine > 0u ? mine : 1u; nx = cnt > 0u ? cnt : 1u;
}

__device__ __forceinline__ void xcd_barrier(const XcdBarrier& b) {
    asm volatile("s_waitcnt vmcnt(0)" ::: "memory");
    __syncthreads();
    if (threadIdx.x == 0) {
        unsigned* bar = b.bar;
        __builtin_amdgcn_s_waitcnt(0);
        unsigned nloc = b.st[0], nx = b.st[1];
        if (nloc == 0u) { xcd_barrier_complete(bar, b.x, nloc, nx); b.st[0] = nloc; b.st[1] = nx; }
        const unsigned old = xb_add(&bar[XB_XSUB(b.x)], 1u);
        const unsigned gen = old / nloc;
        if (old + 1u == (gen + 1u) * nloc) {
            __builtin_amdgcn_fence(__ATOMIC_RELEASE, "agent");
            asm volatile("s_waitcnt vmcnt(0)" ::: "memory");
            const unsigned og = xb_add(&bar[XB_TOP], 1u);
            const unsigned tg = og / nx;
            if (og + 1u == (tg + 1u) * nx) xb_add(&bar[XB_TOPGEN], 1u);
            else XB_SPIN(xb_ld(&bar[XB_TOPGEN]) == tg, bar);
            __builtin_amdgcn_fence(__ATOMIC_ACQUIRE, "agent");
            xb_add(&bar[XB_XGEN(b.x)], 1u);
            asm volatile("s_waitcnt vmcnt(0)" ::: "memory");
        } else {
            XB_SPIN(xb_ld(&bar[XB_XGEN(b.x)]) == gen, bar);
            __builtin_amdgcn_fence(__ATOMIC_ACQUIRE, "agent");
            asm volatile("s_waitcnt vmcnt(0)" ::: "memory");
        }
    }
    __syncthreads();
}
__device__ __forceinline__ float wave_sum(float v) {
#pragma unroll
    for (int o = 1; o < 64; o <<= 1) v += __shfl_xor(v, o);
    return v;
}
__device__ __forceinline__ void p0_transpose_item(const float* W, int K, int N, bf16* WT, int row_off, LAS float* scr, int item, int lane) {
    const int nblk = N / 32, kb = item / nblk, nb = item % nblk, k0 = 64 * kb, n0 = 32 * nb;
#pragma unroll 8
    for (int i = 0; i < 32; ++i) { const int kk = 2 * i + (lane >> 5); scr[kk * 33 + (lane & 31)] = W[(size_t)(k0 + kk) * N + n0 + (lane & 31)]; }
    LDS_WAIT(); asm volatile("" ::: "memory");
    const int c = lane & 7;
#pragma unroll
    for (int j = 0; j < 4; ++j) { const int n = (lane >> 3) + 8 * j; const LAS float* s = scr + (8 * c) * 33 + n;
        v4u o; o.x = pk2(s[0 * 33], s[1 * 33]); o.y = pk2(s[2 * 33], s[3 * 33]); o.z = pk2(s[4 * 33], s[5 * 33]); o.w = pk2(s[6 * 33], s[7 * 33]);
        *(GAS v4u*)(WT + (size_t)(row_off + n0 + n) * K + k0 + 8 * c) = o; }
    LDS_WAIT(); asm volatile("" ::: "memory");
}
struct Frame {
    LAS unsigned char* lds;
    volatile LAS unsigned* MISC;
    gu32* ctl;
    int tid, lane, wave;
    int vcu, G;
};
__device__ __forceinline__ float bf2f(bf16 b) { return __builtin_bit_cast(float, (unsigned)b << 16); }
__device__ __forceinline__ float wave_max(float v) {
#pragma unroll
    for (int o = 1; o < 64; o <<= 1) v = fmaxf(v, __shfl_xor(v, o));
    return v;
}
__device__ __forceinline__ float sigm(float x) { return 1.0f / (1.0f + __expf(-x)); }

__device__ __forceinline__ void p0_prologue(Frame& F, const float* x, const float* w_pre, const float* w_in, const float* w_br, const float* w_out,
                                            bf16* XN, bf16* WIN_T, bf16* WBA_T, bf16* WBB_T, bf16* WOUT_T) {
    LAS float* scr = (LAS float*)(F.lds + RING_OFF + F.wave * 16384);
    const int gw = F.vcu * NWAVES + F.wave, NGW = F.G * NWAVES;
    constexpr int I_IN = (D / 64) * (INC / 32), I_BR = (PW / 64) * (D / 32), I_OUT = (D / 64) * (D / 32);
    constexpr int NITEMS = I_IN + 2 * I_BR + I_OUT;
    for (int it = gw; it < NITEMS; it += NGW) {
        int r = it;
        if (r < I_IN) { p0_transpose_item(w_in, D, INC, WIN_T, 0, scr, r, F.lane); continue; } r -= I_IN;
        if (r < I_BR) { p0_transpose_item(w_br, PW, D, WBA_T, 0, scr, r, F.lane); continue; } r -= I_BR;
        if (r < I_BR) { p0_transpose_item(w_br + (size_t)PW * D, PW, D, WBB_T, 0, scr, r, F.lane); continue; } r -= I_BR;
        p0_transpose_item(w_out, D, D, WOUT_T, 0, scr, r, F.lane);
    }
    for (int m = gw; m < M; m += NGW) {
        const f32x4* xr = (const f32x4*)(x + (size_t)m * D) + F.lane;
        f32x4 v[8]; float s = 0.f;
#pragma unroll
        for (int j = 0; j < 8; ++j) { v[j] = xr[64 * j]; s += (v[j].x * v[j].x + v[j].y * v[j].y) + (v[j].z * v[j].z + v[j].w * v[j].w); }
        const float rstd = 1.0f / sqrtf(wave_sum(s) * (1.f / D) + EPS);
        unsigned long long* o8 = (unsigned long long*)(XN + (size_t)m * D) + F.lane;
#pragma unroll
        for (int j = 0; j < 8; ++j) { const f32x4 w = *((const f32x4*)w_pre + F.lane + 64 * j);
            o8[64 * j] = (unsigned long long)pk2(v[j].x * rstd * w.x, v[j].y * rstd * w.y) | ((unsigned long long)pk2(v[j].z * rstd * w.z, v[j].w * rstd * w.w) << 32); }
    }
}

__device__ __forceinline__ void na_naive(Frame& F, bf16* Q, const bf16* K, const bf16* V, const bf16* Z, const float* rpb) {
    const int gw = F.vcu * NWAVES + F.wave, NGW = F.G * NWAVES, lane = F.lane;
    for (int it = gw; it < M * NAH; it += NGW) {
        const int h = it & 15, tq = it >> 4, r = tq >> 6, c = tq & 63;
        int rs = r - 4; rs = rs < 0 ? 0 : (rs > GROWS - 8 ? GROWS - 8 : rs);
        int cs = c - 8; cs = cs < 0 ? 0 : (cs > GW - 16 ? GW - 16 : cs);
        const v4u* qp = (const v4u*)(Q + (size_t)tq * PW + h * NADH);
        v4u qv[8];
#pragma unroll
        for (int i = 0; i < 8; ++i) qv[i] = qp[i];
        float sc[2];
#pragma unroll
        for (int e = 0; e < 2; ++e) {
            const int j = lane + 64 * e, kr = rs + (j >> 4), kc = cs + (j & 15), tk = kr * GW + kc;
            const v4u* kp = (const v4u*)(K + (size_t)tk * PW + h * NADH);
            float a = 0.f;
#pragma unroll
            for (int i = 0; i < 8; ++i) { const v4u kv = kp[i];
                a += pg8::bf_lo(qv[i].x) * pg8::bf_lo(kv.x) + pg8::bf_hi(qv[i].x) * pg8::bf_hi(kv.x) + pg8::bf_lo(qv[i].y) * pg8::bf_lo(kv.y) + pg8::bf_hi(qv[i].y) * pg8::bf_hi(kv.y)
                   + pg8::bf_lo(qv[i].z) * pg8::bf_lo(kv.z) + pg8::bf_hi(qv[i].z) * pg8::bf_hi(kv.z) + pg8::bf_lo(qv[i].w) * pg8::bf_lo(kv.w) + pg8::bf_hi(qv[i].w) * pg8::bf_hi(kv.w); }
            sc[e] = a * 0.125f + rpb[(h * 15 + (kr - r + 7)) * 31 + (kc - c + 15)];
        }
        const float mx = wave_max(fmaxf(sc[0], sc[1]));
        const float e0 = __expf(sc[0] - mx), e1 = __expf(sc[1] - mx);
        const float inv = 1.0f / wave_sum(e0 + e1);
        const float p0 = e0 * inv, p1 = e1 * inv;
        float o = 0.f;
        for (int j = 0; j < 64; ++j) {
            const int kr = rs + (j >> 4), kc = cs + (j & 15), tk = kr * GW + kc;
            const float pa = __shfl(p0, j), pb = __shfl(p1, j);
            o += pa * bf2f(V[(size_t)tk * PW + h * NADH + lane]);
            o += pb * bf2f(V[(size_t)(tk + 4 * GW) * PW + h * NADH + lane]);
        }
        const float z = bf2f(Z[(size_t)tq * PW + h * NADH + lane]);
        o *= z * sigm(z);
        Q[(size_t)tq * PW + h * NADH + lane] = (bf16)f2bf(o);
    }
}

__device__ __forceinline__ void hg_naive(Frame& F, const bf16* HQ, const bf16* HFF, const bf16* HFB, const bf16* HI, const float* lb_logits, float* OFWD, float* OBWD) {
    LAS float* red = (LAS float*)(F.lds + RING_OFF);
    for (int u = blockIdx.x; u < 256; u += F.G) {
        const int hd = u >> 4, head = hd >> 1, dir = hd & 1, dv0 = (u & 15) * 8;
        const int dk = F.tid & 127, part = F.tid >> 7;
        const int ch = head * HGD + dk;
        const float lbv = sigm(lb_logits[dir * 1024 + ch] - lb_logits[2048 + dir * 1024 + ch]);
        const bf16* FL = dir ? HFB : HFF; float* OUT = dir ? OBWD : OFWD;
        const int cv = head * HGD + dv0 + part * 2;
        float S0 = 0.f, S1 = 0.f;
        for (int cb = 0; cb < M / 64; ++cb) {
            LAS float* rb = red + (cb & 1) * 1024;
#pragma unroll 8
            for (int s = 0; s < 64; ++s) {
                const int step = cb * 64 + s, t = dir ? (M - 1 - step) : step;
                const float fl = bf2f(FL[(size_t)t * PW + ch]), q = bf2f(HQ[(size_t)t * PW + ch]);
                const unsigned vv = *(const unsigned*)(HI + (size_t)t * PW + cv);
                const float v0 = pg8::bf_lo(vv), v1 = pg8::bf_hi(vv);
                const float sg = sigm(fl), f = lbv + (1.f - lbv) * sg, k = (1.f - lbv) * (1.f - sg);
                S0 = f * S0 + k * v0; S1 = f * S1 + k * v1;
                const float p0 = wave_sum(S0 * q), p1 = wave_sum(S1 * q);
                if (F.lane == 0) { rb[(s * 8 + F.wave) * 2] = p0; rb[(s * 8 + F.wave) * 2 + 1] = p1; }
            }
            __syncthreads();
            { const int s = F.tid >> 3, j = F.tid & 7, pp = j >> 1, e = j & 1;
              const int step = cb * 64 + s, t = dir ? (M - 1 - step) : step;
              OUT[(size_t)t * PW + head * HGD + dv0 + j] = rb[(s * 8 + 2 * pp) * 2 + e] + rb[(s * 8 + 2 * pp + 1) * 2 + e]; }
        }
        __syncthreads();
    }
}
constexpr int HG_IMQ = 0, HG_IMK = 16384, HG_IMV = 32768, HG_IMP = 49152, HG_PROW = 144, HG_IMS = HG_IMP + 64 * HG_PROW, HG_WTOT = HG_IMS + 8 * 4096, HG_EREF = HG_WTOT + 4096, HG_CSC = HG_EREF + 512, HG_LDS_END = HG_CSC + 512;
static_assert(HG_LDS_END <= RING_BYTES, "hg lds");
__device__ __forceinline__ unsigned off_b(unsigned row, unsigned ch) { return 256u * row + 16u * (ch ^ (((row & 3) << 2) | ((row >> 2) & 3))); }
typedef short s16x4 __attribute__((ext_vector_type(4)));
typedef float f32x2 __attribute__((ext_vector_type(2)));
__device__ __forceinline__ void tr_read4(unsigned a0, unsigned a1, unsigned a2, unsigned a3, s16x4& r0, s16x4& r1, s16x4& r2, s16x4& r3) {
    asm volatile("ds_read_b64_tr_b16 %0, %4\n\tds_read_b64_tr_b16 %1, %5\n\tds_read_b64_tr_b16 %2, %6\n\tds_read_b64_tr_b16 %3, %7\n\ts_waitcnt lgkmcnt(0)"
                 : "=&v"(r0), "=&v"(r1), "=&v"(r2), "=&v"(r3) : "v"(a0), "v"(a1), "v"(a2), "v"(a3) : "memory");
}
#define MFMA16(a, b, c) __builtin_amdgcn_mfma_f32_16x16x32_bf16((a), (b), (c), 0, 0, 0)
template <bool PRE>
__device__ __forceinline__ void hg_unit(Frame& F, int head, int dir, int c0, int nch, const bf16* HQ, const bf16* FL, const bf16* HI, const float* lb_logits,
                                        const float* S_in, float* S_out, float* Dseg_out, float* OUT) {
    LAS unsigned char* L = F.lds + RING_OFF;
    const unsigned lbase = (unsigned)(size_t)L;
    const int lane = F.lane, w = F.wave, n = lane & 15, g = lane >> 4, q4 = n >> 2, p4 = n & 3;
    const int chb = head * HGD;
    float lbv[2];
#pragma unroll
    for (int e = 0; e < 2; ++e) { const int ch = chb + 2 * lane + e; lbv[e] = sigm(lb_logits[dir * 1024 + ch] - lb_logits[2048 + dir * 1024 + ch]); }
    f32x4 S[8];
#pragma unroll
    for (int kt = 0; kt < 8; ++kt) {
        if (S_in) {
#pragma unroll
            for (int r = 0; r < 4; ++r) S[kt][r] = S_in[(size_t)(16 * kt + 4 * g + r) * HGD + 16 * w + n]; }
        else S[kt] = (f32x4){0.f, 0.f, 0.f, 0.f};
    }
    float dseg[2] = {0.f, 0.f};
    for (int ci = 0; ci < nch; ++ci) {
        const int c = dir ? (c0 + nch - 1 - ci) : (c0 + ci);
        float Aloc[8][2], kk[8][2], qq[8][2]; unsigned vraw[8];
        float run0 = 0.f, run1 = 0.f;
#pragma unroll
        for (int i = 0; i < 8; ++i) {
            const int tau = 8 * w + i, t = dir ? (64 * c + 63 - tau) : (64 * c + tau);
            const size_t o = (size_t)t * PW + chb + 2 * lane;
            const unsigned fw = *(const unsigned*)(FL + o), qw = *(const unsigned*)(HQ + o); vraw[i] = *(const unsigned*)(HI + o);
            const float f0 = pg8::bf_lo(fw), f1 = pg8::bf_hi(fw);
            const float s0 = pg8::sigmoidf_(f0), s1 = pg8::sigmoidf_(f1);
            const float g0 = __builtin_amdgcn_logf(lbv[0] + (1.f - lbv[0]) * s0), g1 = __builtin_amdgcn_logf(lbv[1] + (1.f - lbv[1]) * s1);
            kk[i][0] = (1.f - lbv[0]) * (1.f - s0); kk[i][1] = (1.f - lbv[1]) * (1.f - s1);
            qq[i][0] = pg8::bf_lo(qw); qq[i][1] = pg8::bf_hi(qw);
            run0 += g0; run1 += g1; Aloc[i][0] = run0; Aloc[i][1] = run1;
        }
        LAS float* WT = (LAS float*)(L + HG_WTOT);
        *(LAS f32x2*)(WT + w * 128 + 2 * lane) = (f32x2){run0, run1};
        __syncthreads();
        float pre0 = 0.f, pre1 = 0.f, ref0 = 0.f, ref1 = 0.f, tot0 = 0.f, tot1 = 0.f;
#pragma unroll
        for (int ww = 0; ww < 8; ++ww) { const f32x2 tv = *(LAS f32x2*)(WT + ww * 128 + 2 * lane);
            if (ww < w) { pre0 += tv.x; pre1 += tv.y; } if (ww < 4) { ref0 += tv.x; ref1 += tv.y; } tot0 += tv.x; tot1 += tv.y; }
        dseg[0] += tot0; dseg[1] += tot1;
#pragma unroll
        for (int i = 0; i < 8; ++i) {
            const int tau = 8 * w + i;
            const float d0 = pre0 + Aloc[i][0] - ref0, d1 = pre1 + Aloc[i][1] - ref1;
            const float qm0 = qq[i][0] * __builtin_amdgcn_exp2f(d0), qm1 = qq[i][1] * __builtin_amdgcn_exp2f(d1);
            const float km0 = kk[i][0] * __builtin_amdgcn_exp2f(fminf(-d0, 120.f)), km1 = kk[i][1] * __builtin_amdgcn_exp2f(fminf(-d1, 120.f));
            const unsigned ob = off_b(tau, lane >> 2) + (lane & 3) * 4;
            *(LAS unsigned*)(L + HG_IMQ + ob) = pk2(qm0, qm1);
            *(LAS unsigned*)(L + HG_IMK + ob) = pk2(km0, km1);
            *(LAS unsigned*)(L + HG_IMV + ob) = vraw[i];
        }
        if (w == 0) { *(LAS f32x2*)((LAS float*)(L + HG_EREF) + 2 * lane) = (f32x2){__builtin_amdgcn_exp2f(ref0), __builtin_amdgcn_exp2f(ref1)};
                      *(LAS f32x2*)((LAS float*)(L + HG_CSC) + 2 * lane) = (f32x2){__builtin_amdgcn_exp2f(tot0 - ref0), __builtin_amdgcn_exp2f(tot1 - ref1)}; }
        __syncthreads();
        if (!PRE) {
            const int tt = w >> 1;
            pg8::bf16x8 bq[4];
#pragma unroll
            for (int ks = 0; ks < 4; ++ks) bq[ks] = *(const LAS pg8::bf16x8*)(L + HG_IMQ + off_b(16 * tt + n, 4 * ks + g));
#pragma unroll
            for (int si = 0; si < 2; ++si) { const int st = 2 * (w & 1) + si;
                f32x4 pacc = (f32x4){0.f, 0.f, 0.f, 0.f};
#pragma unroll
                for (int ks = 0; ks < 4; ++ks) { const pg8::bf16x8 ak = *(const LAS pg8::bf16x8*)(L + HG_IMK + off_b(16 * st + n, 4 * ks + g)); pacc = MFMA16(ak, bq[ks], pacc); }
                const int tcol = 16 * tt + n, srow = 16 * st + 4 * g;
                float pv[4];
#pragma unroll
                for (int r = 0; r < 4; ++r) pv[r] = (srow + r <= tcol) ? pacc[r] : 0.f;
                *(LAS unsigned long long*)(L + HG_IMP + tcol * HG_PROW + srow * 2) = (unsigned long long)pk2(pv[0], pv[1]) | ((unsigned long long)pk2(pv[2], pv[3]) << 32);
            }
        }
#pragma unroll
        for (int kt = 0; kt < 8; ++kt) { const f32x4 e4 = *(const LAS f32x4*)((LAS float*)(L + HG_EREF) + 16 * kt + 4 * g);
            S[kt] = S[kt] * e4;
            if (!PRE) *(LAS unsigned long long*)(L + HG_IMS + w * 4096 + off_b(n, 2 * kt + (g >> 1)) + 8 * (g & 1)) = (unsigned long long)pk2(S[kt][0], S[kt][1]) | ((unsigned long long)pk2(S[kt][2], S[kt][3]) << 32);
        }
        pg8::bf16x8 vf[2];
        { s16x4 r0, r1, r2, r3;
          tr_read4(lbase + HG_IMV + off_b(8 * g + q4, 2 * w + (p4 >> 1)) + 8 * (p4 & 1), lbase + HG_IMV + off_b(8 * g + 4 + q4, 2 * w + (p4 >> 1)) + 8 * (p4 & 1),
                   lbase + HG_IMV + off_b(32 + 8 * g + q4, 2 * w + (p4 >> 1)) + 8 * (p4 & 1), lbase + HG_IMV + off_b(32 + 8 * g + 4 + q4, 2 * w + (p4 >> 1)) + 8 * (p4 & 1), r0, r1, r2, r3);
          vf[0] = __builtin_shufflevector(r0, r1, 0, 1, 2, 3, 4, 5, 6, 7); vf[1] = __builtin_shufflevector(r2, r3, 0, 1, 2, 3, 4, 5, 6, 7); }
        if (!PRE) {
            __syncthreads();
            pg8::bf16x8 sf[4];
#pragma unroll
            for (int ks = 0; ks < 4; ++ks) sf[ks] = *(const LAS pg8::bf16x8*)(L + HG_IMS + w * 4096 + off_b(n, 4 * ks + g));
#pragma unroll
            for (int tt = 0; tt < 4; ++tt) {
                f32x4 oacc = (f32x4){0.f, 0.f, 0.f, 0.f};
#pragma unroll
                for (int ks = 0; ks < 2; ++ks) { if (32 * ks > 16 * tt + 15) continue;
                    const pg8::bf16x8 pf = *(const LAS pg8::bf16x8*)(L + HG_IMP + (16 * tt + n) * HG_PROW + (32 * ks + 8 * g) * 2); oacc = MFMA16(pf, vf[ks], oacc); }
#pragma unroll
                for (int ks = 0; ks < 4; ++ks) { const pg8::bf16x8 qf = *(const LAS pg8::bf16x8*)(L + HG_IMQ + off_b(16 * tt + n, 4 * ks + g)); oacc = MFMA16(qf, sf[ks], oacc); }
#pragma unroll
                for (int r = 0; r < 4; ++r) { const int tau = 16 * tt + 4 * g + r, t = dir ? (64 * c + 63 - tau) : (64 * c + tau);
                    OUT[(size_t)t * PW + chb + 16 * w + n] = oacc[r]; }
            }
        }
#pragma unroll
        for (int kt = 0; kt < 8; ++kt) {
            s16x4 r0, r1, r2, r3;
            tr_read4(lbase + HG_IMK + off_b(8 * g + q4, 2 * kt + (p4 >> 1)) + 8 * (p4 & 1), lbase + HG_IMK + off_b(8 * g + 4 + q4, 2 * kt + (p4 >> 1)) + 8 * (p4 & 1),
                     lbase + HG_IMK + off_b(32 + 8 * g + q4, 2 * kt + (p4 >> 1)) + 8 * (p4 & 1), lbase + HG_IMK + off_b(32 + 8 * g + 4 + q4, 2 * kt + (p4 >> 1)) + 8 * (p4 & 1), r0, r1, r2, r3);
            const pg8::bf16x8 k0 = __builtin_shufflevector(r0, r1, 0, 1, 2, 3, 4, 5, 6, 7), k1 = __builtin_shufflevector(r2, r3, 0, 1, 2, 3, 4, 5, 6, 7);
            S[kt] = MFMA16(k0, vf[0], S[kt]); S[kt] = MFMA16(k1, vf[1], S[kt]);
            const f32x4 c4 = *(const LAS f32x4*)((LAS float*)(L + HG_CSC) + 16 * kt + 4 * g);
            S[kt] = S[kt] * c4;
        }
    }
    __syncthreads();
    if (S_out) {
#pragma unroll
        for (int kt = 0; kt < 8; ++kt)
#pragma unroll
            for (int r = 0; r < 4; ++r) S_out[(size_t)(16 * kt + 4 * g + r) * HGD + 16 * w + n] = S[kt][r];
    }
    if (Dseg_out && w == 0) { Dseg_out[2 * lane] = dseg[0]; Dseg_out[2 * lane + 1] = dseg[1]; }
}

constexpr int NA_SLOT = 16384, NA_NSLOT = 9, NA_BIAS = NA_SLOT * NA_NSLOT, NA_LDS_END = NA_BIAS + 2048;
static_assert(NA_LDS_END <= RING_BYTES, "na lds");
__device__ __forceinline__ void tr_read2(unsigned a0, unsigned a1, s16x4& r0, s16x4& r1) {
    asm volatile("ds_read_b64_tr_b16 %0, %2\n\tds_read_b64_tr_b16 %1, %3\n\ts_waitcnt lgkmcnt(0)" : "=&v"(r0), "=&v"(r1) : "v"(a0), "v"(a1) : "memory");
}
__device__ __forceinline__ int na_rs(int r) { int rs = r - 4; return rs < 0 ? 0 : (rs > GROWS - 8 ? GROWS - 8 : rs); }
__device__ __forceinline__ void na_unit(Frame& F, int h, int r0, bf16* Q, const bf16* K, const bf16* V, const bf16* Z, const float* rpb) {
    LAS unsigned char* L = F.lds + RING_OFF;
    const unsigned lbase = (unsigned)(size_t)L;
    const int tid = F.tid, lane = F.lane, w = F.wave, n = lane & 15, g = lane >> 4, q4 = n >> 2, p4 = n & 3;
    const int scol = tid >> 3, sch = tid & 7;
    const unsigned sdst = (unsigned)(scol * 128 + 16 * (sch ^ (scol & 7)));
    __syncthreads();
    for (int i = tid; i < 15 * 31; i += NWAVES * 64) ((LAS float*)(L + NA_BIAS))[i] = rpb[h * 465 + i] * 1.44269504089f;
    int hi = na_rs(r0) - 1;
    { const int need = na_rs(r0 + 1) + 7;
      for (int kr = hi + 1; kr <= need; ++kr) { const size_t o = (size_t)(kr * GW + scol) * PW + h * NADH + sch * 8;
          const v4u kv = *(const v4u*)(K + o), vv = *(const v4u*)(V + o); LAS unsigned char* sl = L + (kr % NA_NSLOT) * NA_SLOT;
          *(LAS v4u*)(sl + sdst) = kv; *(LAS v4u*)(sl + 8192 + sdst) = vv; }
      hi = need; }
    __syncthreads();
    for (int st = 0; st < 8; ++st) {
        const int r = r0 + 2 * st;
        int nnew = 0; v4u pk[2], pv[2];
        if (st < 7) { const int need = na_rs(r + 3) + 7; nnew = need - hi;
#pragma unroll
            for (int e = 0; e < 2; ++e) if (e < nnew) { const size_t o = (size_t)((hi + 1 + e) * GW + scol) * PW + h * NADH + sch * 8; pk[e] = *(const v4u*)(K + o); pv[e] = *(const v4u*)(V + o); } }
        {
            const int rq = r + (w >> 2), cb = w & 3, rs = na_rs(rq);
            int kb0 = 16 * cb - 8; kb0 = kb0 < 0 ? 0 : (kb0 > 32 ? 32 : kb0);
            const int qc = 16 * cb + n; int cs = qc - 8; cs = cs < 0 ? 0 : (cs > GW - 16 ? GW - 16 : cs);
            const int tq = rq * GW + qc;
            pg8::bf16x8 qf[2];
#pragma unroll
            for (int ks = 0; ks < 2; ++ks) qf[ks] = *(const pg8::bf16x8*)(Q + (size_t)tq * PW + h * NADH + 32 * ks + 8 * g);
            bool val[2][4]; int ci[2][4];
#pragma unroll
            for (int hf = 0; hf < 2; ++hf)
#pragma unroll
                for (int rr = 0; rr < 4; ++rr) { const int kc = kb0 + 16 * hf + 4 * g + rr; val[hf][rr] = (kc >= cs) && (kc < cs + 16); int c = kc - qc + 15; c = c < 0 ? 0 : (c > 30 ? 30 : c); ci[hf][rr] = c; }
            f32x4 sc[8][2]; float mx = -1e30f;
#pragma unroll
            for (int jr = 0; jr < 8; ++jr) { const int kr = rs + jr; const unsigned slb = (unsigned)((kr % NA_NSLOT) * NA_SLOT); const int ri = kr - rq + 7;
#pragma unroll
                for (int hf = 0; hf < 2; ++hf) { const int col = kb0 + 16 * hf + n; f32x4 a = (f32x4){0.f, 0.f, 0.f, 0.f};
#pragma unroll
                    for (int ks = 0; ks < 2; ++ks) { const pg8::bf16x8 kf = *(const LAS pg8::bf16x8*)(L + slb + col * 128 + 16 * ((4 * ks + g) ^ (col & 7))); a = MFMA16(kf, qf[ks], a); }
#pragma unroll
                    for (int rr = 0; rr < 4; ++rr) { const float b = ((const LAS float*)(L + NA_BIAS))[ri * 31 + ci[hf][rr]];
                        const float s2 = val[hf][rr] ? (a[rr] * 1.44269504089f + b) : -1e30f; a[rr] = s2; mx = fmaxf(mx, s2); }
                    sc[jr][hf] = a; } }
            mx = fmaxf(mx, __shfl_xor(mx, 16)); mx = fmaxf(mx, __shfl_xor(mx, 32));
            float ls = 0.f; pg8::bf16x8 pf[8];
#pragma unroll
            for (int jr = 0; jr < 8; ++jr) { float e[8];
#pragma unroll
                for (int hf = 0; hf < 2; ++hf)
#pragma unroll
                    for (int rr = 0; rr < 4; ++rr) { e[hf * 4 + rr] = __builtin_amdgcn_exp2f(sc[jr][hf][rr] - mx); ls += e[hf * 4 + rr]; }
                v4u pw; pw.x = pk2(e[0], e[1]); pw.y = pk2(e[2], e[3]); pw.z = pk2(e[4], e[5]); pw.w = pk2(e[6], e[7]); pf[jr] = __builtin_bit_cast(pg8::bf16x8, pw); }
            ls += __shfl_xor(ls, 16); ls += __shfl_xor(ls, 32);
            const float inv = 1.0f / ls;
            f32x4 oacc[4];
#pragma unroll
            for (int dt = 0; dt < 4; ++dt) oacc[dt] = (f32x4){0.f, 0.f, 0.f, 0.f};
#pragma unroll
            for (int jr = 0; jr < 8; ++jr) { const int kr = rs + jr; const unsigned slb = lbase + (unsigned)((kr % NA_NSLOT) * NA_SLOT) + 8192u;
                const int c0 = kb0 + 4 * g + q4, c1 = c0 + 16;
#pragma unroll
                for (int dt = 0; dt < 4; ++dt) { s16x4 v0, v1;
                    tr_read2(slb + c0 * 128 + 16 * ((2 * dt + (p4 >> 1)) ^ (c0 & 7)) + 8 * (p4 & 1), slb + c1 * 128 + 16 * ((2 * dt + (p4 >> 1)) ^ (c1 & 7)) + 8 * (p4 & 1), v0, v1);
                    const pg8::bf16x8 vf = __builtin_shufflevector(v0, v1, 0, 1, 2, 3, 4, 5, 6, 7);
                    oacc[dt] = MFMA16(vf, pf[jr], oacc[dt]); } }
#pragma unroll
            for (int dt = 0; dt < 4; ++dt) { const size_t o = (size_t)tq * PW + h * NADH + 16 * dt + 4 * g;
                const unsigned long long zz = *(const unsigned long long*)(Z + o); const unsigned zl = (unsigned)zz, zh = (unsigned)(zz >> 32);
                const float z0 = pg8::bf_lo(zl), z1 = pg8::bf_hi(zl), z2 = pg8::bf_lo(zh), z3 = pg8::bf_hi(zh);
                const float o0 = oacc[dt][0] * inv * z0 * pg8::sigmoidf_(z0), o1 = oacc[dt][1] * inv * z1 * pg8::sigmoidf_(z1), o2 = oacc[dt][2] * inv * z2 * pg8::sigmoidf_(z2), o3 = oacc[dt][3] * inv * z3 * pg8::sigmoidf_(z3);
                *(unsigned long long*)(Q + o) = (unsigned long long)pk2(o0, o1) | ((unsigned long long)pk2(o2, o3) << 32); }
        }
        __syncthreads();
#pragma unroll
        for (int e = 0; e < 2; ++e) if (e < nnew) { LAS unsigned char* sl = L + ((hi + 1 + e) % NA_NSLOT) * NA_SLOT; *(LAS v4u*)(sl + sdst) = pk[e]; *(LAS v4u*)(sl + 8192 + sdst) = pv[e]; }
        hi += nnew;
        __syncthreads();
    }
}

__device__ __forceinline__ void hg_finish(Frame& F, const float* OFWD, const float* OBWD, const bf16* HZ, const float* w, bf16* OB) {
    const int gw = F.vcu * NWAVES + F.wave, NGW = F.G * NWAVES, lane = F.lane;
    for (int m = gw; m < M; m += NGW) {
        const f32x4* a = (const f32x4*)(OFWD + (size_t)m * PW) + lane * 4; const f32x4* b = (const f32x4*)(OBWD + (size_t)m * PW) + lane * 4;
        f32x4 o[4]; float ss = 0.f;
#pragma unroll
        for (int i = 0; i < 4; ++i) { o[i] = a[i] + b[i]; ss += (o[i].x * o[i].x + o[i].y * o[i].y) + (o[i].z * o[i].z + o[i].w * o[i].w); }
        ss += __shfl_xor(ss, 1); ss += __shfl_xor(ss, 2); ss += __shfl_xor(ss, 4);
        const float rstd = 1.0f / sqrtf(ss * (1.f / HGD) + EPS);
        const v4u* zp = (const v4u*)(HZ + (size_t)m * PW) + lane * 2; v4u* op = (v4u*)(OB + (size_t)m * PW) + lane * 2;
#pragma unroll
        for (int hh = 0; hh < 2; ++hh) { const v4u zz = zp[hh]; const f32x4 w0 = *((const f32x4*)w + lane * 4 + hh * 2), w1 = *((const f32x4*)w + lane * 4 + hh * 2 + 1);
            const f32x4 o0 = o[hh * 2], o1 = o[hh * 2 + 1];
            float zf[8] = {pg8::bf_lo(zz.x), pg8::bf_hi(zz.x), pg8::bf_lo(zz.y), pg8::bf_hi(zz.y), pg8::bf_lo(zz.z), pg8::bf_hi(zz.z), pg8::bf_lo(zz.w), pg8::bf_hi(zz.w)};
            float r[8] = {o0.x * w0.x, o0.y * w0.y, o0.z * w0.z, o0.w * w0.w, o1.x * w1.x, o1.y * w1.y, o1.z * w1.z, o1.w * w1.w};
#pragma unroll
            for (int i = 0; i < 8; ++i) r[i] = r[i] * rstd * zf[i] * sigm(zf[i]);
            v4u ow; ow.x = pk2(r[0], r[1]); ow.y = pk2(r[2], r[3]); ow.z = pk2(r[4], r[5]); ow.w = pk2(r[6], r[7]); op[hh] = ow; }
    }
}
__device__ __forceinline__ void final_phase(Frame& F, const float* x, const bf16* Zb, const float* ssq, const float* w, float* out) {
    const int gw = F.vcu * NWAVES + F.wave, NGW = F.G * NWAVES, lane = F.lane;
    for (int m = gw; m < M; m += NGW) {
        const float part = lane < 32 ? ssq[(size_t)m * 32 + lane] : 0.f;
        const float rstd = 1.0f / sqrtf(wave_sum(part) * (1.f / D) + EPS);
        const f32x4* xr = (const f32x4*)(x + (size_t)m * D) + lane; f32x4* orow = (f32x4*)(out + (size_t)m * D) + lane;
        const unsigned long long* zr = (const unsigned long long*)(Zb + (size_t)m * D) + lane;
#pragma unroll
        for (int j = 0; j < 8; ++j) { const f32x4 xv = xr[64 * j]; const unsigned long long zz = zr[64 * j]; const f32x4 wv = *((const f32x4*)w + lane + 64 * j);
            const unsigned lo = (unsigned)zz, hi = (unsigned)(zz >> 32);
            f32x4 o; o.x = xv.x + pg8::bf_lo(lo) * rstd * wv.x; o.y = xv.y + pg8::bf_hi(lo) * rstd * wv.y; o.z = xv.z + pg8::bf_lo(hi) * rstd * wv.z; o.w = xv.w + pg8::bf_hi(hi) * rstd * wv.w;
            orow[64 * j] = o; }
    }
}
struct Args { const float* in[10]; float* out; unsigned char* ws; int ph_lo, ph_hi, li, pad; };
constexpr int N_PHASES = 9;
__global__ void __launch_bounds__(NWAVES * 64, 2) fwd_kernel(Args args) {
    extern __shared__ __attribute__((aligned(16))) unsigned char lds[];
    Frame F;
    F.lds = (LAS unsigned char*)lds;
    F.MISC = (volatile LAS unsigned*)(F.lds + MISC_OFF);
    F.tid = threadIdx.x; F.lane = F.tid & 63; F.wave = __builtin_amdgcn_readfirstlane(F.tid >> 6);
    F.G = gridDim.x; { const int bx = blockIdx.x; F.vcu = (F.G % 8 == 0) ? (bx % 8) * (F.G / 8) + bx / 8 : bx; }
    unsigned char* ws = args.ws;
    F.ctl = (gu32*)(ws + WS_CTL);
    const float* x = args.in[0]; const float* w_pre = args.in[1]; const float* w_in = args.in[2]; const float* b_gate = args.in[3]; const float* rpb = args.in[4];
    const float* lb_logits = args.in[5]; const float* hg_norm_w = args.in[6]; const float* w_br = args.in[7]; const float* w_out = args.in[8]; const float* w_post = args.in[9];
    bf16* WIN_T = (bf16*)(ws + WS_WIN); bf16* WBA_T = (bf16*)(ws + WS_WBA); bf16* WBB_T = (bf16*)(ws + WS_WBB); bf16* WOUT_T = (bf16*)(ws + WS_WOUT);
    bf16* H = (bf16*)(ws + WS_H);
    float* SSQ = (float*)(ws + WS_SSQ);
    bf16* XN = (bf16*)args.out;
    float* OFWD = args.out; float* OBWD = args.out + (size_t)M * PW;
    bf16* OA = H + P_NQ * PIECE_ELEMS; bf16* OB = H + P_HQ * PIECE_ELEMS; bf16* YA = H + P_NK * PIECE_ELEMS; bf16* Y = H + P_HFF * PIECE_ELEMS; bf16* Zb = H + P_HI * PIECE_ELEMS;
    for (int u = F.tid; u < (LDS_BYTES - LDSCTL_OFF) / 4; u += NWAVES * 64) ((LAS unsigned*)(F.lds + LDSCTL_OFF))[u] = 0u;
    __syncthreads();
    XcdBarrier bar = xcd_barrier_post((unsigned*)(F.ctl + CW_BAR) + args.li * XCD_BAR_WORDS, F.MISC + 8);
    const int lo = args.ph_lo, hi = args.ph_hi;
#define IN(k) (lo <= (k) && (k) < hi)
#define BOTH(k) (IN(k) && IN((k) + 1))
#define GRID_BAR() xcd_barrier(bar)

    if (IN(0)) { p0_prologue(F, x, w_pre, w_in, w_br, w_out, XN, WIN_T, WBA_T, WBB_T, WOUT_T); if (BOTH(0)) GRID_BAR(); }
    if (IN(1)) {
        pg8::Gemm g{XN, WIN_T, M, INC, D}; pg8::StaticOrder S; S.init(M, INC, F.G, (int)blockIdx.x);
        pg8::EpiBf16 E{H, PW, PW, PIECE_ELEMS, 0.125f};
        pg8::gemm_phase<pg8::EpiBf16, pg8::StaticOrder, true, true>(F.lds + RING_OFF, g, S, E);
        if (BOTH(1)) GRID_BAR();
    }
    float* SLOC = (float*)(ws + WS_SLOC); float* DSEG = (float*)(ws + WS_DSEG);
    if (IN(2)) {
        for (int u = blockIdx.x; u < 16 * HG_NSEG; u += F.G) { const int hd = u / HG_NSEG, j = u % HG_NSEG, head = hd >> 1, dir = hd & 1;
            const int c0 = dir ? (M / 64 - HG_SEGC * (j + 1)) : HG_SEGC * j;
            hg_unit<true>(F, head, dir, c0, HG_SEGC, H + P_HQ * PIECE_ELEMS, H + (dir ? P_HFB : P_HFF) * PIECE_ELEMS, H + P_HI * PIECE_ELEMS, lb_logits, nullptr,
                          SLOC + (size_t)u * HGD * HGD, DSEG + (size_t)u * HGD, nullptr); }
        for (int u = blockIdx.x; u < NAH * (GROWS / 16); u += F.G) na_unit(F, u & 15, (u >> 4) * 16, H + P_NQ * PIECE_ELEMS, H + P_NK * PIECE_ELEMS, H + P_NV * PIECE_ELEMS, H + P_NZ * PIECE_ELEMS, rpb);
        if (BOTH(2)) GRID_BAR();
    }
    if (IN(3)) {
        for (int e = F.vcu * NWAVES * 64 + F.tid; e < 16 * HGD * HGD; e += F.G * NWAVES * 64) { const int hd = e / (HGD * HGD), el = e % (HGD * HGD), dk = el / HGD;
            float* sp = SLOC + (size_t)hd * HG_NSEG * HGD * HGD + el; const float* dp = DSEG + (size_t)hd * HG_NSEG * HGD + dk; float S = 0.f;
#pragma unroll 8
            for (int j = 0; j < HG_NSEG; ++j) { const float Lc = sp[(size_t)j * HGD * HGD]; sp[(size_t)j * HGD * HGD] = S; S = __builtin_amdgcn_exp2f(dp[j * HGD]) * S + Lc; } }
        if (BOTH(3)) GRID_BAR();
    }
    if (IN(4)) {
        for (int u = blockIdx.x; u < 16 * HG_NSEG; u += F.G) { const int hd = u / HG_NSEG, j = u % HG_NSEG, head = hd >> 1, dir = hd & 1;
            const int c0 = dir ? (M / 64 - HG_SEGC * (j + 1)) : HG_SEGC * j;
            hg_unit<false>(F, head, dir, c0, HG_SEGC, H + P_HQ * PIECE_ELEMS, H + (dir ? P_HFB : P_HFF) * PIECE_ELEMS, H + P_HI * PIECE_ELEMS, lb_logits,
                           SLOC + (size_t)u * HGD * HGD, nullptr, nullptr, dir ? OBWD : OFWD); }
        if (BOTH(4)) GRID_BAR();
    }
    if (IN(5)) { hg_finish(F, OFWD, OBWD, H + P_HZ * PIECE_ELEMS, hg_norm_w, OB); if (BOTH(5)) GRID_BAR(); }
    if (IN(6)) {
        { pg8::Gemm g{OA, WBA_T, M, D, PW}; pg8::StaticOrder S; S.init(M, D, F.G, (int)blockIdx.x);
          pg8::EpiGate<false> E{H + P_GA * PIECE_ELEMS, PIECE_ELEMS, b_gate, nullptr, YA, D};
          pg8::gemm_phase<pg8::EpiGate<false>, pg8::StaticOrder, true, true>(F.lds + RING_OFF, g, S, E); }
        { pg8::Gemm g{OB, WBB_T, M, D, PW}; pg8::StaticOrder S; S.init(M, D, F.G, (int)blockIdx.x);
          pg8::EpiGate<true> E{H + P_GB * PIECE_ELEMS, PIECE_ELEMS, b_gate + D, YA, Y, D};
          pg8::gemm_phase<pg8::EpiGate<true>, pg8::StaticOrder, true, true>(F.lds + RING_OFF, g, S, E); }
        if (BOTH(6)) GRID_BAR();
    }
    if (IN(7)) {
        pg8::Gemm g{Y, WOUT_T, M, D, D}; pg8::StaticOrder S; S.init(M, D, F.G, (int)blockIdx.x);
        pg8::EpiSsq E{Zb, D, SSQ};
        pg8::gemm_phase<pg8::EpiSsq, pg8::StaticOrder, true, true>(F.lds + RING_OFF, g, S, E);
        if (BOTH(7)) GRID_BAR();
    }
    if (IN(8)) { final_phase(F, x, Zb, SSQ, w_post, args.out); }
#undef IN
#undef BOTH
}

#ifndef MK_N_LAUNCHES
#define MK_N_LAUNCHES 1
#endif
extern "C" void kernel_launch(void* const* d_in, const int* in_sizes, int n_in, void* d_out, int out_size, void* d_ws, size_t ws_size, hipStream_t stream) {
    static int grid = 0;
    if (grid == 0) {
        if (n_in != 10 || in_sizes[0] != M * D || out_size != M * D || ws_size < WS_END) { fprintf(stderr, "kernel_launch: unexpected shapes: n_in %d in0 %d out %d ws %zu (need %zu)\n", n_in, n_in > 0 ? in_sizes[0] : -1, out_size, ws_size, (size_t)WS_END); grid = -1; return; }
        int dev = 0, cus = 0, per_cu = 0;
        if (hipGetDevice(&dev) != hipSuccess || hipDeviceGetAttribute(&cus, hipDeviceAttributeMultiprocessorCount, dev) != hipSuccess) { fprintf(stderr, "kernel_launch: device query failed\n"); grid = -1; return; }
        if (hipFuncSetAttribute((const void*)fwd_kernel, hipFuncAttributeMaxDynamicSharedMemorySize, LDS_BYTES) != hipSuccess) { fprintf(stderr, "kernel_launch: hipFuncSetAttribute failed\n"); grid = -1; return; }
        if (hipOccupancyMaxActiveBlocksPerMultiprocessor(&per_cu, (const void*)fwd_kernel, NWAVES * 64, LDS_BYTES) != hipSuccess || per_cu < 1) { fprintf(stderr, "kernel_launch: occupancy query reports %d blocks/CU; nothing launched\n", per_cu); (void)hipGetLastError(); grid = -1; return; }
        grid = cus;
    }
    if (grid < 0) return;
    if (hipMemsetAsync((char*)d_ws + WS_CTL, 0, CTL_ZERO_BYTES, stream) != hipSuccess) { fprintf(stderr, "kernel_launch: memset failed\n"); return; }
    Args a{};
    for (int i = 0; i < 10; ++i) a.in[i] = (const float*)d_in[i];
    a.out = (float*)d_out; a.ws = (unsigned char*)d_ws;
#if MK_N_LAUNCHES == 1
    a.ph_lo = 0; a.ph_hi = N_PHASES; a.li = 0;
    hipLaunchKernelGGL(fwd_kernel, dim3(grid), dim3(NWAVES * 64), LDS_BYTES, stream, a);
#else
    for (int li = 0; li < N_PHASES; ++li) { a.ph_lo = li; a.ph_hi = li + 1; a.li = li;
        hipLaunchKernelGGL(fwd_kernel, dim3(grid), dim3(NWAVES * 64), LDS_BYTES, stream, a); }
#endif
    const hipError_t le = hipPeekAtLastError();
    if (le != hipSuccess) fprintf(stderr, "kernel_launch: launch failed: %s\n", hipGetErrorName(le));
}
```

```cpp
#include <hip/hip_runtime.h>
#include <cstdio>
#include <cstdint>
namespace pg8 {
#define PG8_LAS __attribute__((address_space(3)))
typedef unsigned short bf16_t;
typedef short bf16x8 __attribute__((ext_vector_type(8)));
typedef float f32x4 __attribute__((ext_vector_type(4)));
typedef unsigned u32x4 __attribute__((ext_vector_type(4)));
constexpr int BM = 256, BK = 64, HALF = 128, HTB = HALF * BK * 2  , STAGE_BYTES = 8 * HTB, NXCD = 8, WGM = 8;

__host__ __device__ __forceinline__ int lds_byte(int r, int c) { const int st = (r >> 4) * 2 + (c >> 5), rr = r & 15, cc = c & 31, ob = rr * 64 + cc * 2; return st * 1024 + (ob ^ (((ob >> 9) & 1) << 5)); }
__host__ __device__ __forceinline__ void stage_rc(int b, int& R, int& C) { const int st = b / 1024, sb = b % 1024, swz = sb ^ (((sb >> 9) & 1) << 5); R = (st >> 1) * 16 + swz / 64; C = (st & 1) * 32 + (swz % 64) / 2; }
__host__ __device__ __forceinline__ int perm32(int rho) { const int n = rho >> 4, i = rho & 15; return 8 * (i >> 2) + 4 * n + (i & 3); }

struct Unit { int pm, pn; };
struct Gemm { const bf16_t* A; const bf16_t* Bt; int M, N, K; };

struct StaticOrder {
    int nM, nN, nwg, G, c;
    __host__ __device__ void init(int M, int N, int G_, int c_) { nM = M / BM; nN = N / BM; nwg = nM * nN; G = G_; c = c_; }
    __host__ __device__ bool next(int i, Unit& u) const {
        const long L = (long)i * G + c; if (L >= nwg) return false;
        int wgid = (int)L; { const int q = nwg / NXCD, r = nwg % NXCD, xcd = wgid % NXCD, off = wgid / NXCD; wgid = (xcd < r ? xcd * (q + 1) : r * (q + 1) + (xcd - r) * q) + off; }
        const int nig = WGM * nN, gid = wgid / nig, fm = gid * WGM, gsz = (nM - fm) < WGM ? (nM - fm) : WGM;
        u.pm = fm + ((wgid % nig) % gsz); u.pn = (wgid % nig) / gsz; return true;
    }
    __device__ __forceinline__ void a_ready(const Unit&) const {}
    __device__ __forceinline__ void done(const Unit&) const {}
};

typedef float f32x2c __attribute__((ext_vector_type(2)));
typedef __bf16 bf16x2c __attribute__((ext_vector_type(2)));
__device__ __forceinline__ unsigned cvt_pk_bf16(float lo, float hi) { const f32x2c v = {lo, hi}; return __builtin_bit_cast(unsigned, __builtin_convertvector(v, bf16x2c)); }
typedef float f32x2 __attribute__((ext_vector_type(2)));
struct EpiBf16 {
    static constexpr bool PERM = true, AFTER_DRAIN = false;
    bf16_t* O; int ldc; int split_cols; size_t split_stride; float scale0;
    __device__ __forceinline__ void operator()(const f32x4 (&acc)[2][2][4][2], const Unit& u, int wr, int wc, int fr, int fq) const {
        const int row0 = u.pm * BM + wr * 64 + fr; int colt = u.pn * BM; bf16_t* base = O;
        float sc = 1.f; if (split_cols) { const int t = colt / split_cols; base += (size_t)t * split_stride; colt -= t * split_cols; if (t == 0) sc = scale0; }
        const int col0 = colt + wc * 32 + 8 * fq;
#pragma unroll
        for (int ai = 0; ai < 2; ++ai)
#pragma unroll
            for (int m = 0; m < 4; ++m) { bf16_t* rowp = base + (size_t)(row0 + ai * HALF + m * 16) * ldc + col0;
#pragma unroll
                for (int bj = 0; bj < 2; ++bj) { f32x4 v0 = acc[ai][bj][m][0] * sc, v1 = acc[ai][bj][m][1] * sc;
                    u32x4 w; w.x = cvt_pk_bf16(v0[0], v0[1]); w.y = cvt_pk_bf16(v0[2], v0[3]); w.z = cvt_pk_bf16(v1[0], v1[1]); w.w = cvt_pk_bf16(v1[2], v1[3]);
                    *(u32x4*)(rowp + bj * HALF) = w; } }
    }
};
__device__ __forceinline__ float bf_lo(unsigned w) { return __builtin_bit_cast(float, w << 16); }
__device__ __forceinline__ float bf_hi(unsigned w) { return __builtin_bit_cast(float, w & 0xffff0000u); }
__device__ __forceinline__ float sigmoidf_(float x) { return __builtin_amdgcn_rcpf(1.0f + __builtin_amdgcn_exp2f(-1.44269504089f * x)); }
template <bool ADD> struct EpiGate {
    static constexpr bool PERM = true, AFTER_DRAIN = false;
    const bf16_t* G; size_t piece_stride; const float* bg; const bf16_t* prev; bf16_t* O; int ldc;
    __device__ __forceinline__ void operator()(const f32x4 (&acc)[2][2][4][2], const Unit& u, int wr, int wc, int fr, int fq) const {
        const int row0 = u.pm * BM + wr * 64 + fr; const int col0 = u.pn * BM + wc * 32 + 8 * fq;
        f32x4 bv[2][2];
#pragma unroll
        for (int bj = 0; bj < 2; ++bj)
#pragma unroll
            for (int n = 0; n < 2; ++n) bv[bj][n] = *(const f32x4*)(bg + col0 + bj * HALF + 4 * n);
#pragma unroll
        for (int ai = 0; ai < 2; ++ai)
#pragma unroll
            for (int m = 0; m < 4; ++m) { const int row = row0 + ai * HALF + m * 16;
#pragma unroll
                for (int bj = 0; bj < 2; ++bj) { const int col = col0 + bj * HALF;
                    const u32x4 gw = *(const u32x4*)(G + (size_t)(col >> 10) * piece_stride + (size_t)row * 1024 + (col & 1023));
                    f32x4 v0 = acc[ai][bj][m][0], v1 = acc[ai][bj][m][1];
                    v0[0] *= sigmoidf_(bf_lo(gw.x) + bv[bj][0][0]); v0[1] *= sigmoidf_(bf_hi(gw.x) + bv[bj][0][1]);
                    v0[2] *= sigmoidf_(bf_lo(gw.y) + bv[bj][0][2]); v0[3] *= sigmoidf_(bf_hi(gw.y) + bv[bj][0][3]);
                    v1[0] *= sigmoidf_(bf_lo(gw.z) + bv[bj][1][0]); v1[1] *= sigmoidf_(bf_hi(gw.z) + bv[bj][1][1]);
                    v1[2] *= sigmoidf_(bf_lo(gw.w) + bv[bj][1][2]); v1[3] *= sigmoidf_(bf_hi(gw.w) + bv[bj][1][3]);
                    if (ADD) { const u32x4 pw = *(const u32x4*)(prev + (size_t)row * ldc + col);
                        v0[0] += bf_lo(pw.x); v0[1] += bf_hi(pw.x); v0[2] += bf_lo(pw.y); v0[3] += bf_hi(pw.y);
                        v1[0] += bf_lo(pw.z); v1[1] += bf_hi(pw.z); v1[2] += bf_lo(pw.w); v1[3] += bf_hi(pw.w); }
                    u32x4 w; w.x = cvt_pk_bf16(v0[0], v0[1]); w.y = cvt_pk_bf16(v0[2], v0[3]); w.z = cvt_pk_bf16(v1[0], v1[1]); w.w = cvt_pk_bf16(v1[2], v1[3]);
                    *(u32x4*)(O + (size_t)row * ldc + col) = w; }
                asm volatile("" ::: "memory"); }
    }
};
struct EpiSsq {
    static constexpr bool PERM = true, AFTER_DRAIN = false;
    bf16_t* O; int ldc; float* ssq;
    __device__ __forceinline__ void operator()(const f32x4 (&acc)[2][2][4][2], const Unit& u, int wr, int wc, int fr, int fq) const {
        const int row0 = u.pm * BM + wr * 64 + fr; const int col0 = u.pn * BM + wc * 32 + 8 * fq;
#pragma unroll
        for (int ai = 0; ai < 2; ++ai)
#pragma unroll
            for (int m = 0; m < 4; ++m) { const int row = row0 + ai * HALF + m * 16; float ss = 0.f;
#pragma unroll
                for (int bj = 0; bj < 2; ++bj) { const f32x4 v0 = acc[ai][bj][m][0], v1 = acc[ai][bj][m][1];
                    ss += (v0[0] * v0[0] + v0[1] * v0[1]) + (v0[2] * v0[2] + v0[3] * v0[3]) + (v1[0] * v1[0] + v1[1] * v1[1]) + (v1[2] * v1[2] + v1[3] * v1[3]);
                    u32x4 w; w.x = cvt_pk_bf16(v0[0], v0[1]); w.y = cvt_pk_bf16(v0[2], v0[3]); w.z = cvt_pk_bf16(v1[0], v1[1]); w.w = cvt_pk_bf16(v1[2], v1[3]);
                    *(u32x4*)(O + (size_t)row * ldc + col0 + bj * HALF) = w; }
                ss += __shfl_xor(ss, 16); ss += __shfl_xor(ss, 32);
                if (fq == 0) ssq[(size_t)row * 32 + u.pn * 4 + wc] = ss; }
    }
};

template <class Epi, class Sched, bool ALIGN_EPI = false, bool SP2 = false>
__device__ __forceinline__ void gemm_phase(PG8_LAS unsigned char* lds, const Gemm g, const Sched& S, const Epi& E) {
    const int tid = threadIdx.x, wid = __builtin_amdgcn_readfirstlane(tid >> 6), lane = tid & 63, wr = wid >> 2, wc = wid & 3, fr = lane & 15, fq = lane >> 4;
    const int K = g.K, nt = K / BK;
    unsigned voffA[2], voffB[2];
#pragma unroll
    for (int i = 0; i < 2; ++i) { int R, C; stage_rc(tid * 16 + i * 8192, R, C); const int Rb = Epi::PERM ? ((R & ~31) + perm32(R & 31)) : R;
        voffA[i] = (unsigned)(R * K + C) * 2u; voffB[i] = (unsigned)(Rb * K + C) * 2u; }
    const size_t kstep = (size_t)(BK * 2);
    const size_t hstep = (size_t)HALF * K * 2;
    const size_t tstep = 2 * hstep;
    const unsigned ldsw = (unsigned)wid * 1024u;
    const int aoff = lds_byte(wr * 64 + fr, fq * 8), boff = lds_byte(wc * 32 + fr, fq * 8);
#define PG8_SA(b, h) (((b) * 2 + (h)) * HTB)
#define PG8_SB(b, h) ((4 + (b) * 2 + (h)) * HTB)
#define PG8_STAGE(bufoff, gbase, voff) do { _Pragma("unroll") for (int _i = 0; _i < 2; ++_i) \
        __builtin_amdgcn_global_load_lds((const unsigned*)((const char*)(gbase) + (voff)[_i]), (PG8_LAS unsigned*)(lds + (bufoff) + ldsw + _i * 8192), 16, 0, 0); } while (0)
#define PG8_LDA(dst, b, h) do { _Pragma("unroll") for (int m = 0; m < 4; ++m) _Pragma("unroll") for (int k = 0; k < 2; ++k) dst[m][k] = *(const PG8_LAS bf16x8*)(lds + PG8_SA(b, h) + aoff + m * 2048 + k * 1024); } while (0)
#define PG8_LDB(dst, b, h) do { _Pragma("unroll") for (int n = 0; n < 2; ++n) _Pragma("unroll") for (int k = 0; k < 2; ++k) dst[n][k] = *(const PG8_LAS bf16x8*)(lds + PG8_SB(b, h) + boff + n * 2048 + k * 1024); } while (0)
#define PG8_MMA(ai, bj, At, Bt) do { __builtin_amdgcn_s_setprio(1); _Pragma("unroll") for (int m = 0; m < 4; ++m) _Pragma("unroll") for (int n = 0; n < 2; ++n) _Pragma("unroll") for (int k = 0; k < 2; ++k) \
        acc[ai][bj][m][n] = __builtin_amdgcn_mfma_f32_16x16x32_bf16(Bt[n][k], At[m][k], acc[ai][bj][m][n], 0, 0, 0); __builtin_amdgcn_s_setprio(0); } while (0)
#define PG8_WAIT_V(n) asm volatile("s_waitcnt vmcnt(" #n ")" ::: "memory")
#define PG8_WAIT_L(n) asm volatile("s_waitcnt lgkmcnt(" #n ")" ::: "memory")
#define PG8_BAR __builtin_amdgcn_s_barrier()
#define PG8_SCHED __builtin_amdgcn_sched_barrier(0)
    Unit cur, nxt; int ui = 0;
    if (!S.next(0, cur)) return;
    f32x4 acc[2][2][4][2];
#pragma unroll
    for (int a = 0; a < 2; ++a)
#pragma unroll
        for (int b = 0; b < 2; ++b)
#pragma unroll
            for (int m = 0; m < 4; ++m)
#pragma unroll
                for (int n = 0; n < 2; ++n) acc[a][b][m][n] = (f32x4){0.f, 0.f, 0.f, 0.f};
    bf16x8 At[4][2], B0[2][2], B1[2][2];
    const char* cA = (const char*)g.A + (size_t)cur.pm * tstep; const char* cB = (const char*)g.Bt + (size_t)cur.pn * tstep;
    S.a_ready(cur);
    if constexpr (SP2) {
        PG8_STAGE(PG8_SB(0, 0), cB, voffB); PG8_STAGE(PG8_SB(0, 1), cB + hstep, voffB); PG8_STAGE(PG8_SA(0, 0), cA, voffA); PG8_STAGE(PG8_SA(0, 1), cA + hstep, voffA);
        if (wr == 1) PG8_BAR;
        PG8_WAIT_V(2); PG8_BAR;
        PG8_STAGE(PG8_SB(1, 0), cB + kstep, voffB); PG8_STAGE(PG8_SA(1, 0), cA + kstep, voffA); PG8_STAGE(PG8_SB(1, 1), cB + hstep + kstep, voffB);
        PG8_WAIT_V(6); PG8_BAR;
    } else {
        PG8_STAGE(PG8_SB(0, 0), cB, voffB); PG8_STAGE(PG8_SA(0, 0), cA, voffA); PG8_STAGE(PG8_SB(0, 1), cB + hstep, voffB); PG8_STAGE(PG8_SA(0, 1), cA + hstep, voffA);
        if (wr == 1) PG8_BAR;
        PG8_WAIT_V(4); PG8_BAR;
        PG8_STAGE(PG8_SB(1, 0), cB + kstep, voffB); PG8_STAGE(PG8_SA(1, 0), cA + kstep, voffA); PG8_STAGE(PG8_SB(1, 1), cB + hstep + kstep, voffB);
        PG8_WAIT_V(6); PG8_BAR;
    }
    for (;;) {
        const bool has_next = S.next(ui + 1, nxt);
        const char* nA = has_next ? (const char*)g.A + (size_t)nxt.pm * tstep : cA; const char* nB = has_next ? (const char*)g.Bt + (size_t)nxt.pn * tstep : cB;
        for (int t = 0; t < nt; t += 2) {
            const bool last = (t == nt - 2);
            const char* a1 = cA + (size_t)(t + 1) * kstep;
            const char* a2 = last ? nA : cA + (size_t)(t + 2) * kstep; const char* b2 = last ? nB : cB + (size_t)(t + 2) * kstep;
            const char* a3 = a2 + kstep; const char* b3 = b2 + kstep;
            if (last && has_next) S.a_ready(nxt);
            if constexpr (SP2) {
            PG8_LDB(B0, 0, 0); PG8_LDB(B1, 0, 1); PG8_SCHED; PG8_LDA(At, 0, 0); PG8_STAGE(PG8_SA(1, 1), a1 + hstep, voffA);
            PG8_WAIT_V(8); PG8_WAIT_L(0); PG8_BAR; PG8_MMA(0, 0, At, B0); PG8_MMA(0, 1, At, B1); PG8_BAR; PG8_SCHED;
            PG8_LDA(At, 0, 1); PG8_STAGE(PG8_SB(0, 0), b2, voffB); PG8_STAGE(PG8_SB(0, 1), b2 + hstep, voffB); PG8_STAGE(PG8_SA(0, 0), a2, voffA);
            PG8_WAIT_V(8); PG8_WAIT_L(0); PG8_BAR; PG8_MMA(1, 0, At, B0); PG8_MMA(1, 1, At, B1); PG8_BAR; PG8_SCHED;
            PG8_LDB(B0, 1, 0); PG8_LDB(B1, 1, 1); PG8_SCHED; PG8_LDA(At, 1, 0); PG8_STAGE(PG8_SA(0, 1), a2 + hstep, voffA);
            PG8_WAIT_V(8); PG8_WAIT_L(0); PG8_BAR; PG8_MMA(0, 0, At, B0); PG8_MMA(0, 1, At, B1); PG8_BAR; PG8_SCHED;
            PG8_LDA(At, 1, 1); PG8_STAGE(PG8_SB(1, 0), b3, voffB); PG8_STAGE(PG8_SB(1, 1), b3 + hstep, voffB); PG8_STAGE(PG8_SA(1, 0), a3, voffA);
            PG8_WAIT_V(8); PG8_WAIT_L(0); PG8_BAR; PG8_MMA(1, 0, At, B0); PG8_MMA(1, 1, At, B1); PG8_BAR; PG8_SCHED;
            } else {
            PG8_LDB(B0, 0, 0); PG8_SCHED; PG8_LDA(At, 0, 0); PG8_STAGE(PG8_SA(1, 1), a1 + hstep, voffA);
            PG8_WAIT_L(8); PG8_BAR; PG8_WAIT_L(0); PG8_MMA(0, 0, At, B0); PG8_BAR; PG8_SCHED;
            PG8_LDB(B1, 0, 1); PG8_STAGE(PG8_SB(0, 0), b2, voffB);
            PG8_BAR; PG8_WAIT_L(0); PG8_MMA(0, 1, At, B1); PG8_BAR;
            PG8_LDA(At, 0, 1); PG8_STAGE(PG8_SA(0, 0), a2, voffA);
            PG8_BAR; PG8_WAIT_L(0); PG8_MMA(1, 0, At, B0); PG8_BAR; PG8_SCHED;
            PG8_STAGE(PG8_SB(0, 1), b2 + hstep, voffB);
            PG8_WAIT_V(6); PG8_BAR; PG8_MMA(1, 1, At, B1); PG8_BAR;
            PG8_LDB(B0, 1, 0); PG8_SCHED; PG8_LDA(At, 1, 0); PG8_STAGE(PG8_SA(0, 1), a2 + hstep, voffA);
            PG8_WAIT_L(8); PG8_BAR; PG8_WAIT_L(0); PG8_MMA(0, 0, At, B0); PG8_BAR; PG8_SCHED;
            PG8_LDB(B1, 1, 1); PG8_STAGE(PG8_SB(1, 0), b3, voffB);
            PG8_BAR; PG8_WAIT_L(0); PG8_MMA(0, 1, At, B1); PG8_BAR;
            PG8_LDA(At, 1, 1); PG8_STAGE(PG8_SA(1, 0), a3, voffA);
            PG8_BAR; PG8_WAIT_L(0); PG8_MMA(1, 0, At, B0); PG8_BAR; PG8_SCHED;
            PG8_STAGE(PG8_SB(1, 1), b3 + hstep, voffB);
            PG8_WAIT_V(6); PG8_BAR; PG8_MMA(1, 1, At, B1); PG8_BAR;
            }
        }
        if constexpr (ALIGN_EPI) { if (wr == 0) PG8_BAR; }
        if constexpr (!Epi::AFTER_DRAIN) { E(acc, cur, wr, wc, fr, fq); S.done(cur); }
        if (!has_next) break;
#pragma unroll
        for (int a = 0; a < 2; ++a)
#pragma unroll
            for (int b = 0; b < 2; ++b)
#pragma unroll
                for (int m = 0; m < 4; ++m)
#pragma unroll
                    for (int n = 0; n < 2; ++n) acc[a][b][m][n] = (f32x4){0.f, 0.f, 0.f, 0.f};
        cur = nxt; cA = nA; cB = nB; ++ui;
        if constexpr (ALIGN_EPI) { if (wr == 1) PG8_BAR; }
    }
    PG8_WAIT_V(0);
    if constexpr (!ALIGN_EPI) { if (wr == 0) PG8_BAR; }
    PG8_BAR;
    if constexpr (Epi::AFTER_DRAIN) { E.fused(acc, cur, wr, wc, fr, fq, lds, wid, lane); S.done(cur); }
#undef PG8_SA
#undef PG8_SB
#undef PG8_STAGE
#undef PG8_LDA
#undef PG8_LDB
#undef PG8_MMA
#undef PG8_WAIT_V
#undef PG8_WAIT_L
#undef PG8_BAR
#undef PG8_SCHED
}
}
constexpr int NWAVES = 8;
constexpr int M = 16384, D = 2048, INC = 13312, PW = 1024, NPIECE = 13;
constexpr int GW = 64, GROWS = 256;
constexpr int NAH = 16, NADH = 64, HGH = 8, HGD = 128;
constexpr float EPS = 1e-6f;
enum { P_NQ = 0, P_NK = 1, P_NV = 2, P_NZ = 3, P_HQ = 4, P_HFF = 5, P_HFB = 6, P_HI = 7, P_HZ = 8, P_GA = 9, P_GB = 11 };
constexpr size_t MiB = 1u << 20;
constexpr size_t WS_CTL = 0, CTL_ZERO_BYTES = 1 * MiB;
constexpr size_t WS_SSQ = 2 * MiB;
constexpr size_t WS_WIN = 4 * MiB;
constexpr size_t WS_WBA = 56 * MiB, WS_WBB = 60 * MiB;
constexpr size_t WS_WOUT = 64 * MiB;
constexpr size_t WS_H = 72 * MiB;
constexpr size_t PIECE_BYTES = (size_t)M * PW * 2, PIECE_ELEMS = (size_t)M * PW;
constexpr size_t WS_END = WS_H + NPIECE * PIECE_BYTES;
static_assert(WS_WIN + (size_t)INC * D * 2 <= WS_WBA && WS_WOUT + (size_t)D * D * 2 <= WS_H, "ws map");
constexpr size_t WS_SLOC = 4 * MiB, WS_DSEG = 36 * MiB;
constexpr int HG_SEGC = 8, HG_NSEG = 32;
constexpr int CW_BAR = 4096;
constexpr int RING_OFF = 0, RING_BYTES = 150528;
constexpr int LDSCTL_OFF = RING_BYTES, MISC_OFF = LDSCTL_OFF + 320;
constexpr int LDS_BYTES = 152576;
#define GAS __attribute__((address_space(1)))
#define LAS __attribute__((address_space(3)))
typedef unsigned short bf16;
typedef unsigned v4u __attribute__((ext_vector_type(4)));
typedef float f32x4 __attribute__((ext_vector_type(4)));
typedef short bf16x8 __attribute__((ext_vector_type(8)));
typedef GAS unsigned gu32;
typedef GAS unsigned long long gu64;
#define RLX_AGENT __ATOMIC_RELAXED, __HIP_MEMORY_SCOPE_AGENT
#define LDS_WAIT() asm volatile("s_waitcnt lgkmcnt(0)" ::: "memory")
#define VM_WAIT() asm volatile("s_waitcnt vmcnt(0)" ::: "memory")
__device__ __forceinline__ unsigned long long rt() { return __builtin_amdgcn_s_memrealtime(); }
__device__ __forceinline__ unsigned f2bf(float f) { unsigned u = __builtin_bit_cast(unsigned, f); return (u + 0x7fffu + ((u >> 16) & 1u)) >> 16; }
__device__ __forceinline__ unsigned pk2(float lo, float hi) { return pg8::cvt_pk_bf16(lo, hi); }

#define XB_TMO      128
#define XB_XCNT(j)  (256  + 64 * (j))
#define XB_XSUB(j)  (1280 + 64 * (j))
#define XB_XGEN(j)  (2304 + 64 * (j))
#define XB_TOP      3328
#define XB_TOPGEN   3392
#define XCD_BAR_WORDS 3456
#define XB_SPIN_CAP (1u << 18)

__device__ __forceinline__ unsigned xb_ld(unsigned* p)              { return __hip_atomic_load(p, __ATOMIC_RELAXED, __HIP_MEMORY_SCOPE_AGENT); }
__device__ __forceinline__ unsigned xb_add(unsigned* p, unsigned v) { return __hip_atomic_fetch_add(p, v, __ATOMIC_RELAXED, __HIP_MEMORY_SCOPE_AGENT); }
__device__ __forceinline__ unsigned xb_xcc_id() { return (unsigned)__builtin_amdgcn_s_getreg((3 << 11) | 20) & 0xFu; }
#define XB_SPIN(cond, bar) do { unsigned _sp = 0; while (cond) { __builtin_amdgcn_s_sleep(1); \
    if ((++_sp & 255u) == 0u) { if (xb_ld(&(bar)[XB_TMO])) break; if (_sp > XB_SPIN_CAP) { atomicAdd(&(bar)[XB_TMO], 1u); break; } } } } while (0)

struct XcdBarrier {
    unsigned* bar; unsigned x;
    volatile LAS unsigned* st;
};

__device__ __forceinline__ XcdBarrier xcd_barrier_post(unsigned* bar, volatile LAS unsigned* st) {
    XcdBarrier b; b.bar = bar; b.x = xb_xcc_id(); b.st = st;
    if (threadIdx.x == 0) (void)xb_add(&bar[XB_XCNT(b.x)], 1u);
    return b;
}
__device__ __forceinline__ void xcd_barrier_complete(unsigned* bar, unsigned x, unsigned& nloc, unsigned& nx) {
    const unsigned G = gridDim.x * gridDim.y * gridDim.z;
    unsigned sum, cnt, mine, sp = 0u;
    for (;;) {
        sum = 0u; cnt = 0u; mine = 0u;
#pragma unroll
        for (unsigned j = 0; j < 16; ++j) { const unsigned c = xb_ld(&bar[XB_XCNT(j)]); sum += c; cnt += (c > 0u) ? 1u : 0u; mine = (j == x) ? c : mine; }
        if (sum == G) break;
        __builtin_amdgcn_s_sleep(1);
        if ((++sp & 255u) == 0u) { if (xb_ld(&bar[XB_TMO])) break; if (sp > XB_SPIN_CAP) { atomicAdd(&bar[XB_TMO], 1u); break; } }
    }
    nloc = mine > 0u ? mine : 1u; nx = cnt > 0u ? cnt : 1u;
}

__device__ __forceinline__ void xcd_barrier(const XcdBarrier& b) {
    asm volatile("s_waitcnt vmcnt(0)" ::: "memory");
    __syncthreads();
    if (threadIdx.x == 0) {
        unsigned* bar = b.bar;
        __builtin_amdgcn_s_waitcnt(0);
        unsigned nloc = b.st[0], nx = b.st[1];
        if (nloc == 0u) { xcd_barrier_complete(bar, b.x, nloc, nx); b.st[0] = nloc; b.st[1] = nx; }
        const unsigned old = xb_add(&bar[XB_XSUB(b.x)], 1u);
        const unsigned gen = old / nloc;
        if (old + 1u == (gen + 1u) * nloc) {
            __builtin_amdgcn_fence(__ATOMIC_RELEASE, "agent");
            asm volatile("s_waitcnt vmcnt(0)" ::: "memory");
            const unsigned og = xb_add(&bar[XB_TOP], 1u);
            const unsigned tg = og / nx;
            if (og + 1u == (tg + 1u) * nx) xb_add(&bar[XB_TOPGEN], 1u);
            else XB_SPIN(xb_ld(&bar[XB_TOPGEN]) == tg, bar);
            __builtin_amdgcn_fence(__ATOMIC_ACQUIRE, "agent");
            xb_add(&bar[XB_XGEN(b.x)], 1u);
            asm volatile("s_waitcnt vmcnt(0)" ::: "memory");
        } else {
            XB_SPIN(xb_ld(&bar[XB_XGEN(b.x)]) == gen, bar);
            __builtin_amdgcn_fence(__ATOMIC_ACQUIRE, "agent");
            asm volatile("s_waitcnt vmcnt(0)" ::: "memory");
        }
    }
    __syncthreads();
}
__device__ __forceinline__ float wave_sum(float v) {
#pragma unroll
    for (int o = 1; o < 64; o <<= 1) v += __shfl_xor(v, o);
    return v;
}
__device__ __forceinline__ void p0_transpose_item(const float* W, int K, int N, bf16* WT, int row_off, LAS float* scr, int item, int lane) {
    const int nblk = N / 32, kb = item / nblk, nb = item % nblk, k0 = 64 * kb, n0 = 32 * nb;
#pragma unroll 8
    for (int i = 0; i < 32; ++i) { const int kk = 2 * i + (lane >> 5); scr[kk * 33 + (lane & 31)] = W[(size_t)(k0 + kk) * N + n0 + (lane & 31)]; }
    LDS_WAIT(); asm volatile("" ::: "memory");
    const int c = lane & 7;
#pragma unroll
    for (int j = 0; j < 4; ++j) { const int n = (lane >> 3) + 8 * j; const LAS float* s = scr + (8 * c) * 33 + n;
        v4u o; o.x = pk2(s[0 * 33], s[1 * 33]); o.y = pk2(s[2 * 33], s[3 * 33]); o.z = pk2(s[4 * 33], s[5 * 33]); o.w = pk2(s[6 * 33], s[7 * 33]);
        *(GAS v4u*)(WT + (size_t)(row_off + n0 + n) * K + k0 + 8 * c) = o; }
    LDS_WAIT(); asm volatile("" ::: "memory");
}
struct Frame {
    LAS unsigned char* lds;
    volatile LAS unsigned* MISC;
    gu32* ctl;
    int wave;
    __device__ __forceinline__ int lane_() const { return (int)__builtin_amdgcn_mbcnt_hi(~0u, __builtin_amdgcn_mbcnt_lo(~0u, 0u)); }
    __device__ __forceinline__ int tid_() const { return wave * 64 + lane_(); }
    int vcu, G;
};
__device__ __forceinline__ float bf2f(bf16 b) { return __builtin_bit_cast(float, (unsigned)b << 16); }
__device__ __forceinline__ float wave_max(float v) {
#pragma unroll
    for (int o = 1; o < 64; o <<= 1) v = fmaxf(v, __shfl_xor(v, o));
    return v;
}
__device__ __forceinline__ float sigm(float x) { return 1.0f / (1.0f + __expf(-x)); }

__device__ __forceinline__ void p0_prologue(Frame& F, const float* x, const float* w_pre, const float* w_in, const float* w_br, const float* w_out,
                                            bf16* XN, bf16* WIN_T, bf16* WBA_T, bf16* WBB_T, bf16* WOUT_T) {
    LAS float* scr = (LAS float*)(F.lds + RING_OFF + F.wave * 16384);
    const int gw = F.vcu * NWAVES + F.wave, NGW = F.G * NWAVES;
    constexpr int I_IN = (D / 64) * (INC / 32), I_BR = (PW / 64) * (D / 32), I_OUT = (D / 64) * (D / 32);
    constexpr int NITEMS = I_IN + 2 * I_BR + I_OUT;
    for (int it = gw; it < NITEMS; it += NGW) {
        int r = it;
        if (r < I_IN) { p0_transpose_item(w_in, D, INC, WIN_T, 0, scr, r, F.lane_()); continue; } r -= I_IN;
        if (r < I_BR) { p0_transpose_item(w_br, PW, D, WBA_T, 0, scr, r, F.lane_()); continue; } r -= I_BR;
        if (r < I_BR) { p0_transpose_item(w_br + (size_t)PW * D, PW, D, WBB_T, 0, scr, r, F.lane_()); continue; } r -= I_BR;
        p0_transpose_item(w_out, D, D, WOUT_T, 0, scr, r, F.lane_());
    }
    for (int m = gw; m < M; m += NGW) {
        const f32x4* xr = (const f32x4*)(x + (size_t)m * D) + F.lane_();
        f32x4 v[8]; float s = 0.f;
#pragma unroll
        for (int j = 0; j < 8; ++j) { v[j] = xr[64 * j]; s += (v[j].x * v[j].x + v[j].y * v[j].y) + (v[j].z * v[j].z + v[j].w * v[j].w); }
        const float rstd = 1.0f / sqrtf(wave_sum(s) * (1.f / D) + EPS);
        unsigned long long* o8 = (unsigned long long*)(XN + (size_t)m * D) + F.lane_();
#pragma unroll
        for (int j = 0; j < 8; ++j) { const f32x4 w = *((const f32x4*)w_pre + F.lane_() + 64 * j);
            o8[64 * j] = (unsigned long long)pk2(v[j].x * rstd * w.x, v[j].y * rstd * w.y) | ((unsigned long long)pk2(v[j].z * rstd * w.z, v[j].w * rstd * w.w) << 32); }
    }
}

__device__ __forceinline__ void na_naive(Frame& F, bf16* Q, const bf16* K, const bf16* V, const bf16* Z, const float* rpb) {
    const int gw = F.vcu * NWAVES + F.wave, NGW = F.G * NWAVES, lane = F.lane_();
    for (int it = gw; it < M * NAH; it += NGW) {
        const int h = it & 15, tq = it >> 4, r = tq >> 6, c = tq & 63;
        int rs = r - 4; rs = rs < 0 ? 0 : (rs > GROWS - 8 ? GROWS - 8 : rs);
        int cs = c - 8; cs = cs < 0 ? 0 : (cs > GW - 16 ? GW - 16 : cs);
        const v4u* qp = (const v4u*)(Q + (size_t)tq * PW + h * NADH);
        v4u qv[8];
#pragma unroll
        for (int i = 0; i < 8; ++i) qv[i] = qp[i];
        float sc[2];
#pragma unroll
        for (int e = 0; e < 2; ++e) {
            const int j = lane + 64 * e, kr = rs + (j >> 4), kc = cs + (j & 15), tk = kr * GW + kc;
            const v4u* kp = (const v4u*)(K + (size_t)tk * PW + h * NADH);
            float a = 0.f;
#pragma unroll
            for (int i = 0; i < 8; ++i) { const v4u kv = kp[i];
                a += pg8::bf_lo(qv[i].x) * pg8::bf_lo(kv.x) + pg8::bf_hi(qv[i].x) * pg8::bf_hi(kv.x) + pg8::bf_lo(qv[i].y) * pg8::bf_lo(kv.y) + pg8::bf_hi(qv[i].y) * pg8::bf_hi(kv.y)
                   + pg8::bf_lo(qv[i].z) * pg8::bf_lo(kv.z) + pg8::bf_hi(qv[i].z) * pg8::bf_hi(kv.z) + pg8::bf_lo(qv[i].w) * pg8::bf_lo(kv.w) + pg8::bf_hi(qv[i].w) * pg8::bf_hi(kv.w); }
            sc[e] = a * 0.125f + rpb[(h * 15 + (kr - r + 7)) * 31 + (kc - c + 15)];
        }
        const float mx = wave_max(fmaxf(sc[0], sc[1]));
        const float e0 = __expf(sc[0] - mx), e1 = __expf(sc[1] - mx);
        const float inv = 1.0f / wave_sum(e0 + e1);
        const float p0 = e0 * inv, p1 = e1 * inv;
        float o = 0.f;
        for (int j = 0; j < 64; ++j) {
            const int kr = rs + (j >> 4), kc = cs + (j & 15), tk = kr * GW + kc;
            const float pa = __shfl(p0, j), pb = __shfl(p1, j);
            o += pa * bf2f(V[(size_t)tk * PW + h * NADH + lane]);
            o += pb * bf2f(V[(size_t)(tk + 4 * GW) * PW + h * NADH + lane]);
        }
        const float z = bf2f(Z[(size_t)tq * PW + h * NADH + lane]);
        o *= z * sigm(z);
        Q[(size_t)tq * PW + h * NADH + lane] = (bf16)f2bf(o);
    }
}

__device__ __forceinline__ void hg_naive(Frame& F, const bf16* HQ, const bf16* HFF, const bf16* HFB, const bf16* HI, const float* lb_logits, float* OFWD, float* OBWD) {
    LAS float* red = (LAS float*)(F.lds + RING_OFF);
    for (int u = blockIdx.x; u < 256; u += F.G) {
        const int hd = u >> 4, head = hd >> 1, dir = hd & 1, dv0 = (u & 15) * 8;
        const int dk = F.tid_() & 127, part = F.tid_() >> 7;
        const int ch = head * HGD + dk;
        const float lbv = sigm(lb_logits[dir * 1024 + ch] - lb_logits[2048 + dir * 1024 + ch]);
        const bf16* FL = dir ? HFB : HFF; float* OUT = dir ? OBWD : OFWD;
        const int cv = head * HGD + dv0 + part * 2;
        float S0 = 0.f, S1 = 0.f;
        for (int cb = 0; cb < M / 64; ++cb) {
            LAS float* rb = red + (cb & 1) * 1024;
#pragma unroll 8
            for (int s = 0; s < 64; ++s) {
                const int step = cb * 64 + s, t = dir ? (M - 1 - step) : step;
                const float fl = bf2f(FL[(size_t)t * PW + ch]), q = bf2f(HQ[(size_t)t * PW + ch]);
                const unsigned vv = *(const unsigned*)(HI + (size_t)t * PW + cv);
                const float v0 = pg8::bf_lo(vv), v1 = pg8::bf_hi(vv);
                const float sg = sigm(fl), f = lbv + (1.f - lbv) * sg, k = (1.f - lbv) * (1.f - sg);
                S0 = f * S0 + k * v0; S1 = f * S1 + k * v1;
                const float p0 = wave_sum(S0 * q), p1 = wave_sum(S1 * q);
                if (F.lane_() == 0) { rb[(s * 8 + F.wave) * 2] = p0; rb[(s * 8 + F.wave) * 2 + 1] = p1; }
            }
            __syncthreads();
            { const int s = F.tid_() >> 3, j = F.tid_() & 7, pp = j >> 1, e = j & 1;
              const int step = cb * 64 + s, t = dir ? (M - 1 - step) : step;
              OUT[(size_t)t * PW + head * HGD + dv0 + j] = rb[(s * 8 + 2 * pp) * 2 + e] + rb[(s * 8 + 2 * pp + 1) * 2 + e]; }
        }
        __syncthreads();
    }
}
constexpr int HG_IM0 = 0, HG_IMSET = 49152  , HG_IMP = 2 * HG_IMSET, HG_PROW = 144, HG_IMS = HG_IMP + 64 * HG_PROW, HG_WTOT = HG_IMS + 8 * 4096, HG_EC = HG_WTOT + 4096  ,
              HG_PART = HG_EC + 2048, HG_LDS_END = HG_PART + 64 * 8 * 4;
static_assert(HG_LDS_END <= RING_BYTES, "hg lds");
__device__ __forceinline__ unsigned off_b(unsigned row, unsigned ch) { return 256u * row + 16u * (ch ^ (((row & 3) << 2) | ((row >> 2) & 3))); }
typedef short s16x4 __attribute__((ext_vector_type(4)));
typedef float f32x2 __attribute__((ext_vector_type(2)));
__device__ __forceinline__ pg8::bf16x8 tr_pair(const LAS unsigned char* a0, const LAS unsigned char* a1) {
    const s16x4 r0 = __builtin_amdgcn_ds_read_tr16_b64_v4i16((LAS s16x4*)a0), r1 = __builtin_amdgcn_ds_read_tr16_b64_v4i16((LAS s16x4*)a1);
    return __builtin_shufflevector(r0, r1, 0, 1, 2, 3, 4, 5, 6, 7);
}
#define MFMA16(a, b, c) __builtin_amdgcn_mfma_f32_16x16x32_bf16((a), (b), (c), 0, 0, 0)
__device__ __forceinline__ unsigned cvtpk(float lo, float hi) { return pg8::cvt_pk_bf16(lo, hi); }
__device__ __forceinline__ unsigned long long cvtpk4(const f32x4 v) { return (unsigned long long)cvtpk(v[0], v[1]) | ((unsigned long long)cvtpk(v[2], v[3]) << 32); }
struct HgRaw { unsigned f[8], q[8], v[8]; };
__device__ __forceinline__ void hg_load(HgRaw& R, __amdgpu_buffer_rsrc_t rs, unsigned offq, unsigned offf, unsigned offv, int c, int w, int lane, int chb) {
    const unsigned row0 = (unsigned)((64 * c + 8 * w) * PW + chb) * 2u;
#pragma unroll
    for (int i = 0; i < 8; ++i) { const unsigned so = row0 + (unsigned)i * (PW * 2u);
        R.f[i] = __builtin_amdgcn_raw_buffer_load_b32(rs, lane * 4, offf + so, 0); R.q[i] = __builtin_amdgcn_raw_buffer_load_b32(rs, lane * 4, offq + so, 0);
        R.v[i] = __builtin_amdgcn_raw_buffer_load_b32(rs, lane * 4, offv + so, 0); }
}
__device__ __forceinline__ void hg_pre(Frame& F, int head, int dir, int c0, int nch, bf16* Hbase, int pq, int pf_, int pv_, const float* lb_logits,
                                       unsigned char* QM, float* EC, float* S_out, float* Dseg_out) {
    LAS unsigned char* L = F.lds + RING_OFF;
    const int lane = F.lane_(), w = F.wave, tid = F.tid_();
    const int chb = head * HGD;
    float lbv[2], omlb[2];
#pragma unroll
    for (int e = 0; e < 2; ++e) { const int ch = chb + 2 * lane + e; lbv[e] = sigm(lb_logits[dir * 1024 + ch] - lb_logits[2048 + dir * 1024 + ch]); omlb[e] = 1.f - lbv[e]; }
    f32x4 S[8];
#pragma unroll
    for (int kt = 0; kt < 8; ++kt) S[kt] = (f32x4){0.f, 0.f, 0.f, 0.f};
    float dseg[2] = {0.f, 0.f}, cprev[2] = {1.f, 1.f};
    HgRaw R;
    const __amdgpu_buffer_rsrc_t rs = __builtin_amdgcn_make_buffer_rsrc((void*)Hbase, 0, (int)(NPIECE * PIECE_BYTES), 0x00020000);
    const unsigned offq = (unsigned)(pq * PIECE_BYTES), offf = (unsigned)(pf_ * PIECE_BYTES), offv = (unsigned)(pv_ * PIECE_BYTES);
    hg_load(R, rs, offq, offf, offv, dir ? (c0 + nch - 1) : c0, w, lane, chb);
    for (int ci = 0; ci < nch; ++ci) {
        const int c = dir ? (c0 + nch - 1 - ci) : (c0 + ci);
        int lane_v = lane; asm volatile("" : "+v"(lane_v));
        const int n = lane_v & 15, g = lane_v >> 4, q4 = n >> 2, p4 = n & 3;
        float Aloc[8][2], kk[8][2], qq[8][2]; unsigned vraw[8];
        float run0 = 0.f, run1 = 0.f;
#pragma unroll
        for (int ii = 0; ii < 8; ++ii) { const int i = dir ? 7 - ii : ii;
            const float s0 = pg8::sigmoidf_(pg8::bf_lo(R.f[i])), s1 = pg8::sigmoidf_(pg8::bf_hi(R.f[i]));
            run0 += __builtin_amdgcn_logf(lbv[0] + omlb[0] * s0); run1 += __builtin_amdgcn_logf(lbv[1] + omlb[1] * s1);
            kk[i][0] = omlb[0] - omlb[0] * s0; kk[i][1] = omlb[1] - omlb[1] * s1;
            qq[i][0] = pg8::bf_lo(R.q[i]); qq[i][1] = pg8::bf_hi(R.q[i]);
            vraw[i] = R.v[i]; Aloc[i][0] = run0; Aloc[i][1] = run1; }
        if (ci + 1 < nch) hg_load(R, rs, offq, offf, offv, dir ? (c - 1) : (c + 1), w, lane, chb);
        LAS float* WT = (LAS float*)(L + HG_WTOT);
        *(LAS f32x2*)(WT + w * 128 + 2 * lane) = (f32x2){run0, run1};
        __syncthreads();
        float pre0 = 0.f, pre1 = 0.f, ref0 = 0.f, ref1 = 0.f, tot0 = 0.f, tot1 = 0.f;
#pragma unroll
        for (int ww = 0; ww < 8; ++ww) { const f32x2 tv = *(LAS f32x2*)(WT + ww * 128 + 2 * lane);
            const bool before = dir ? (ww > w) : (ww < w), inref = dir ? (ww >= 4) : (ww < 4);
            if (before) { pre0 += tv.x; pre1 += tv.y; } if (inref) { ref0 += tv.x; ref1 += tv.y; } tot0 += tv.x; tot1 += tv.y; }
        dseg[0] += tot0; dseg[1] += tot1;
        unsigned char* qimg = QM + (size_t)(head * (M / 64) + c) * 16384;
        unsigned char* kimg = (unsigned char*)Hbase + (size_t)pf_ * PIECE_BYTES + ((size_t)(64 * c) * PW + chb) * 2;
#pragma unroll
        for (int i = 0; i < 8; ++i) {
            const int tau = 8 * w + i;
            const float d0 = pre0 + Aloc[i][0] - ref0, d1 = pre1 + Aloc[i][1] - ref1;
            const unsigned ob = off_b(tau, lane >> 2) + (lane & 3) * 4;
            const unsigned qm = cvtpk(qq[i][0] * __builtin_amdgcn_exp2f(d0), qq[i][1] * __builtin_amdgcn_exp2f(d1));
            const unsigned km = cvtpk(kk[i][0] * __builtin_amdgcn_exp2f(fminf(-d0, 120.f)), kk[i][1] * __builtin_amdgcn_exp2f(fminf(-d1, 120.f)));
            *(unsigned*)(qimg + ob) = qm;
            *(unsigned*)(kimg + (size_t)tau * (PW * 2) + (ob - 256u * tau)) = km;
            *(LAS unsigned*)(L + HG_IM0 + 16384 + ob) = km;
            *(LAS unsigned*)(L + HG_IM0 + 32768 + ob) = vraw[i];
        }
        if (w == 0) { const f32x2 er = (f32x2){__builtin_amdgcn_exp2f(ref0), __builtin_amdgcn_exp2f(ref1)};
                      const f32x2 fs = (f32x2){er.x * cprev[0], er.y * cprev[1]};
                      cprev[0] = __builtin_amdgcn_exp2f(tot0 - ref0); cprev[1] = __builtin_amdgcn_exp2f(tot1 - ref1);
                      *(LAS f32x2*)((LAS float*)(L + HG_EC) + 2 * lane) = fs;
                      *(LAS f32x2*)((LAS float*)(L + HG_EC) + 128 + 2 * lane) = (f32x2){cprev[0], cprev[1]};
                      *(f32x2*)(EC + (size_t)(head * (M / 64) + c) * 128 + 2 * lane) = (ci == 0) ? er : fs; }
        __syncthreads();
        f32x4 fsc[8];
#pragma unroll
        for (int kt = 0; kt < 8; ++kt) fsc[kt] = *(const LAS f32x4*)((LAS float*)(L + HG_EC) + 16 * kt + 4 * g);
        pg8::bf16x8 vf[2];
#pragma unroll
        for (int ks = 0; ks < 2; ++ks) vf[ks] = tr_pair(L + HG_IM0 + 32768 + off_b(32 * ks + 8 * g + q4, 2 * w + (p4 >> 1)) + 8 * (p4 & 1), L + HG_IM0 + 32768 + off_b(32 * ks + 8 * g + 4 + q4, 2 * w + (p4 >> 1)) + 8 * (p4 & 1));
#pragma unroll
        for (int kh = 0; kh < 2; ++kh) {
            pg8::bf16x8 kf[4][2];
#pragma unroll
            for (int k2 = 0; k2 < 4; ++k2) { const int kt = 4 * kh + k2;
                kf[k2][0] = tr_pair(L + HG_IM0 + 16384 + off_b(8 * g + q4, 2 * kt + (p4 >> 1)) + 8 * (p4 & 1), L + HG_IM0 + 16384 + off_b(8 * g + 4 + q4, 2 * kt + (p4 >> 1)) + 8 * (p4 & 1));
                kf[k2][1] = tr_pair(L + HG_IM0 + 16384 + off_b(32 + 8 * g + q4, 2 * kt + (p4 >> 1)) + 8 * (p4 & 1), L + HG_IM0 + 16384 + off_b(32 + 8 * g + 4 + q4, 2 * kt + (p4 >> 1)) + 8 * (p4 & 1)); }
#pragma unroll
            for (int k2 = 0; k2 < 4; ++k2) { const int kt = 4 * kh + k2; S[kt] = S[kt] * fsc[kt]; S[kt] = MFMA16(kf[k2][0], vf[0], S[kt]); S[kt] = MFMA16(kf[k2][1], vf[1], S[kt]); }
        }
    }
    __syncthreads();
#pragma unroll
    for (int kt = 0; kt < 8; ++kt) { const f32x4 c4 = *(const LAS f32x4*)((LAS float*)(L + HG_EC) + 128 + 16 * kt + 4 * (lane >> 4)); S[kt] = S[kt] * c4; }
    __syncthreads();
#pragma unroll
    for (int kt = 0; kt < 8; ++kt) ((f32x4*)S_out)[kt * 512 + tid] = S[kt];
    if (w == 0) { Dseg_out[2 * lane] = dseg[0]; Dseg_out[2 * lane + 1] = dseg[1]; }
}
struct HgImg { v4u q[2], k[2], v[2]; float ec; };
__device__ __forceinline__ void hg_img_load(HgImg& R, const unsigned char* qimg, const unsigned char* kimg, const unsigned char* vimg, const float* ec, int tid) {
#pragma unroll
    for (int j = 0; j < 2; ++j) { const int p = tid + 512 * j, tau = p >> 4, c16 = p & 15;
        R.q[j] = *(const v4u*)(qimg + 16 * p); R.k[j] = *(const v4u*)(kimg + (size_t)tau * (PW * 2) + 16 * c16); R.v[j] = *(const v4u*)(vimg + (size_t)tau * (PW * 2) + 16 * c16); }
    R.ec = ec[tid & 127];
}
template <int MODE>
__device__ __forceinline__ void hg_main(Frame& F, int head, int dir, int c0, int nch, const bf16* Hbase, int pf_, int pv_, const unsigned char* QM, const float* EC,
                                        const float* S_in, unsigned long long* SCR, const bf16* HZ, const float* wn, bf16* OB) {
    LAS unsigned char* L = F.lds + RING_OFF;
    const int lane = F.lane_(), w = F.wave, tid = F.tid_();
    const int chb = head * HGD;
    f32x4 S[8];
#pragma unroll
    for (int kt = 0; kt < 8; ++kt) S[kt] = ((const f32x4*)S_in)[kt * 512 + tid];
    const unsigned char* kbase = (const unsigned char*)Hbase + (size_t)pf_ * PIECE_BYTES + (size_t)chb * 2;
    const unsigned char* vbase = (const unsigned char*)Hbase + (size_t)pv_ * PIECE_BYTES + (size_t)chb * 2;
    f32x4 wv = (f32x4){0.f, 0.f, 0.f, 0.f};
    if (MODE == 2) wv = *(const f32x4*)(wn + chb + 16 * w + 4 * (lane >> 4));
    unsigned long long held[4] = {0ull, 0ull, 0ull, 0ull}; int c_held = -1;
    HgImg R;
    { const int c = dir ? (c0 + nch - 1) : c0; hg_img_load(R, QM + (size_t)(head * (M / 64) + c) * 16384, kbase + (size_t)(64 * c) * (PW * 2), vbase + (size_t)(64 * c) * (PW * 2), EC + (size_t)(head * (M / 64) + c) * 128, tid); }
    for (int ci = 0; ci < nch; ++ci) {
        const int c = dir ? (c0 + nch - 1 - ci) : (c0 + ci);
        int lane_v = lane; asm volatile("" : "+v"(lane_v));
        const int n = lane_v & 15, g = lane_v >> 4, q4 = n >> 2, p4 = n & 3;
        LAS unsigned char* IM = L + HG_IM0 + (ci & 1) * HG_IMSET;
        LAS float* ECL = (LAS float*)(L + HG_EC) + (ci & 1) * 128;
#pragma unroll
        for (int j = 0; j < 2; ++j) { const int p = tid + 512 * j, tau = p >> 4, c16 = p & 15;
            *(LAS v4u*)(IM + 16 * p) = R.q[j]; *(LAS v4u*)(IM + 16384 + 16 * p) = R.k[j]; *(LAS v4u*)(IM + 32768 + off_b(tau, c16)) = R.v[j]; }
        if (tid < 128) ECL[tid] = R.ec;
        if (c_held >= 0) {
#pragma unroll
            for (int tt = 0; tt < 4; ++tt) { if (MODE == 1) SCR[(size_t)((c_held - c0) * 4 + tt) * 512 + tid] = held[tt];
                else *(unsigned long long*)(OB + (size_t)(64 * c_held + 16 * tt + n) * PW + chb + 16 * w + 4 * g) = held[tt]; } }
        unsigned long long scr[4], zz4[4];
        if (MODE == 2) {
#pragma unroll
            for (int tt = 0; tt < 4; ++tt) { scr[tt] = SCR[(size_t)((c - c0) * 4 + tt) * 512 + tid]; zz4[tt] = *(const unsigned long long*)(HZ + (size_t)(64 * c + 16 * tt + n) * PW + chb + 16 * w + 4 * g); } }
        if (ci + 1 < nch) { const int cn = dir ? (c - 1) : (c + 1);
            hg_img_load(R, QM + (size_t)(head * (M / 64) + cn) * 16384, kbase + (size_t)(64 * cn) * (PW * 2), vbase + (size_t)(64 * cn) * (PW * 2), EC + (size_t)(head * (M / 64) + cn) * 128, tid); }
        __syncthreads();
        { const int tt = w >> 1;
          pg8::bf16x8 bq[4], ak[2][4]; f32x4 fsc[8];
#pragma unroll
          for (int ks = 0; ks < 4; ++ks) bq[ks] = *(const LAS pg8::bf16x8*)(IM + off_b(16 * tt + n, 4 * ks + g));
#pragma unroll
          for (int si = 0; si < 2; ++si)
#pragma unroll
              for (int ks = 0; ks < 4; ++ks) ak[si][ks] = *(const LAS pg8::bf16x8*)(IM + 16384 + off_b(16 * (2 * (w & 1) + si) + n, 4 * ks + g));
#pragma unroll
          for (int kt = 0; kt < 8; ++kt) fsc[kt] = *(const LAS f32x4*)(ECL + 16 * kt + 4 * g);
          f32x4 pacc[2];
#pragma unroll
          for (int si = 0; si < 2; ++si) { pacc[si] = (f32x4){0.f, 0.f, 0.f, 0.f};
#pragma unroll
              for (int ks = 0; ks < 4; ++ks) pacc[si] = MFMA16(ak[si][ks], bq[ks], pacc[si]); }
#pragma unroll
          for (int kt = 0; kt < 8; ++kt) S[kt] = S[kt] * fsc[kt];
#pragma unroll
          for (int si = 0; si < 2; ++si) { const int st = 2 * (w & 1) + si, tcol = 16 * tt + n, srow = 16 * st + 4 * g;
#pragma unroll
              for (int r = 0; r < 4; ++r) pacc[si][r] = (dir ? (srow + r >= tcol) : (srow + r <= tcol)) ? pacc[si][r] : 0.f;
              *(LAS unsigned long long*)(L + HG_IMP + tcol * HG_PROW + srow * 2) = cvtpk4(pacc[si]); }
#pragma unroll
          for (int kt = 0; kt < 8; ++kt) *(LAS unsigned long long*)(L + HG_IMS + w * 4096 + off_b(n, 2 * kt + (g >> 1)) + 8 * (g & 1)) = cvtpk4(S[kt]);
        }
        pg8::bf16x8 vf[2];
#pragma unroll
        for (int ks = 0; ks < 2; ++ks) vf[ks] = tr_pair(IM + 32768 + off_b(32 * ks + 8 * g + q4, 2 * w + (p4 >> 1)) + 8 * (p4 & 1), IM + 32768 + off_b(32 * ks + 8 * g + 4 + q4, 2 * w + (p4 >> 1)) + 8 * (p4 & 1));
        __syncthreads();
        f32x4 oacc[4];
        { pg8::bf16x8 sf[4];
#pragma unroll
          for (int ks = 0; ks < 4; ++ks) sf[ks] = *(const LAS pg8::bf16x8*)(L + HG_IMS + w * 4096 + off_b(n, 4 * ks + g));
#pragma unroll
          for (int th = 0; th < 2; ++th) {
              pg8::bf16x8 pf[2][2], qf[2][4];
#pragma unroll
              for (int t2 = 0; t2 < 2; ++t2) { const int tt = 2 * th + t2;
#pragma unroll
                  for (int ks = 0; ks < 2; ++ks) { if (dir ? (32 * ks + 31 < 16 * tt) : (32 * ks > 16 * tt + 15)) continue;
                      pf[t2][ks] = *(const LAS pg8::bf16x8*)(L + HG_IMP + (16 * tt + n) * HG_PROW + (32 * ks + 8 * g) * 2); }
#pragma unroll
                  for (int ks = 0; ks < 4; ++ks) qf[t2][ks] = *(const LAS pg8::bf16x8*)(IM + off_b(16 * tt + n, 4 * ks + g)); }
#pragma unroll
              for (int t2 = 0; t2 < 2; ++t2) { const int tt = 2 * th + t2;
                  f32x4 a = (f32x4){0.f, 0.f, 0.f, 0.f};
#pragma unroll
                  for (int ks = 0; ks < 2; ++ks) { if (dir ? (32 * ks + 31 < 16 * tt) : (32 * ks > 16 * tt + 15)) continue; a = MFMA16(vf[ks], pf[t2][ks], a); }
#pragma unroll
                  for (int ks = 0; ks < 4; ++ks) a = MFMA16(sf[ks], qf[t2][ks], a);
                  oacc[tt] = a; }
          } }
        if (MODE == 1) {
#pragma unroll
            for (int tt = 0; tt < 4; ++tt) held[tt] = cvtpk4(oacc[tt]);
            c_held = c;
        }
#pragma unroll
        for (int kh = 0; kh < 2; ++kh) {
            pg8::bf16x8 kf[4][2];
#pragma unroll
            for (int k2 = 0; k2 < 4; ++k2) { const int kt = 4 * kh + k2;
                kf[k2][0] = tr_pair(IM + 16384 + off_b(8 * g + q4, 2 * kt + (p4 >> 1)) + 8 * (p4 & 1), IM + 16384 + off_b(8 * g + 4 + q4, 2 * kt + (p4 >> 1)) + 8 * (p4 & 1));
                kf[k2][1] = tr_pair(IM + 16384 + off_b(32 + 8 * g + q4, 2 * kt + (p4 >> 1)) + 8 * (p4 & 1), IM + 16384 + off_b(32 + 8 * g + 4 + q4, 2 * kt + (p4 >> 1)) + 8 * (p4 & 1)); }
#pragma unroll
            for (int k2 = 0; k2 < 4; ++k2) { const int kt = 4 * kh + k2; S[kt] = MFMA16(kf[k2][0], vf[0], S[kt]); S[kt] = MFMA16(kf[k2][1], vf[1], S[kt]); }
        }
        if (MODE == 2) {
            LAS float* PT = (LAS float*)(L + HG_PART);
#pragma unroll
            for (int tt = 0; tt < 4; ++tt) { const unsigned lo = (unsigned)scr[tt], hi = (unsigned)(scr[tt] >> 32);
                oacc[tt][0] += pg8::bf_lo(lo); oacc[tt][1] += pg8::bf_hi(lo); oacc[tt][2] += pg8::bf_lo(hi); oacc[tt][3] += pg8::bf_hi(hi);
                float ss = (oacc[tt][0] * oacc[tt][0] + oacc[tt][1] * oacc[tt][1]) + (oacc[tt][2] * oacc[tt][2] + oacc[tt][3] * oacc[tt][3]);
                ss += __shfl_xor(ss, 16); ss += __shfl_xor(ss, 32);
                if (g == 0) PT[(16 * tt + n) * 8 + w] = ss; }
            __syncthreads();
#pragma unroll
            for (int tt = 0; tt < 4; ++tt) { const f32x4 pa = *(const LAS f32x4*)(PT + (16 * tt + n) * 8), pb = *(const LAS f32x4*)(PT + (16 * tt + n) * 8 + 4);
                const float rstd = 1.0f / sqrtf(((pa[0] + pa[1]) + (pa[2] + pa[3]) + (pb[0] + pb[1]) + (pb[2] + pb[3])) * (1.f / HGD) + EPS);
                const unsigned long long zz = zz4[tt]; const unsigned zl = (unsigned)zz, zh = (unsigned)(zz >> 32);
                const float z0 = pg8::bf_lo(zl), z1 = pg8::bf_hi(zl), z2 = pg8::bf_lo(zh), z3 = pg8::bf_hi(zh);
                f32x4 ov; ov[0] = oacc[tt][0] * rstd * wv[0] * z0 * pg8::sigmoidf_(z0); ov[1] = oacc[tt][1] * rstd * wv[1] * z1 * pg8::sigmoidf_(z1);
                ov[2] = oacc[tt][2] * rstd * wv[2] * z2 * pg8::sigmoidf_(z2); ov[3] = oacc[tt][3] * rstd * wv[3] * z3 * pg8::sigmoidf_(z3);
                held[tt] = cvtpk4(ov); }
            c_held = c;
        }
    }
    if (c_held >= 0) { const int n = lane & 15, g = lane >> 4;
#pragma unroll
        for (int tt = 0; tt < 4; ++tt) { if (MODE == 1) SCR[(size_t)((c_held - c0) * 4 + tt) * 512 + tid] = held[tt];
            else *(unsigned long long*)(OB + (size_t)(64 * c_held + 16 * tt + n) * PW + chb + 16 * w + 4 * g) = held[tt]; } }
    __syncthreads();
}

constexpr int NA_SLOT = 16384, NA_NSLOT = 9, NA_BIAS = NA_SLOT * NA_NSLOT, NA_LDS_END = NA_BIAS + 2048;
static_assert(NA_LDS_END <= RING_BYTES, "na lds");
__device__ __forceinline__ void tr_read2(unsigned a0, unsigned a1, s16x4& r0, s16x4& r1) {
    asm volatile("ds_read_b64_tr_b16 %0, %2\n\tds_read_b64_tr_b16 %1, %3\n\ts_waitcnt lgkmcnt(0)" : "=&v"(r0), "=&v"(r1) : "v"(a0), "v"(a1) : "memory");
}
__device__ __forceinline__ int na_rs(int r) { int rs = r - 4; return rs < 0 ? 0 : (rs > GROWS - 8 ? GROWS - 8 : rs); }
__device__ __forceinline__ void na_unit(Frame& F, int h, int r0, const bf16* Q, const bf16* K, const bf16* V, const bf16* Z, const float* rpb, bf16* O) {
    LAS unsigned char* L = F.lds + RING_OFF;
    const unsigned lbase = (unsigned)(size_t)L;
    const int tid = F.tid_(), lane = F.lane_(), w = F.wave;
    const int scol = tid >> 3, sch = tid & 7;
    const unsigned sdst = (unsigned)(scol * 128 + 16 * (sch ^ (scol & 7)));
    __syncthreads();
    for (int i = tid; i < 15 * 31; i += NWAVES * 64) ((LAS float*)(L + NA_BIAS))[i] = rpb[h * 465 + i] * 1.44269504089f;
    int hi = na_rs(r0) - 1;
    { const int need = na_rs(r0 + 1) + 7;
      for (int kr = hi + 1; kr <= need; ++kr) { const size_t o = (size_t)(kr * GW + scol) * PW + h * NADH + sch * 8;
          const v4u kv = *(const v4u*)(K + o), vv = *(const v4u*)(V + o); LAS unsigned char* sl = L + (kr % NA_NSLOT) * NA_SLOT;
          *(LAS v4u*)(sl + sdst) = kv; *(LAS v4u*)(sl + 8192 + sdst) = vv; }
      hi = need; }
    __syncthreads();
    pg8::bf16x8 qnx[2]; unsigned long long znx[4];
    { const int rq = r0 + (w >> 2), tq = rq * GW + 16 * (w & 3) + (lane & 15), g0 = lane >> 4;
#pragma unroll
      for (int ks = 0; ks < 2; ++ks) qnx[ks] = *(const pg8::bf16x8*)(Q + (size_t)tq * PW + h * NADH + 32 * ks + 8 * g0);
#pragma unroll
      for (int dt = 0; dt < 4; ++dt) znx[dt] = *(const unsigned long long*)(Z + (size_t)tq * PW + h * NADH + 16 * dt + 4 * g0); }
    for (int st = 0; st < 8; ++st) {
        const int r = r0 + 2 * st;
        pg8::bf16x8 qf[2]; unsigned long long zc[4];
#pragma unroll
        for (int ks = 0; ks < 2; ++ks) qf[ks] = qnx[ks];
#pragma unroll
        for (int dt = 0; dt < 4; ++dt) zc[dt] = znx[dt];
        if (st < 7) { const int rq = r + 2 + (w >> 2), tq = rq * GW + 16 * (w & 3) + (lane & 15), g0 = lane >> 4;
#pragma unroll
            for (int ks = 0; ks < 2; ++ks) qnx[ks] = *(const pg8::bf16x8*)(Q + (size_t)tq * PW + h * NADH + 32 * ks + 8 * g0);
#pragma unroll
            for (int dt = 0; dt < 4; ++dt) znx[dt] = *(const unsigned long long*)(Z + (size_t)tq * PW + h * NADH + 16 * dt + 4 * g0); }
        int nnew = 0; v4u pk[2], pv[2];
        if (st < 7) { const int need = na_rs(r + 3) + 7; nnew = need - hi;
#pragma unroll
            for (int e = 0; e < 2; ++e) if (e < nnew) { const size_t o = (size_t)((hi + 1 + e) * GW + scol) * PW + h * NADH + sch * 8; pk[e] = *(const v4u*)(K + o); pv[e] = *(const v4u*)(V + o); } }
        {
            int lane_v = lane; asm volatile("" : "+v"(lane_v));
            const int n = lane_v & 15, g = lane_v >> 4, q4 = n >> 2, p4 = n & 3;
            const int rq = r + (w >> 2), cb = w & 3, rs = na_rs(rq);
            int kb0 = 16 * cb - 8; kb0 = kb0 < 0 ? 0 : (kb0 > 32 ? 32 : kb0);
            const int qc = 16 * cb + n; int cs = qc - 8; cs = cs < 0 ? 0 : (cs > GW - 16 ? GW - 16 : cs);
            const int tq = rq * GW + qc;
            bool val[2][4]; int ci[2][4];
#pragma unroll
            for (int hf = 0; hf < 2; ++hf)
#pragma unroll
                for (int rr = 0; rr < 4; ++rr) { const int kc = kb0 + 16 * hf + 4 * g + rr; val[hf][rr] = (kc >= cs) && (kc < cs + 16); int c = kc - qc + 15; c = c < 0 ? 0 : (c > 30 ? 30 : c); ci[hf][rr] = c; }
            f32x4 sc[8][2]; float mx = -1e30f;
#pragma unroll
            for (int jr = 0; jr < 8; ++jr) { const int kr = rs + jr; const unsigned slb = (unsigned)((kr % NA_NSLOT) * NA_SLOT); const int ri = kr - rq + 7;
#pragma unroll
                for (int hf = 0; hf < 2; ++hf) { const int col = kb0 + 16 * hf + n; f32x4 a = (f32x4){0.f, 0.f, 0.f, 0.f};
#pragma unroll
                    for (int ks = 0; ks < 2; ++ks) { const pg8::bf16x8 kf = *(const LAS pg8::bf16x8*)(L + slb + col * 128 + 16 * ((4 * ks + g) ^ (col & 7))); a = MFMA16(kf, qf[ks], a); }
                    float bb[4];
#pragma unroll
                    for (int rr = 0; rr < 4; ++rr) bb[rr] = ((const LAS float*)(L + NA_BIAS))[ri * 31 + ci[hf][rr]];
                    asm volatile("" : "+v"(bb[0]), "+v"(bb[1]), "+v"(bb[2]), "+v"(bb[3]));
#pragma unroll
                    for (int rr = 0; rr < 4; ++rr) { const float s2 = val[hf][rr] ? (a[rr] * 1.44269504089f + bb[rr]) : -1e30f; a[rr] = s2; mx = fmaxf(mx, s2); }
                    sc[jr][hf] = a; } }
            mx = fmaxf(mx, __shfl_xor(mx, 16)); mx = fmaxf(mx, __shfl_xor(mx, 32));
            float ls = 0.f; pg8::bf16x8 pf[8];
#pragma unroll
            for (int jr = 0; jr < 8; ++jr) { float e[8];
#pragma unroll
                for (int hf = 0; hf < 2; ++hf)
#pragma unroll
                    for (int rr = 0; rr < 4; ++rr) { e[hf * 4 + rr] = __builtin_amdgcn_exp2f(sc[jr][hf][rr] - mx); ls += e[hf * 4 + rr]; }
                v4u pw; pw.x = pk2(e[0], e[1]); pw.y = pk2(e[2], e[3]); pw.z = pk2(e[4], e[5]); pw.w = pk2(e[6], e[7]); pf[jr] = __builtin_bit_cast(pg8::bf16x8, pw); }
            ls += __shfl_xor(ls, 16); ls += __shfl_xor(ls, 32);
            const float inv = 1.0f / ls;
            f32x4 oacc[4];
#pragma unroll
            for (int dt = 0; dt < 4; ++dt) oacc[dt] = (f32x4){0.f, 0.f, 0.f, 0.f};
#pragma unroll
            for (int jr = 0; jr < 8; ++jr) { const int kr = rs + jr; const unsigned slb = (unsigned)((kr % NA_NSLOT) * NA_SLOT) + 8192u;
                const int c0 = kb0 + 4 * g + q4, c1 = c0 + 16;
#pragma unroll
                for (int dt = 0; dt < 4; ++dt) {
                    const pg8::bf16x8 vf = tr_pair(L + slb + c0 * 128 + 16 * ((2 * dt + (p4 >> 1)) ^ (c0 & 7)) + 8 * (p4 & 1), L + slb + c1 * 128 + 16 * ((2 * dt + (p4 >> 1)) ^ (c1 & 7)) + 8 * (p4 & 1));
                    oacc[dt] = MFMA16(vf, pf[jr], oacc[dt]); } }
#pragma unroll
            for (int dt = 0; dt < 4; ++dt) { const size_t o = (size_t)tq * PW + h * NADH + 16 * dt + 4 * g;
                const unsigned long long zz = zc[dt]; const unsigned zl = (unsigned)zz, zh = (unsigned)(zz >> 32);
                const float z0 = pg8::bf_lo(zl), z1 = pg8::bf_hi(zl), z2 = pg8::bf_lo(zh), z3 = pg8::bf_hi(zh);
                const float o0 = oacc[dt][0] * inv * z0 * pg8::sigmoidf_(z0), o1 = oacc[dt][1] * inv * z1 * pg8::sigmoidf_(z1), o2 = oacc[dt][2] * inv * z2 * pg8::sigmoidf_(z2), o3 = oacc[dt][3] * inv * z3 * pg8::sigmoidf_(z3);
                *(unsigned long long*)(O + o) = (unsigned long long)pk2(o0, o1) | ((unsigned long long)pk2(o2, o3) << 32); }
        }
        __syncthreads();
#pragma unroll
        for (int e = 0; e < 2; ++e) if (e < nnew) { LAS unsigned char* sl = L + ((hi + 1 + e) % NA_NSLOT) * NA_SLOT; *(LAS v4u*)(sl + sdst) = pk[e]; *(LAS v4u*)(sl + 8192 + sdst) = pv[e]; }
        hi += nnew;
        __syncthreads();
    }
}

__device__ __forceinline__ void hg_finish(Frame& F, const float* OFWD, const float* OBWD, const bf16* HZ, const float* w, bf16* OB) {
    const int gw = F.vcu * NWAVES + F.wave, NGW = F.G * NWAVES, lane = F.lane_();
    for (int m = gw; m < M; m += NGW) {
        const f32x4* a = (const f32x4*)(OFWD + (size_t)m * PW) + lane * 4; const f32x4* b = (const f32x4*)(OBWD + (size_t)m * PW) + lane * 4;
        f32x4 o[4]; float ss = 0.f;
#pragma unroll
        for (int i = 0; i < 4; ++i) { o[i] = a[i] + b[i]; ss += (o[i].x * o[i].x + o[i].y * o[i].y) + (o[i].z * o[i].z + o[i].w * o[i].w); }
        ss += __shfl_xor(ss, 1); ss += __shfl_xor(ss, 2); ss += __shfl_xor(ss, 4);
        const float rstd = 1.0f / sqrtf(ss * (1.f / HGD) + EPS);
        const v4u* zp = (const v4u*)(HZ + (size_t)m * PW) + lane * 2; v4u* op = (v4u*)(OB + (size_t)m * PW) + lane * 2;
#pragma unroll
        for (int hh = 0; hh < 2; ++hh) { const v4u zz = zp[hh]; const f32x4 w0 = *((const f32x4*)w + lane * 4 + hh * 2), w1 = *((const f32x4*)w + lane * 4 + hh * 2 + 1);
            const f32x4 o0 = o[hh * 2], o1 = o[hh * 2 + 1];
            float zf[8] = {pg8::bf_lo(zz.x), pg8::bf_hi(zz.x), pg8::bf_lo(zz.y), pg8::bf_hi(zz.y), pg8::bf_lo(zz.z), pg8::bf_hi(zz.z), pg8::bf_lo(zz.w), pg8::bf_hi(zz.w)};
            float r[8] = {o0.x * w0.x, o0.y * w0.y, o0.z * w0.z, o0.w * w0.w, o1.x * w1.x, o1.y * w1.y, o1.z * w1.z, o1.w * w1.w};
#pragma unroll
            for (int i = 0; i < 8; ++i) r[i] = r[i] * rstd * zf[i] * sigm(zf[i]);
            v4u ow; ow.x = pk2(r[0], r[1]); ow.y = pk2(r[2], r[3]); ow.z = pk2(r[4], r[5]); ow.w = pk2(r[6], r[7]); op[hh] = ow; }
    }
}
__device__ __forceinline__ void final_phase(Frame& F, const float* x, const bf16* Zb, const float* ssq, const float* w, float* out) {
    const int gw = F.vcu * NWAVES + F.wave, NGW = F.G * NWAVES, lane = F.lane_();
    for (int m = gw; m < M; m += NGW) {
        const float part = lane < 32 ? ssq[(size_t)m * 32 + lane] : 0.f;
        const float rstd = 1.0f / sqrtf(wave_sum(part) * (1.f / D) + EPS);
        const f32x4* xr = (const f32x4*)(x + (size_t)m * D) + lane; f32x4* orow = (f32x4*)(out + (size_t)m * D) + lane;
        const unsigned long long* zr = (const unsigned long long*)(Zb + (size_t)m * D) + lane;
#pragma unroll
        for (int j = 0; j < 8; ++j) { const f32x4 xv = xr[64 * j]; const unsigned long long zz = zr[64 * j]; const f32x4 wv = *((const f32x4*)w + lane + 64 * j);
            const unsigned lo = (unsigned)zz, hi = (unsigned)(zz >> 32);
            f32x4 o; o.x = xv.x + pg8::bf_lo(lo) * rstd * wv.x; o.y = xv.y + pg8::bf_hi(lo) * rstd * wv.y; o.z = xv.z + pg8::bf_lo(hi) * rstd * wv.z; o.w = xv.w + pg8::bf_hi(hi) * rstd * wv.w;
            orow[64 * j] = o; }
    }
}
struct Args { const float* in[10]; float* out; unsigned char* ws; int ph_lo, ph_hi, li, pad; };
constexpr int N_PHASES = 8;
__global__ void __launch_bounds__(NWAVES * 64, 2) fwd_kernel(Args args) {
    extern __shared__ __attribute__((aligned(16))) unsigned char lds[];
    Frame F;
    F.lds = (LAS unsigned char*)lds;
    F.MISC = (volatile LAS unsigned*)(F.lds + MISC_OFF);
    F.wave = __builtin_amdgcn_readfirstlane((int)threadIdx.x >> 6);
    F.G = gridDim.x; { const int bx = blockIdx.x; F.vcu = (F.G % 8 == 0) ? (bx % 8) * (F.G / 8) + bx / 8 : bx; }
    unsigned char* ws = args.ws;
    F.ctl = (gu32*)(ws + WS_CTL);
    const float* x = args.in[0]; const float* w_pre = args.in[1]; const float* w_in = args.in[2]; const float* b_gate = args.in[3]; const float* rpb = args.in[4];
    const float* lb_logits = args.in[5]; const float* hg_norm_w = args.in[6]; const float* w_br = args.in[7]; const float* w_out = args.in[8]; const float* w_post = args.in[9];
    bf16* WIN_T = (bf16*)(ws + WS_WIN); bf16* WBA_T = (bf16*)(ws + WS_WBA); bf16* WBB_T = (bf16*)(ws + WS_WBB); bf16* WOUT_T = (bf16*)(ws + WS_WOUT);
    bf16* H = (bf16*)(ws + WS_H);
    float* SSQ = (float*)(ws + WS_SSQ);
    bf16* XN = (bf16*)args.out;
    bf16* OA = (bf16*)((unsigned char*)args.out + 32 * MiB); bf16* OB = H + P_HQ * PIECE_ELEMS; unsigned char* QMI = (unsigned char*)args.out + 64 * MiB; float* ECG = (float*)(ws + 40 * MiB); bf16* YA = H + P_NK * PIECE_ELEMS; bf16* Y = H + P_HFF * PIECE_ELEMS; bf16* Zb = H + P_HI * PIECE_ELEMS;
    for (int u = F.tid_(); u < (LDS_BYTES - LDSCTL_OFF) / 4; u += NWAVES * 64) ((LAS unsigned*)(F.lds + LDSCTL_OFF))[u] = 0u;
    __syncthreads();
    XcdBarrier bar = xcd_barrier_post((unsigned*)(F.ctl + CW_BAR) + args.li * XCD_BAR_WORDS, F.MISC + 8);
    const int lo = args.ph_lo, hi = args.ph_hi;
#define IN(k) (lo <= (k) && (k) < hi)
#define BOTH(k) (IN(k) && IN((k) + 1))
#define GRID_BAR() xcd_barrier(bar)
#ifndef REP_PHASE
#define REP_PHASE -1
#endif
#ifndef REP_N
#define REP_N 2
#endif
#define REPEAT(k) for (int rep_ = 0; rep_ < ((REP_PHASE == (k)) ? 1 + REP_N : 1); ++rep_)

    if (IN(0)) REPEAT(0) { p0_prologue(F, x, w_pre, w_in, w_br, w_out, XN, WIN_T, WBA_T, WBB_T, WOUT_T); if (BOTH(0)) GRID_BAR(); }
    if (IN(1)) REPEAT(1) {
        pg8::Gemm g{XN, WIN_T, M, INC, D}; pg8::StaticOrder S; S.init(M, INC, F.G, (int)blockIdx.x);
        pg8::EpiBf16 E{H, PW, PW, PIECE_ELEMS, 0.125f};
        pg8::gemm_phase<pg8::EpiBf16, pg8::StaticOrder, true, true>(F.lds + RING_OFF, g, S, E);
        if (BOTH(1)) GRID_BAR();
    }
    float* SLOC = (float*)(ws + WS_SLOC); float* DSEG = (float*)(ws + WS_DSEG);
    if (IN(2)) {
        for (int u = blockIdx.x; u < 16 * HG_NSEG; u += F.G) { const int hd = u / HG_NSEG, j = u % HG_NSEG, head = hd >> 1, dir = hd & 1;
            const int c0 = dir ? (M / 64 - HG_SEGC * (j + 1)) : HG_SEGC * j;
            hg_pre(F, head, dir, c0, HG_SEGC, H, P_HQ, dir ? P_HFB : P_HFF, P_HI, lb_logits, QMI + (size_t)dir * (32 * MiB), ECG + (size_t)dir * (HGH * (M / 64) * 128),
                   SLOC + (size_t)u * HGD * HGD, DSEG + (size_t)u * HGD); }
        REPEAT(9) for (int u = blockIdx.x; u < NAH * (GROWS / 16); u += F.G) na_unit(F, u & 15, (u >> 4) * 16, H + P_NQ * PIECE_ELEMS, H + P_NK * PIECE_ELEMS, H + P_NV * PIECE_ELEMS, H + P_NZ * PIECE_ELEMS, rpb, OA);
        if (BOTH(2)) GRID_BAR();
    }
    if (IN(3)) REPEAT(3) {
        for (int e = F.vcu * NWAVES * 64 + F.tid_(); e < 16 * HGD * HGD; e += F.G * NWAVES * 64) { const int hd = e / (HGD * HGD), el = e % (HGD * HGD), dk = 16 * (el >> 11) + 4 * (((el >> 2) & 63) >> 4) + (el & 3);
            float* sp = SLOC + (size_t)hd * HG_NSEG * HGD * HGD + el; const float* dp = DSEG + (size_t)hd * HG_NSEG * HGD + dk; float S = 0.f;
#pragma unroll 8
            for (int j = 0; j < HG_NSEG; ++j) { const float Lc = sp[(size_t)j * HGD * HGD]; sp[(size_t)j * HGD * HGD] = S; S = __builtin_amdgcn_exp2f(dp[j * HGD]) * S + Lc; } }
        if (BOTH(3)) GRID_BAR();
    }
    if (IN(4)) REPEAT(4) {
        for (int u = blockIdx.x; u < HGH * HG_NSEG; u += F.G) { const int head = u / HG_NSEG, seg = u % HG_NSEG;
            unsigned long long* scr = (unsigned long long*)args.out + (size_t)u * (HG_SEGC * 4 * 512);
            hg_main<1>(F, head, 0, HG_SEGC * seg, HG_SEGC, H, P_HFF, P_HI, QMI, ECG, SLOC + (size_t)((head * 2 + 0) * HG_NSEG + seg) * HGD * HGD, scr, nullptr, nullptr, nullptr);
            hg_main<2>(F, head, 1, HG_SEGC * seg, HG_SEGC, H, P_HFB, P_HI, QMI + 32 * MiB, ECG + (size_t)HGH * (M / 64) * 128,
                       SLOC + (size_t)((head * 2 + 1) * HG_NSEG + (HG_NSEG - 1 - seg)) * HGD * HGD, scr, H + P_HZ * PIECE_ELEMS, hg_norm_w, OB); }
        if (BOTH(4)) GRID_BAR();
    }
    if (IN(5)) REPEAT(5) {
        { pg8::Gemm g{OA, WBA_T, M, D, PW}; pg8::StaticOrder S; S.init(M, D, F.G, (int)blockIdx.x);
          pg8::EpiGate<false> E{H + P_GA * PIECE_ELEMS, PIECE_ELEMS, b_gate, nullptr, YA, D};
          pg8::gemm_phase<pg8::EpiGate<false>, pg8::StaticOrder, true, true>(F.lds + RING_OFF, g, S, E); }
        { pg8::Gemm g{OB, WBB_T, M, D, PW}; pg8::StaticOrder S; S.init(M, D, F.G, (int)blockIdx.x);
          pg8::EpiGate<true> E{H + P_GB * PIECE_ELEMS, PIECE_ELEMS, b_gate + D, YA, Y, D};
          pg8::gemm_phase<pg8::EpiGate<true>, pg8::StaticOrder, true, true>(F.lds + RING_OFF, g, S, E); }
        if (BOTH(5)) GRID_BAR();
    }
    if (IN(6)) REPEAT(6) {
        pg8::Gemm g{Y, WOUT_T, M, D, D}; pg8::StaticOrder S; S.init(M, D, F.G, (int)blockIdx.x);
        pg8::EpiSsq E{Zb, D, SSQ};
        pg8::gemm_phase<pg8::EpiSsq, pg8::StaticOrder, true, true>(F.lds + RING_OFF, g, S, E);
        if (BOTH(6)) GRID_BAR();
    }
    if (IN(7)) REPEAT(7) { final_phase(F, x, Zb, SSQ, w_post, args.out); }
#undef IN
#undef BOTH
}

#ifndef MK_N_LAUNCHES
#define MK_N_LAUNCHES 1
#endif
extern "C" void kernel_launch(void* const* d_in, const int* in_sizes, int n_in, void* d_out, int out_size, void* d_ws, size_t ws_size, hipStream_t stream) {
    static int grid = 0;
    if (grid == 0) {
        if (n_in != 10 || in_sizes[0] != M * D || out_size != M * D || ws_size < WS_END) { fprintf(stderr, "kernel_launch: unexpected shapes: n_in %d in0 %d out %d ws %zu (need %zu)\n", n_in, n_in > 0 ? in_sizes[0] : -1, out_size, ws_size, (size_t)WS_END); grid = -1; return; }
        int dev = 0, cus = 0, per_cu = 0;
        if (hipGetDevice(&dev) != hipSuccess || hipDeviceGetAttribute(&cus, hipDeviceAttributeMultiprocessorCount, dev) != hipSuccess) { fprintf(stderr, "kernel_launch: device query failed\n"); grid = -1; return; }
        if (hipFuncSetAttribute((const void*)fwd_kernel, hipFuncAttributeMaxDynamicSharedMemorySize, LDS_BYTES) != hipSuccess) { fprintf(stderr, "kernel_launch: hipFuncSetAttribute failed\n"); grid = -1; return; }
        if (hipOccupancyMaxActiveBlocksPerMultiprocessor(&per_cu, (const void*)fwd_kernel, NWAVES * 64, LDS_BYTES) != hipSuccess || per_cu < 1) { fprintf(stderr, "kernel_launch: occupancy query reports %d blocks/CU; nothing launched\n", per_cu); (void)hipGetLastError(); grid = -1; return; }
        grid = cus;
    }
    if (grid < 0) return;
    if (hipMemsetAsync((char*)d_ws + WS_CTL, 0, CTL_ZERO_BYTES, stream) != hipSuccess) { fprintf(stderr, "kernel_launch: memset failed\n"); return; }
    Args a{};
    for (int i = 0; i < 10; ++i) a.in[i] = (const float*)d_in[i];
    a.out = (float*)d_out; a.ws = (unsigned char*)d_ws;
#if MK_N_LAUNCHES == 1
    a.ph_lo = 0; a.ph_hi = N_PHASES; a.li = 0;
    hipLaunchKernelGGL(fwd_kernel, dim3(grid), dim3(NWAVES * 64), LDS_BYTES, stream, a);
#else
    for (int li = 0; li < N_PHASES; ++li) { a.ph_lo = li; a.ph_hi = li + 1; a.li = li;
        hipLaunchKernelGGL(fwd_kernel, dim3(grid), dim3(NWAVES * 64), LDS_BYTES, stream, a); }
#endif
    const hipError_t le = hipPeekAtLastError();
    if (le != hipSuccess) fprintf(stderr, "kernel_launch: launch failed: %s\n", hipGetErrorName(le));
}
```

```cpp
#include <hip/hip_runtime.h>
#include <cstdio>
#include <cstdint>
namespace pg8 {
#define PG8_LAS __attribute__((address_space(3)))
typedef unsigned short bf16_t;
typedef short bf16x8 __attribute__((ext_vector_type(8)));
typedef float f32x4 __attribute__((ext_vector_type(4)));
typedef unsigned u32x4 __attribute__((ext_vector_type(4)));
constexpr int BM = 256, BK = 64, HALF = 128, HTB = HALF * BK * 2  , STAGE_BYTES = 8 * HTB, NXCD = 8, WGM = 4;

__host__ __device__ __forceinline__ int lds_byte(int r, int c) { const int st = (r >> 4) * 2 + (c >> 5), rr = r & 15, cc = c & 31, ob = rr * 64 + cc * 2; return st * 1024 + (ob ^ (((ob >> 9) & 1) << 5)); }
__host__ __device__ __forceinline__ void stage_rc(int b, int& R, int& C) { const int st = b / 1024, sb = b % 1024, swz = sb ^ (((sb >> 9) & 1) << 5); R = (st >> 1) * 16 + swz / 64; C = (st & 1) * 32 + (swz % 64) / 2; }
__host__ __device__ __forceinline__ int perm32(int rho) { const int n = rho >> 4, i = rho & 15; return 8 * (i >> 2) + 4 * n + (i & 3); }

struct Unit { int pm, pn; };
struct Gemm { const bf16_t* A; const bf16_t* Bt; int M, N, K; };

struct StaticOrder {
    int nM, nN, nwg, G, c;
    __host__ __device__ void init(int M, int N, int G_, int c_) { nM = M / BM; nN = N / BM; nwg = nM * nN; G = G_; c = c_; }
    __host__ __device__ bool next(int i, Unit& u) const {
        const long L = (long)i * G + c; if (L >= nwg) return false;
        int wgid = (int)L; { const int q = nwg / NXCD, r = nwg % NXCD, xcd = wgid % NXCD, off = wgid / NXCD; wgid = (xcd < r ? xcd * (q + 1) : r * (q + 1) + (xcd - r) * q) + off; }
        const int nig = WGM * nN, gid = wgid / nig, fm = gid * WGM, gsz = (nM - fm) < WGM ? (nM - fm) : WGM;
        u.pm = fm + ((wgid % nig) % gsz); u.pn = (wgid % nig) / gsz; return true;
    }
    __device__ __forceinline__ void a_ready(const Unit&) const {}
    __device__ __forceinline__ void done(const Unit&) const {}
};

typedef float f32x2c __attribute__((ext_vector_type(2)));
typedef __bf16 bf16x2c __attribute__((ext_vector_type(2)));
__device__ __forceinline__ unsigned cvt_pk_bf16(float lo, float hi) { const f32x2c v = {lo, hi}; return __builtin_bit_cast(unsigned, __builtin_convertvector(v, bf16x2c)); }
typedef float f32x2 __attribute__((ext_vector_type(2)));
struct EpiBf16 {
    static constexpr bool PERM = true, AFTER_DRAIN = false;
    bf16_t* O; int ldc; int split_cols; size_t split_stride; float scale0;
    __device__ __forceinline__ void operator()(const f32x4 (&acc)[2][2][4][2], const Unit& u, int wr, int wc, int fr, int fq) const {
        const int row0 = u.pm * BM + wr * 64 + fr; int colt = u.pn * BM; bf16_t* base = O;
        float sc = 1.f; if (split_cols) { const int t = colt / split_cols; base += (size_t)t * split_stride; colt -= t * split_cols; if (t == 0) sc = scale0; }
        const int col0 = colt + wc * 32 + 8 * fq;
#pragma unroll
        for (int ai = 0; ai < 2; ++ai)
#pragma unroll
            for (int m = 0; m < 4; ++m) { bf16_t* rowp = base + (size_t)(row0 + ai * HALF + m * 16) * ldc + col0;
#pragma unroll
                for (int bj = 0; bj < 2; ++bj) { f32x4 v0 = acc[ai][bj][m][0] * sc, v1 = acc[ai][bj][m][1] * sc;
                    u32x4 w; w.x = cvt_pk_bf16(v0[0], v0[1]); w.y = cvt_pk_bf16(v0[2], v0[3]); w.z = cvt_pk_bf16(v1[0], v1[1]); w.w = cvt_pk_bf16(v1[2], v1[3]);
                    *(u32x4*)(rowp + bj * HALF) = w; } }
    }
};
__device__ __forceinline__ float bf_lo(unsigned w) { return __builtin_bit_cast(float, w << 16); }
__device__ __forceinline__ float bf_hi(unsigned w) { return __builtin_bit_cast(float, w & 0xffff0000u); }
__device__ __forceinline__ float sigmoidf_(float x) { return __builtin_amdgcn_rcpf(1.0f + __builtin_amdgcn_exp2f(-1.44269504089f * x)); }
template <bool ADD> struct EpiGate {
    static constexpr bool PERM = true, AFTER_DRAIN = false;
    const bf16_t* G; size_t piece_stride; const float* bg; const bf16_t* prev; bf16_t* O; int ldc;
    __device__ __forceinline__ void operator()(const f32x4 (&acc)[2][2][4][2], const Unit& u, int wr, int wc, int fr, int fq) const {
        const int row0 = u.pm * BM + wr * 64 + fr; const int col0 = u.pn * BM + wc * 32 + 8 * fq;
        f32x4 bv[2][2];
#pragma unroll
        for (int bj = 0; bj < 2; ++bj)
#pragma unroll
            for (int n = 0; n < 2; ++n) bv[bj][n] = *(const f32x4*)(bg + col0 + bj * HALF + 4 * n);
#pragma unroll
        for (int ai = 0; ai < 2; ++ai) {
            u32x4 gw[4][2], pw[4][2];
#pragma unroll
            for (int m = 0; m < 4; ++m)
#pragma unroll
                for (int bj = 0; bj < 2; ++bj) { const int row = row0 + ai * HALF + m * 16, col = col0 + bj * HALF;
                    gw[m][bj] = *(const u32x4*)(G + (size_t)(col >> 10) * piece_stride + (size_t)row * 1024 + (col & 1023));
                    if (ADD) pw[m][bj] = *(const u32x4*)(prev + (size_t)row * ldc + col); }
#pragma unroll
            for (int m = 0; m < 4; ++m)
#pragma unroll
                for (int bj = 0; bj < 2; ++bj) { const int row = row0 + ai * HALF + m * 16, col = col0 + bj * HALF; const u32x4 g4 = gw[m][bj];
                    f32x4 v0 = acc[ai][bj][m][0], v1 = acc[ai][bj][m][1];
                    v0[0] *= sigmoidf_(bf_lo(g4.x) + bv[bj][0][0]); v0[1] *= sigmoidf_(bf_hi(g4.x) + bv[bj][0][1]);
                    v0[2] *= sigmoidf_(bf_lo(g4.y) + bv[bj][0][2]); v0[3] *= sigmoidf_(bf_hi(g4.y) + bv[bj][0][3]);
                    v1[0] *= sigmoidf_(bf_lo(g4.z) + bv[bj][1][0]); v1[1] *= sigmoidf_(bf_hi(g4.z) + bv[bj][1][1]);
                    v1[2] *= sigmoidf_(bf_lo(g4.w) + bv[bj][1][2]); v1[3] *= sigmoidf_(bf_hi(g4.w) + bv[bj][1][3]);
                    if (ADD) { const u32x4 p4 = pw[m][bj];
                        v0[0] += bf_lo(p4.x); v0[1] += bf_hi(p4.x); v0[2] += bf_lo(p4.y); v0[3] += bf_hi(p4.y);
                        v1[0] += bf_lo(p4.z); v1[1] += bf_hi(p4.z); v1[2] += bf_lo(p4.w); v1[3] += bf_hi(p4.w); }
                    u32x4 w; w.x = cvt_pk_bf16(v0[0], v0[1]); w.y = cvt_pk_bf16(v0[2], v0[3]); w.z = cvt_pk_bf16(v1[0], v1[1]); w.w = cvt_pk_bf16(v1[2], v1[3]);
                    *(u32x4*)(O + (size_t)row * ldc + col) = w; }
            asm volatile("" ::: "memory"); }
    }
};
struct EpiSsq {
    static constexpr bool PERM = true, AFTER_DRAIN = false;
    bf16_t* O; int ldc; float* ssq;
    __device__ __forceinline__ void operator()(const f32x4 (&acc)[2][2][4][2], const Unit& u, int wr, int wc, int fr, int fq) const {
        const int row0 = u.pm * BM + wr * 64 + fr; const int col0 = u.pn * BM + wc * 32 + 8 * fq;
#pragma unroll
        for (int ai = 0; ai < 2; ++ai)
#pragma unroll
            for (int m = 0; m < 4; ++m) { const int row = row0 + ai * HALF + m * 16; float ss = 0.f;
#pragma unroll
                for (int bj = 0; bj < 2; ++bj) { const f32x4 v0 = acc[ai][bj][m][0], v1 = acc[ai][bj][m][1];
                    ss += (v0[0] * v0[0] + v0[1] * v0[1]) + (v0[2] * v0[2] + v0[3] * v0[3]) + (v1[0] * v1[0] + v1[1] * v1[1]) + (v1[2] * v1[2] + v1[3] * v1[3]);
                    u32x4 w; w.x = cvt_pk_bf16(v0[0], v0[1]); w.y = cvt_pk_bf16(v0[2], v0[3]); w.z = cvt_pk_bf16(v1[0], v1[1]); w.w = cvt_pk_bf16(v1[2], v1[3]);
                    *(u32x4*)(O + (size_t)row * ldc + col0 + bj * HALF) = w; }
                ss += __shfl_xor(ss, 16); ss += __shfl_xor(ss, 32);
                if (fq == 0) ssq[(size_t)row * 32 + u.pn * 4 + wc] = ss; }
    }
};

template <class Epi, class Sched, bool ALIGN_EPI = false, bool SP2 = false>
__device__ __forceinline__ void gemm_phase(PG8_LAS unsigned char* lds, const Gemm g, const Sched& S, const Epi& E) {
    const int tid = threadIdx.x, wid = __builtin_amdgcn_readfirstlane(tid >> 6), lane = tid & 63, wr = wid >> 2, wc = wid & 3, fr = lane & 15, fq = lane >> 4;
    const int K = g.K, nt = K / BK;
    unsigned voffA[2], voffB[2];
#pragma unroll
    for (int i = 0; i < 2; ++i) { int R, C; stage_rc(tid * 16 + i * 8192, R, C); const int Rb = Epi::PERM ? ((R & ~31) + perm32(R & 31)) : R;
        voffA[i] = (unsigned)(R * K + C) * 2u; voffB[i] = (unsigned)(Rb * K + C) * 2u; }
    const size_t kstep = (size_t)(BK * 2);
    const size_t hstep = (size_t)HALF * K * 2;
    const size_t tstep = 2 * hstep;
    const unsigned ldsw = (unsigned)wid * 1024u;
    const int aoff = lds_byte(wr * 64 + fr, fq * 8), boff = lds_byte(wc * 32 + fr, fq * 8);
#define PG8_SA(b, h) (((b) * 2 + (h)) * HTB)
#define PG8_SB(b, h) ((4 + (b) * 2 + (h)) * HTB)
#define PG8_STAGE(bufoff, gbase, voff) do { _Pragma("unroll") for (int _i = 0; _i < 2; ++_i) \
        __builtin_amdgcn_global_load_lds((const unsigned*)((const char*)(gbase) + (voff)[_i]), (PG8_LAS unsigned*)(lds + (bufoff) + ldsw + _i * 8192), 16, 0, 0); } while (0)
#define PG8_LDA(dst, b, h) do { _Pragma("unroll") for (int m = 0; m < 4; ++m) _Pragma("unroll") for (int k = 0; k < 2; ++k) dst[m][k] = *(const PG8_LAS bf16x8*)(lds + PG8_SA(b, h) + aoff + m * 2048 + k * 1024); } while (0)
#define PG8_LDB(dst, b, h) do { _Pragma("unroll") for (int n = 0; n < 2; ++n) _Pragma("unroll") for (int k = 0; k < 2; ++k) dst[n][k] = *(const PG8_LAS bf16x8*)(lds + PG8_SB(b, h) + boff + n * 2048 + k * 1024); } while (0)
#define PG8_MMA(ai, bj, At, Bt) do { __builtin_amdgcn_s_setprio(1); _Pragma("unroll") for (int m = 0; m < 4; ++m) _Pragma("unroll") for (int n = 0; n < 2; ++n) _Pragma("unroll") for (int k = 0; k < 2; ++k) \
        acc[ai][bj][m][n] = __builtin_amdgcn_mfma_f32_16x16x32_bf16(Bt[n][k], At[m][k], acc[ai][bj][m][n], 0, 0, 0); __builtin_amdgcn_s_setprio(0); } while (0)
#define PG8_WAIT_V(n) asm volatile("s_waitcnt vmcnt(" #n ")" ::: "memory")
#define PG8_WAIT_L(n) asm volatile("s_waitcnt lgkmcnt(" #n ")" ::: "memory")
#define PG8_BAR __builtin_amdgcn_s_barrier()
#define PG8_SCHED __builtin_amdgcn_sched_barrier(0)
    Unit cur, nxt; int ui = 0;
    if (!S.next(0, cur)) return;
    f32x4 acc[2][2][4][2];
#pragma unroll
    for (int a = 0; a < 2; ++a)
#pragma unroll
        for (int b = 0; b < 2; ++b)
#pragma unroll
            for (int m = 0; m < 4; ++m)
#pragma unroll
                for (int n = 0; n < 2; ++n) acc[a][b][m][n] = (f32x4){0.f, 0.f, 0.f, 0.f};
    bf16x8 At[4][2], B0[2][2], B1[2][2];
    const char* cA = (const char*)g.A + (size_t)cur.pm * tstep; const char* cB = (const char*)g.Bt + (size_t)cur.pn * tstep;
    S.a_ready(cur);
    if constexpr (SP2) {
        PG8_STAGE(PG8_SB(0, 0), cB, voffB); PG8_STAGE(PG8_SB(0, 1), cB + hstep, voffB); PG8_STAGE(PG8_SA(0, 0), cA, voffA); PG8_STAGE(PG8_SA(0, 1), cA + hstep, voffA);
        if (wr == 1) PG8_BAR;
        PG8_WAIT_V(2); PG8_BAR;
        PG8_STAGE(PG8_SB(1, 0), cB + kstep, voffB); PG8_STAGE(PG8_SA(1, 0), cA + kstep, voffA); PG8_STAGE(PG8_SB(1, 1), cB + hstep + kstep, voffB);
        PG8_WAIT_V(6); PG8_BAR;
    } else {
        PG8_STAGE(PG8_SB(0, 0), cB, voffB); PG8_STAGE(PG8_SA(0, 0), cA, voffA); PG8_STAGE(PG8_SB(0, 1), cB + hstep, voffB); PG8_STAGE(PG8_SA(0, 1), cA + hstep, voffA);
        if (wr == 1) PG8_BAR;
        PG8_WAIT_V(4); PG8_BAR;
        PG8_STAGE(PG8_SB(1, 0), cB + kstep, voffB); PG8_STAGE(PG8_SA(1, 0), cA + kstep, voffA); PG8_STAGE(PG8_SB(1, 1), cB + hstep + kstep, voffB);
        PG8_WAIT_V(6); PG8_BAR;
    }
    for (;;) {
        const bool has_next = S.next(ui + 1, nxt);
        const char* nA = has_next ? (const char*)g.A + (size_t)nxt.pm * tstep : cA; const char* nB = has_next ? (const char*)g.Bt + (size_t)nxt.pn * tstep : cB;
        for (int t = 0; t < nt; t += 2) {
            const bool last = (t == nt - 2);
            const char* a1 = cA + (size_t)(t + 1) * kstep;
            const char* a2 = last ? nA : cA + (size_t)(t + 2) * kstep; const char* b2 = last ? nB : cB + (size_t)(t + 2) * kstep;
            const char* a3 = a2 + kstep; const char* b3 = b2 + kstep;
            if (last && has_next) S.a_ready(nxt);
            if constexpr (SP2) {
            PG8_LDB(B0, 0, 0); PG8_LDB(B1, 0, 1); PG8_SCHED; PG8_LDA(At, 0, 0); PG8_STAGE(PG8_SA(1, 1), a1 + hstep, voffA);
            PG8_WAIT_V(8); PG8_WAIT_L(0); PG8_BAR; PG8_MMA(0, 0, At, B0); PG8_MMA(0, 1, At, B1); PG8_BAR; PG8_SCHED;
            PG8_LDA(At, 0, 1); PG8_STAGE(PG8_SB(0, 0), b2, voffB); PG8_STAGE(PG8_SB(0, 1), b2 + hstep, voffB); PG8_STAGE(PG8_SA(0, 0), a2, voffA);
            PG8_WAIT_V(8); PG8_WAIT_L(0); PG8_BAR; PG8_MMA(1, 0, At, B0); PG8_MMA(1, 1, At, B1); PG8_BAR; PG8_SCHED;
            PG8_LDB(B0, 1, 0); PG8_LDB(B1, 1, 1); PG8_SCHED; PG8_LDA(At, 1, 0); PG8_STAGE(PG8_SA(0, 1), a2 + hstep, voffA);
            PG8_WAIT_V(8); PG8_WAIT_L(0); PG8_BAR; PG8_MMA(0, 0, At, B0); PG8_MMA(0, 1, At, B1); PG8_BAR; PG8_SCHED;
            PG8_LDA(At, 1, 1); PG8_STAGE(PG8_SB(1, 0), b3, voffB); PG8_STAGE(PG8_SB(1, 1), b3 + hstep, voffB); PG8_STAGE(PG8_SA(1, 0), a3, voffA);
            PG8_WAIT_V(8); PG8_WAIT_L(0); PG8_BAR; PG8_MMA(1, 0, At, B0); PG8_MMA(1, 1, At, B1); PG8_BAR; PG8_SCHED;
            } else {
            PG8_LDB(B0, 0, 0); PG8_SCHED; PG8_LDA(At, 0, 0); PG8_STAGE(PG8_SA(1, 1), a1 + hstep, voffA);
            PG8_WAIT_L(8); PG8_BAR; PG8_WAIT_L(0); PG8_MMA(0, 0, At, B0); PG8_BAR; PG8_SCHED;
            PG8_LDB(B1, 0, 1); PG8_STAGE(PG8_SB(0, 0), b2, voffB);
            PG8_BAR; PG8_WAIT_L(0); PG8_MMA(0, 1, At, B1); PG8_BAR;
            PG8_LDA(At, 0, 1); PG8_STAGE(PG8_SA(0, 0), a2, voffA);
            PG8_BAR; PG8_WAIT_L(0); PG8_MMA(1, 0, At, B0); PG8_BAR; PG8_SCHED;
            PG8_STAGE(PG8_SB(0, 1), b2 + hstep, voffB);
            PG8_WAIT_V(6); PG8_BAR; PG8_MMA(1, 1, At, B1); PG8_BAR;
            PG8_LDB(B0, 1, 0); PG8_SCHED; PG8_LDA(At, 1, 0); PG8_STAGE(PG8_SA(0, 1), a2 + hstep, voffA);
            PG8_WAIT_L(8); PG8_BAR; PG8_WAIT_L(0); PG8_MMA(0, 0, At, B0); PG8_BAR; PG8_SCHED;
            PG8_LDB(B1, 1, 1); PG8_STAGE(PG8_SB(1, 0), b3, voffB);
            PG8_BAR; PG8_WAIT_L(0); PG8_MMA(0, 1, At, B1); PG8_BAR;
            PG8_LDA(At, 1, 1); PG8_STAGE(PG8_SA(1, 0), a3, voffA);
            PG8_BAR; PG8_WAIT_L(0); PG8_MMA(1, 0, At, B0); PG8_BAR; PG8_SCHED;
            PG8_STAGE(PG8_SB(1, 1), b3 + hstep, voffB);
            PG8_WAIT_V(6); PG8_BAR; PG8_MMA(1, 1, At, B1); PG8_BAR;
            }
        }
        if constexpr (ALIGN_EPI) { if (wr == 0) PG8_BAR; }
        if constexpr (!Epi::AFTER_DRAIN) { E(acc, cur, wr, wc, fr, fq); S.done(cur); }
        if (!has_next) break;
#pragma unroll
        for (int a = 0; a < 2; ++a)
#pragma unroll
            for (int b = 0; b < 2; ++b)
#pragma unroll
                for (int m = 0; m < 4; ++m)
#pragma unroll
                    for (int n = 0; n < 2; ++n) acc[a][b][m][n] = (f32x4){0.f, 0.f, 0.f, 0.f};
        cur = nxt; cA = nA; cB = nB; ++ui;
        if constexpr (ALIGN_EPI) { if (wr == 1) PG8_BAR; }
    }
    PG8_WAIT_V(0);
    if constexpr (!ALIGN_EPI) { if (wr == 0) PG8_BAR; }
    PG8_BAR;
    if constexpr (Epi::AFTER_DRAIN) { E.fused(acc, cur, wr, wc, fr, fq, lds, wid, lane); S.done(cur); }
#undef PG8_SA
#undef PG8_SB
#undef PG8_STAGE
#undef PG8_LDA
#undef PG8_LDB
#undef PG8_MMA
#undef PG8_WAIT_V
#undef PG8_WAIT_L
#undef PG8_BAR
#undef PG8_SCHED
}
}
constexpr int NWAVES = 8;
constexpr int M = 16384, D = 2048, INC = 13312, PW = 1024, NPIECE = 13;
constexpr int GW = 64, GROWS = 256;
constexpr int NAH = 16, NADH = 64, HGH = 8, HGD = 128;
constexpr float EPS = 1e-6f;
enum { P_NQ = 0, P_NK = 1, P_NV = 2, P_NZ = 3, P_HQ = 4, P_HFF = 5, P_HFB = 6, P_HI = 7, P_HZ = 8, P_GA = 9, P_GB = 11 };
constexpr size_t MiB = 1u << 20;
constexpr size_t WS_CTL = 0, CTL_ZERO_BYTES = 1 * MiB;
constexpr size_t WS_SSQ = 2 * MiB;
constexpr size_t WS_WIN = 4 * MiB;
constexpr size_t WS_WBA = 56 * MiB, WS_WBB = 60 * MiB;
constexpr size_t WS_WOUT = 64 * MiB;
constexpr size_t WS_H = 72 * MiB;
constexpr size_t PIECE_BYTES = (size_t)M * PW * 2, PIECE_ELEMS = (size_t)M * PW;
constexpr size_t WS_END = WS_H + NPIECE * PIECE_BYTES;
static_assert(WS_WIN + (size_t)INC * D * 2 <= WS_WBA && WS_WOUT + (size_t)D * D * 2 <= WS_H, "ws map");
constexpr size_t WS_SLOC = 4 * MiB, WS_DSEG = 36 * MiB;
constexpr int HG_SEGC = 8, HG_NSEG = 32;
constexpr int CW_BAR = 4096;
constexpr int RING_OFF = 0, RING_BYTES = 150528;
constexpr int LDSCTL_OFF = RING_BYTES, MISC_OFF = LDSCTL_OFF + 320;
constexpr int LDS_BYTES = 152576;
#define GAS __attribute__((address_space(1)))
#define LAS __attribute__((address_space(3)))
typedef unsigned short bf16;
typedef unsigned v4u __attribute__((ext_vector_type(4)));
typedef float f32x4 __attribute__((ext_vector_type(4)));
typedef short bf16x8 __attribute__((ext_vector_type(8)));
typedef GAS unsigned gu32;
typedef GAS unsigned long long gu64;
#define RLX_AGENT __ATOMIC_RELAXED, __HIP_MEMORY_SCOPE_AGENT
#define LDS_WAIT() asm volatile("s_waitcnt lgkmcnt(0)" ::: "memory")
#define VM_WAIT() asm volatile("s_waitcnt vmcnt(0)" ::: "memory")
__device__ __forceinline__ unsigned long long rt() { return __builtin_amdgcn_s_memrealtime(); }
__device__ __forceinline__ unsigned f2bf(float f) { unsigned u = __builtin_bit_cast(unsigned, f); return (u + 0x7fffu + ((u >> 16) & 1u)) >> 16; }
__device__ __forceinline__ unsigned pk2(float lo, float hi) { return pg8::cvt_pk_bf16(lo, hi); }

#define XB_TMO      128
#define XB_XCNT(j)  (256  + 64 * (j))
#define XB_XSUB(j)  (1280 + 64 * (j))
#define XB_XGEN(j)  (2304 + 64 * (j))
#define XB_TOP      3328
#define XB_TOPGEN   3392
#define XCD_BAR_WORDS 3456
#define XB_SPIN_CAP (1u << 18)

__device__ __forceinline__ unsigned xb_ld(unsigned* p)              { return __hip_atomic_load(p, __ATOMIC_RELAXED, __HIP_MEMORY_SCOPE_AGENT); }
__device__ __forceinline__ unsigned xb_add(unsigned* p, unsigned v) { return __hip_atomic_fetch_add(p, v, __ATOMIC_RELAXED, __HIP_MEMORY_SCOPE_AGENT); }
__device__ __forceinline__ unsigned xb_xcc_id() { return (unsigned)__builtin_amdgcn_s_getreg((3 << 11) | 20) & 0xFu; }
#define XB_SPIN(cond, bar) do { unsigned _sp = 0; while (cond) { __builtin_amdgcn_s_sleep(1); \
    if ((++_sp & 255u) == 0u) { if (xb_ld(&(bar)[XB_TMO])) break; if (_sp > XB_SPIN_CAP) { atomicAdd(&(bar)[XB_TMO], 1u); break; } } } } while (0)

struct XcdBarrier {
    unsigned* bar; unsigned x;
    volatile LAS unsigned* st;
};

__device__ __forceinline__ XcdBarrier xcd_barrier_post(unsigned* bar, volatile LAS unsigned* st) {
    XcdBarrier b; b.bar = bar; b.x = xb_xcc_id(); b.st = st;
    if (threadIdx.x == 0) (void)xb_add(&bar[XB_XCNT(b.x)], 1u);
    return b;
}
__device__ __forceinline__ void xcd_barrier_complete(unsigned* bar, unsigned x, unsigned& nloc, unsigned& nx) {
    const unsigned G = gridDim.x * gridDim.y * gridDim.z;
    unsigned sum, cnt, mine, sp = 0u;
    for (;;) {
        sum = 0u; cnt = 0u; mine = 0u;
#pragma unroll
        for (unsigned j = 0; j < 16; ++j) { const unsigned c = xb_ld(&bar[XB_XCNT(j)]); sum += c; cnt += (c > 0u) ? 1u : 0u; mine = (j == x) ? c : mine; }
        if (sum == G) break;
        __builtin_amdgcn_s_sleep(1);
        if ((++sp & 255u) == 0u) { if (xb_ld(&bar[XB_TMO])) break; if (sp > XB_SPIN_CAP) { atomicAdd(&bar[XB_TMO], 1u); break; } }
    }
    nloc = mine > 0u ? mine : 1u; nx = cnt > 0u ? cnt : 1u;
}

__device__ __forceinline__ void xcd_barrier(const XcdBarrier& b) {
    asm volatile("s_waitcnt vmcnt(0)" ::: "memory");
    __syncthreads();
    if (threadIdx.x == 0) {
        unsigned* bar = b.bar;
        __builtin_amdgcn_s_waitcnt(0);
        unsigned nloc = b.st[0], nx = b.st[1];
        if (nloc == 0u) { xcd_barrier_complete(bar, b.x, nloc, nx); b.st[0] = nloc; b.st[1] = nx; }
        const unsigned old = xb_add(&bar[XB_XSUB(b.x)], 1u);
        const unsigned gen = old / nloc;
        if (old + 1u == (gen + 1u) * nloc) {
            __builtin_amdgcn_fence(__ATOMIC_RELEASE, "agent");
            asm volatile("s_waitcnt vmcnt(0)" ::: "memory");
            const unsigned og = xb_add(&bar[XB_TOP], 1u);
            const unsigned tg = og / nx;
            if (og + 1u == (tg + 1u) * nx) xb_add(&bar[XB_TOPGEN], 1u);
            else XB_SPIN(xb_ld(&bar[XB_TOPGEN]) == tg, bar);
            __builtin_amdgcn_fence(__ATOMIC_ACQUIRE, "agent");
            xb_add(&bar[XB_XGEN(b.x)], 1u);
            asm volatile("s_waitcnt vmcnt(0)" ::: "memory");
        } else {
            XB_SPIN(xb_ld(&bar[XB_XGEN(b.x)]) == gen, bar);
            __builtin_amdgcn_fence(__ATOMIC_ACQUIRE, "agent");
            asm volatile("s_waitcnt vmcnt(0)" ::: "memory");
        }
    }
    __syncthreads();
}
__device__ __forceinline__ float wave_sum(float v) {
#pragma unroll
    for (int o = 1; o < 64; o <<= 1) v += __shfl_xor(v, o);
    return v;
}
__device__ __forceinline__ void p0_transpose_item(const float* W, int K, int N, bf16* WT, int row_off, LAS float* scr, int item, int lane) {
    const int nblk = N / 32, kb = item / nblk, nb = item % nblk, k0 = 64 * kb, n0 = 32 * nb;
    float wv_[32];
#pragma unroll
    for (int i = 0; i < 32; ++i) { const int kk = 2 * i + (lane >> 5); wv_[i] = W[(size_t)(k0 + kk) * N + n0 + (lane & 31)]; }
#pragma unroll
    for (int i = 0; i < 32; ++i) { const int kk = 2 * i + (lane >> 5); scr[kk * 33 + (lane & 31)] = wv_[i]; }
    LDS_WAIT(); asm volatile("" ::: "memory");
    const int c = lane & 7;
#pragma unroll
    for (int j = 0; j < 4; ++j) { const int n = (lane >> 3) + 8 * j; const LAS float* s = scr + (8 * c) * 33 + n;
        v4u o; o.x = pk2(s[0 * 33], s[1 * 33]); o.y = pk2(s[2 * 33], s[3 * 33]); o.z = pk2(s[4 * 33], s[5 * 33]); o.w = pk2(s[6 * 33], s[7 * 33]);
        *(GAS v4u*)(WT + (size_t)(row_off + n0 + n) * K + k0 + 8 * c) = o; }
    LDS_WAIT(); asm volatile("" ::: "memory");
}
struct Frame {
    LAS unsigned char* lds;
    volatile LAS unsigned* MISC;
    gu32* ctl;
    int wave;
    __device__ __forceinline__ int lane_() const { return (int)__builtin_amdgcn_mbcnt_hi(~0u, __builtin_amdgcn_mbcnt_lo(~0u, 0u)); }
    __device__ __forceinline__ int tid_() const { return wave * 64 + lane_(); }
    int vcu, G;
};
__device__ __forceinline__ float bf2f(bf16 b) { return __builtin_bit_cast(float, (unsigned)b << 16); }
__device__ __forceinline__ float wave_max(float v) {
#pragma unroll
    for (int o = 1; o < 64; o <<= 1) v = fmaxf(v, __shfl_xor(v, o));
    return v;
}
__device__ __forceinline__ float sigm(float x) { return 1.0f / (1.0f + __expf(-x)); }

__device__ __forceinline__ void p0_prologue(Frame& F, const float* x, const float* w_pre, const float* w_in, const float* w_br, const float* w_out,
                                            bf16* XN, bf16* WIN_T, bf16* WBA_T, bf16* WBB_T, bf16* WOUT_T) {
    LAS float* scr = (LAS float*)(F.lds + RING_OFF + F.wave * 16384);
    const int gw = F.vcu * NWAVES + F.wave, NGW = F.G * NWAVES;
    constexpr int I_IN = (D / 64) * (INC / 32), I_BR = (PW / 64) * (D / 32), I_OUT = (D / 64) * (D / 32);
    constexpr int NITEMS = I_IN + 2 * I_BR + I_OUT;
    for (int it = gw; it < NITEMS; it += NGW) {
        int r = it;
        if (r < I_IN) { p0_transpose_item(w_in, D, INC, WIN_T, 0, scr, r, F.lane_()); continue; } r -= I_IN;
        if (r < I_BR) { p0_transpose_item(w_br, PW, D, WBA_T, 0, scr, r, F.lane_()); continue; } r -= I_BR;
        if (r < I_BR) { p0_transpose_item(w_br + (size_t)PW * D, PW, D, WBB_T, 0, scr, r, F.lane_()); continue; } r -= I_BR;
        p0_transpose_item(w_out, D, D, WOUT_T, 0, scr, r, F.lane_());
    }
    for (int m = gw; m < M; m += NGW) {
        const f32x4* xr = (const f32x4*)(x + (size_t)m * D) + F.lane_();
        f32x4 v[8]; float s = 0.f;
#pragma unroll
        for (int j = 0; j < 8; ++j) { v[j] = xr[64 * j]; s += (v[j].x * v[j].x + v[j].y * v[j].y) + (v[j].z * v[j].z + v[j].w * v[j].w); }
        const float rstd = 1.0f / sqrtf(wave_sum(s) * (1.f / D) + EPS);
        unsigned long long* o8 = (unsigned long long*)(XN + (size_t)m * D) + F.lane_();
#pragma unroll
        for (int j = 0; j < 8; ++j) { const f32x4 w = *((const f32x4*)w_pre + F.lane_() + 64 * j);
            o8[64 * j] = (unsigned long long)pk2(v[j].x * rstd * w.x, v[j].y * rstd * w.y) | ((unsigned long long)pk2(v[j].z * rstd * w.z, v[j].w * rstd * w.w) << 32); }
    }
}

__device__ __forceinline__ void na_naive(Frame& F, bf16* Q, const bf16* K, const bf16* V, const bf16* Z, const float* rpb) {
    const int gw = F.vcu * NWAVES + F.wave, NGW = F.G * NWAVES, lane = F.lane_();
    for (int it = gw; it < M * NAH; it += NGW) {
        const int h = it & 15, tq = it >> 4, r = tq >> 6, c = tq & 63;
        int rs = r - 4; rs = rs < 0 ? 0 : (rs > GROWS - 8 ? GROWS - 8 : rs);
        int cs = c - 8; cs = cs < 0 ? 0 : (cs > GW - 16 ? GW - 16 : cs);
        const v4u* qp = (const v4u*)(Q + (size_t)tq * PW + h * NADH);
        v4u qv[8];
#pragma unroll
        for (int i = 0; i < 8; ++i) qv[i] = qp[i];
        float sc[2];
#pragma unroll
        for (int e = 0; e < 2; ++e) {
            const int j = lane + 64 * e, kr = rs + (j >> 4), kc = cs + (j & 15), tk = kr * GW + kc;
            const v4u* kp = (const v4u*)(K + (size_t)tk * PW + h * NADH);
            float a = 0.f;
#pragma unroll
            for (int i = 0; i < 8; ++i) { const v4u kv = kp[i];
                a += pg8::bf_lo(qv[i].x) * pg8::bf_lo(kv.x) + pg8::bf_hi(qv[i].x) * pg8::bf_hi(kv.x) + pg8::bf_lo(qv[i].y) * pg8::bf_lo(kv.y) + pg8::bf_hi(qv[i].y) * pg8::bf_hi(kv.y)
                   + pg8::bf_lo(qv[i].z) * pg8::bf_lo(kv.z) + pg8::bf_hi(qv[i].z) * pg8::bf_hi(kv.z) + pg8::bf_lo(qv[i].w) * pg8::bf_lo(kv.w) + pg8::bf_hi(qv[i].w) * pg8::bf_hi(kv.w); }
            sc[e] = a * 0.125f + rpb[(h * 15 + (kr - r + 7)) * 31 + (kc - c + 15)];
        }
        const float mx = wave_max(fmaxf(sc[0], sc[1]));
        const float e0 = __expf(sc[0] - mx), e1 = __expf(sc[1] - mx);
        const float inv = 1.0f / wave_sum(e0 + e1);
        const float p0 = e0 * inv, p1 = e1 * inv;
        float o = 0.f;
        for (int j = 0; j < 64; ++j) {
            const int kr = rs + (j >> 4), kc = cs + (j & 15), tk = kr * GW + kc;
            const float pa = __shfl(p0, j), pb = __shfl(p1, j);
            o += pa * bf2f(V[(size_t)tk * PW + h * NADH + lane]);
            o += pb * bf2f(V[(size_t)(tk + 4 * GW) * PW + h * NADH + lane]);
        }
        const float z = bf2f(Z[(size_t)tq * PW + h * NADH + lane]);
        o *= z * sigm(z);
        Q[(size_t)tq * PW + h * NADH + lane] = (bf16)f2bf(o);
    }
}

__device__ __forceinline__ void hg_naive(Frame& F, const bf16* HQ, const bf16* HFF, const bf16* HFB, const bf16* HI, const float* lb_logits, float* OFWD, float* OBWD) {
    LAS float* red = (LAS float*)(F.lds + RING_OFF);
    for (int u = blockIdx.x; u < 256; u += F.G) {
        const int hd = u >> 4, head = hd >> 1, dir = hd & 1, dv0 = (u & 15) * 8;
        const int dk = F.tid_() & 127, part = F.tid_() >> 7;
        const int ch = head * HGD + dk;
        const float lbv = sigm(lb_logits[dir * 1024 + ch] - lb_logits[2048 + dir * 1024 + ch]);
        const bf16* FL = dir ? HFB : HFF; float* OUT = dir ? OBWD : OFWD;
        const int cv = head * HGD + dv0 + part * 2;
        float S0 = 0.f, S1 = 0.f;
        for (int cb = 0; cb < M / 64; ++cb) {
            LAS float* rb = red + (cb & 1) * 1024;
#pragma unroll 8
            for (int s = 0; s < 64; ++s) {
                const int step = cb * 64 + s, t = dir ? (M - 1 - step) : step;
                const float fl = bf2f(FL[(size_t)t * PW + ch]), q = bf2f(HQ[(size_t)t * PW + ch]);
                const unsigned vv = *(const unsigned*)(HI + (size_t)t * PW + cv);
                const float v0 = pg8::bf_lo(vv), v1 = pg8::bf_hi(vv);
                const float sg = sigm(fl), f = lbv + (1.f - lbv) * sg, k = (1.f - lbv) * (1.f - sg);
                S0 = f * S0 + k * v0; S1 = f * S1 + k * v1;
                const float p0 = wave_sum(S0 * q), p1 = wave_sum(S1 * q);
                if (F.lane_() == 0) { rb[(s * 8 + F.wave) * 2] = p0; rb[(s * 8 + F.wave) * 2 + 1] = p1; }
            }
            __syncthreads();
            { const int s = F.tid_() >> 3, j = F.tid_() & 7, pp = j >> 1, e = j & 1;
              const int step = cb * 64 + s, t = dir ? (M - 1 - step) : step;
              OUT[(size_t)t * PW + head * HGD + dv0 + j] = rb[(s * 8 + 2 * pp) * 2 + e] + rb[(s * 8 + 2 * pp + 1) * 2 + e]; }
        }
        __syncthreads();
    }
}
constexpr int HG_IM0 = 0, HG_IMSET = 49152  , HG_IMP = 2 * HG_IMSET, HG_PROW = 144, HG_IMS = HG_IMP + 64 * HG_PROW, HG_WTOT = HG_IMS + 8 * 4096, HG_EC = HG_WTOT + 4096  ,
              HG_PART = HG_EC + 2048, HG_LDS_END = HG_PART + 64 * 8 * 4;
static_assert(HG_LDS_END <= RING_BYTES, "hg lds");
__device__ __forceinline__ unsigned off_b(unsigned row, unsigned ch) { return 256u * row + 16u * (ch ^ (((row & 3) << 2) | ((row >> 2) & 3))); }
typedef short s16x4 __attribute__((ext_vector_type(4)));
typedef float f32x2 __attribute__((ext_vector_type(2)));
__device__ __forceinline__ pg8::bf16x8 tr_pair(const LAS unsigned char* a0, const LAS unsigned char* a1) {
    const s16x4 r0 = __builtin_amdgcn_ds_read_tr16_b64_v4i16((LAS s16x4*)a0), r1 = __builtin_amdgcn_ds_read_tr16_b64_v4i16((LAS s16x4*)a1);
    return __builtin_shufflevector(r0, r1, 0, 1, 2, 3, 4, 5, 6, 7);
}
#define MFMA16(a, b, c) __builtin_amdgcn_mfma_f32_16x16x32_bf16((a), (b), (c), 0, 0, 0)
__device__ __forceinline__ unsigned cvtpk(float lo, float hi) { return pg8::cvt_pk_bf16(lo, hi); }
__device__ __forceinline__ unsigned long long cvtpk4(const f32x4 v) { return (unsigned long long)cvtpk(v[0], v[1]) | ((unsigned long long)cvtpk(v[2], v[3]) << 32); }
struct HgRaw { unsigned f[8], q[8], v[8]; };
__device__ __forceinline__ void hg_load(HgRaw& R, __amdgpu_buffer_rsrc_t rs, unsigned offq, unsigned offf, unsigned offv, int c, int w, int lane, int chb) {
    const unsigned row0 = (unsigned)((64 * c + 8 * w) * PW + chb) * 2u;
#pragma unroll
    for (int i = 0; i < 8; ++i) { const unsigned so = row0 + (unsigned)i * (PW * 2u);
        R.f[i] = __builtin_amdgcn_raw_buffer_load_b32(rs, lane * 4, offf + so, 0); R.q[i] = __builtin_amdgcn_raw_buffer_load_b32(rs, lane * 4, offq + so, 0);
        R.v[i] = __builtin_amdgcn_raw_buffer_load_b32(rs, lane * 4, offv + so, 0); }
}
__device__ __forceinline__ void hg_pre(Frame& F, int head, int dir, int c0, int nch, bf16* Hbase, int pq, int pf_, int pv_, const float* lb_logits,
                                       unsigned char* QM, float* EC, float* S_out, float* Dseg_out) {
    LAS unsigned char* L = F.lds + RING_OFF;
    const int lane = F.lane_(), w = F.wave, tid = F.tid_();
    const int chb = head * HGD;
    float lbv[2], omlb[2];
#pragma unroll
    for (int e = 0; e < 2; ++e) { const int ch = chb + 2 * lane + e; lbv[e] = sigm(lb_logits[dir * 1024 + ch] - lb_logits[2048 + dir * 1024 + ch]); omlb[e] = 1.f - lbv[e]; }
    f32x4 S[8];
#pragma unroll
    for (int kt = 0; kt < 8; ++kt) S[kt] = (f32x4){0.f, 0.f, 0.f, 0.f};
    float dseg[2] = {0.f, 0.f}, cprev[2] = {1.f, 1.f};
    HgRaw R;
    const __amdgpu_buffer_rsrc_t rs = __builtin_amdgcn_make_buffer_rsrc((void*)Hbase, 0, (int)(NPIECE * PIECE_BYTES), 0x00020000);
    const unsigned offq = (unsigned)(pq * PIECE_BYTES), offf = (unsigned)(pf_ * PIECE_BYTES), offv = (unsigned)(pv_ * PIECE_BYTES);
    hg_load(R, rs, offq, offf, offv, dir ? (c0 + nch - 1) : c0, w, lane, chb);
    for (int ci = 0; ci < nch; ++ci) {
        const int c = dir ? (c0 + nch - 1 - ci) : (c0 + ci);
        int lane_v = lane; asm volatile("" : "+v"(lane_v));
        const int n = lane_v & 15, g = lane_v >> 4, q4 = n >> 2, p4 = n & 3;
        float Aloc[8][2], kk[8][2], qq[8][2]; unsigned vraw[8];
        float run0 = 0.f, run1 = 0.f;
#pragma unroll
        for (int ii = 0; ii < 8; ++ii) { const int i = dir ? 7 - ii : ii;
            const float s0 = pg8::sigmoidf_(pg8::bf_lo(R.f[i])), s1 = pg8::sigmoidf_(pg8::bf_hi(R.f[i]));
            run0 += __builtin_amdgcn_logf(lbv[0] + omlb[0] * s0); run1 += __builtin_amdgcn_logf(lbv[1] + omlb[1] * s1);
            kk[i][0] = omlb[0] - omlb[0] * s0; kk[i][1] = omlb[1] - omlb[1] * s1;
            qq[i][0] = pg8::bf_lo(R.q[i]); qq[i][1] = pg8::bf_hi(R.q[i]);
            vraw[i] = R.v[i]; Aloc[i][0] = run0; Aloc[i][1] = run1; }
        if (ci + 1 < nch) hg_load(R, rs, offq, offf, offv, dir ? (c - 1) : (c + 1), w, lane, chb);
        LAS float* WT = (LAS float*)(L + HG_WTOT);
        *(LAS f32x2*)(WT + w * 128 + 2 * lane) = (f32x2){run0, run1};
        __syncthreads();
        float pre0 = 0.f, pre1 = 0.f, ref0 = 0.f, ref1 = 0.f, tot0 = 0.f, tot1 = 0.f;
#pragma unroll
        for (int ww = 0; ww < 8; ++ww) { const f32x2 tv = *(LAS f32x2*)(WT + ww * 128 + 2 * lane);
            const bool before = dir ? (ww > w) : (ww < w), inref = dir ? (ww >= 4) : (ww < 4);
            if (before) { pre0 += tv.x; pre1 += tv.y; } if (inref) { ref0 += tv.x; ref1 += tv.y; } tot0 += tv.x; tot1 += tv.y; }
        dseg[0] += tot0; dseg[1] += tot1;
        unsigned char* qimg = QM + (size_t)(head * (M / 64) + c) * 16384;
        unsigned char* kimg = (unsigned char*)Hbase + (size_t)pf_ * PIECE_BYTES + ((size_t)(64 * c) * PW + chb) * 2;
#pragma unroll
        for (int i = 0; i < 8; ++i) {
            const int tau = 8 * w + i;
            const float d0 = pre0 + Aloc[i][0] - ref0, d1 = pre1 + Aloc[i][1] - ref1;
            const unsigned ob = off_b(tau, lane >> 2) + (lane & 3) * 4;
            const unsigned qm = cvtpk(qq[i][0] * __builtin_amdgcn_exp2f(d0), qq[i][1] * __builtin_amdgcn_exp2f(d1));
            const unsigned km = cvtpk(kk[i][0] * __builtin_amdgcn_exp2f(fminf(-d0, 120.f)), kk[i][1] * __builtin_amdgcn_exp2f(fminf(-d1, 120.f)));
            *(unsigned*)(qimg + ob) = qm;
            *(unsigned*)(kimg + (size_t)tau * (PW * 2) + (ob - 256u * tau)) = km;
            *(LAS unsigned*)(L + HG_IM0 + 16384 + ob) = km;
            *(LAS unsigned*)(L + HG_IM0 + 32768 + ob) = vraw[i];
        }
        if (w == 0) { const f32x2 er = (f32x2){__builtin_amdgcn_exp2f(ref0), __builtin_amdgcn_exp2f(ref1)};
                      const f32x2 fs = (f32x2){er.x * cprev[0], er.y * cprev[1]};
                      cprev[0] = __builtin_amdgcn_exp2f(tot0 - ref0); cprev[1] = __builtin_amdgcn_exp2f(tot1 - ref1);
                      *(LAS f32x2*)((LAS float*)(L + HG_EC) + 2 * lane) = fs;
                      *(LAS f32x2*)((LAS float*)(L + HG_EC) + 128 + 2 * lane) = (f32x2){cprev[0], cprev[1]};
                      *(f32x2*)(EC + (size_t)(head * (M / 64) + c) * 128 + 2 * lane) = (ci == 0) ? er : fs; }
        __syncthreads();
        f32x4 fsc[8];
#pragma unroll
        for (int kt = 0; kt < 8; ++kt) fsc[kt] = *(const LAS f32x4*)((LAS float*)(L + HG_EC) + 16 * kt + 4 * g);
        pg8::bf16x8 vf[2];
#pragma unroll
        for (int ks = 0; ks < 2; ++ks) vf[ks] = tr_pair(L + HG_IM0 + 32768 + off_b(32 * ks + 8 * g + q4, 2 * w + (p4 >> 1)) + 8 * (p4 & 1), L + HG_IM0 + 32768 + off_b(32 * ks + 8 * g + 4 + q4, 2 * w + (p4 >> 1)) + 8 * (p4 & 1));
#pragma unroll
        for (int kh = 0; kh < 2; ++kh) {
            pg8::bf16x8 kf[4][2];
#pragma unroll
            for (int k2 = 0; k2 < 4; ++k2) { const int kt = 4 * kh + k2;
                kf[k2][0] = tr_pair(L + HG_IM0 + 16384 + off_b(8 * g + q4, 2 * kt + (p4 >> 1)) + 8 * (p4 & 1), L + HG_IM0 + 16384 + off_b(8 * g + 4 + q4, 2 * kt + (p4 >> 1)) + 8 * (p4 & 1));
                kf[k2][1] = tr_pair(L + HG_IM0 + 16384 + off_b(32 + 8 * g + q4, 2 * kt + (p4 >> 1)) + 8 * (p4 & 1), L + HG_IM0 + 16384 + off_b(32 + 8 * g + 4 + q4, 2 * kt + (p4 >> 1)) + 8 * (p4 & 1)); }
#pragma unroll
            for (int k2 = 0; k2 < 4; ++k2) { const int kt = 4 * kh + k2; S[kt] = S[kt] * fsc[kt]; S[kt] = MFMA16(kf[k2][0], vf[0], S[kt]); S[kt] = MFMA16(kf[k2][1], vf[1], S[kt]); }
        }
    }
    __syncthreads();
#pragma unroll
    for (int kt = 0; kt < 8; ++kt) { const f32x4 c4 = *(const LAS f32x4*)((LAS float*)(L + HG_EC) + 128 + 16 * kt + 4 * (lane >> 4)); S[kt] = S[kt] * c4; }
    __syncthreads();
#pragma unroll
    for (int kt = 0; kt < 8; ++kt) ((f32x4*)S_out)[kt * 512 + tid] = S[kt];
    if (w == 0) { Dseg_out[2 * lane] = dseg[0]; Dseg_out[2 * lane + 1] = dseg[1]; }
}
struct HgImg { v4u q[2], k[2], v[2]; float ec; };
__device__ __forceinline__ void hg_img_load(HgImg& R, const unsigned char* qimg, const unsigned char* kimg, const unsigned char* vimg, const float* ec, int tid) {
#pragma unroll
    for (int j = 0; j < 2; ++j) { const int p = tid + 512 * j, tau = p >> 4, c16 = p & 15;
        R.q[j] = *(const v4u*)(qimg + 16 * p); R.k[j] = *(const v4u*)(kimg + (size_t)tau * (PW * 2) + 16 * c16); R.v[j] = *(const v4u*)(vimg + (size_t)tau * (PW * 2) + 16 * c16); }
    R.ec = ec[tid & 127];
}
template <int MODE>
__device__ __forceinline__ void hg_main(Frame& F, int head, int dir, int c0, int nch, const bf16* Hbase, int pf_, int pv_, const unsigned char* QM, const float* EC,
                                        const float* SL, const float* DS, int jseg, unsigned long long* SCR, const bf16* HZ, const float* wn, bf16* OB) {
    LAS unsigned char* L = F.lds + RING_OFF;
    const int lane = F.lane_(), w = F.wave, tid = F.tid_();
    const int chb = head * HGD;
    f32x4 S[8];
#pragma unroll
    for (int kt = 0; kt < 8; ++kt) S[kt] = (f32x4){0.f, 0.f, 0.f, 0.f};
    if (jseg > 0) {
        const int g0 = lane >> 4;
#pragma unroll
        for (int kt = 0; kt < 8; ++kt) S[kt] = ((const f32x4*)(SL + (size_t)(jseg - 1) * HGD * HGD))[kt * 512 + tid];
        f32x4 P[8];
#pragma unroll
        for (int kt = 0; kt < 8; ++kt) P[kt] = (f32x4){1.f, 1.f, 1.f, 1.f};
        for (int i = jseg - 2; i >= 0; --i) {
            bool live = false;
#pragma unroll
            for (int kt = 0; kt < 8; ++kt) { const f32x4 dl = *(const f32x4*)(DS + (size_t)(i + 1) * HGD + 16 * kt + 4 * g0);
#pragma unroll
                for (int r = 0; r < 4; ++r) { P[kt][r] *= __builtin_amdgcn_exp2f(dl[r]); live |= (P[kt][r] != 0.f); } }
            if (!live) break;
#pragma unroll
            for (int kt = 0; kt < 8; ++kt) { const f32x4 Lc = ((const f32x4*)(SL + (size_t)i * HGD * HGD))[kt * 512 + tid]; S[kt] = S[kt] + P[kt] * Lc; }
        }
    }
    const unsigned char* kbase = (const unsigned char*)Hbase + (size_t)pf_ * PIECE_BYTES + (size_t)chb * 2;
    const unsigned char* vbase = (const unsigned char*)Hbase + (size_t)pv_ * PIECE_BYTES + (size_t)chb * 2;
    f32x4 wv = (f32x4){0.f, 0.f, 0.f, 0.f};
    if (MODE == 2) wv = *(const f32x4*)(wn + chb + 16 * w + 4 * (lane >> 4));
    unsigned long long held[4] = {0ull, 0ull, 0ull, 0ull}; int c_held = -1;
    HgImg R;
    { const int c = dir ? (c0 + nch - 1) : c0; hg_img_load(R, QM + (size_t)(head * (M / 64) + c) * 16384, kbase + (size_t)(64 * c) * (PW * 2), vbase + (size_t)(64 * c) * (PW * 2), EC + (size_t)(head * (M / 64) + c) * 128, tid); }
    for (int ci = 0; ci < nch; ++ci) {
        const int c = dir ? (c0 + nch - 1 - ci) : (c0 + ci);
        int lane_v = lane; asm volatile("" : "+v"(lane_v));
        const int n = lane_v & 15, g = lane_v >> 4, q4 = n >> 2, p4 = n & 3;
        LAS unsigned char* IM = L + HG_IM0 + (ci & 1) * HG_IMSET;
        LAS float* ECL = (LAS float*)(L + HG_EC) + (ci & 1) * 128;
#pragma unroll
        for (int j = 0; j < 2; ++j) { const int p = tid + 512 * j, tau = p >> 4, c16 = p & 15;
            *(LAS v4u*)(IM + 16 * p) = R.q[j]; *(LAS v4u*)(IM + 16384 + 16 * p) = R.k[j]; *(LAS v4u*)(IM + 32768 + off_b(tau, c16)) = R.v[j]; }
        if (tid < 128) ECL[tid] = R.ec;
        if (c_held >= 0) {
#pragma unroll
            for (int tt = 0; tt < 4; ++tt) { if (MODE == 1) SCR[(size_t)((c_held - c0) * 4 + tt) * 512 + tid] = held[tt];
                else *(unsigned long long*)(OB + (size_t)(64 * c_held + 16 * tt + n) * PW + chb + 16 * w + 4 * g) = held[tt]; } }
        unsigned long long scr[4], zz4[4];
        if (MODE == 2) {
#pragma unroll
            for (int tt = 0; tt < 4; ++tt) { scr[tt] = SCR[(size_t)((c - c0) * 4 + tt) * 512 + tid]; zz4[tt] = *(const unsigned long long*)(HZ + (size_t)(64 * c + 16 * tt + n) * PW + chb + 16 * w + 4 * g); } }
        if (ci + 1 < nch) { const int cn = dir ? (c - 1) : (c + 1);
            hg_img_load(R, QM + (size_t)(head * (M / 64) + cn) * 16384, kbase + (size_t)(64 * cn) * (PW * 2), vbase + (size_t)(64 * cn) * (PW * 2), EC + (size_t)(head * (M / 64) + cn) * 128, tid); }
        __syncthreads();
        { const int tt = w >> 1;
          pg8::bf16x8 bq[4], ak[2][4]; f32x4 fsc[8];
#pragma unroll
          for (int ks = 0; ks < 4; ++ks) bq[ks] = *(const LAS pg8::bf16x8*)(IM + off_b(16 * tt + n, 4 * ks + g));
#pragma unroll
          for (int si = 0; si < 2; ++si)
#pragma unroll
              for (int ks = 0; ks < 4; ++ks) ak[si][ks] = *(const LAS pg8::bf16x8*)(IM + 16384 + off_b(16 * (2 * (w & 1) + si) + n, 4 * ks + g));
#pragma unroll
          for (int kt = 0; kt < 8; ++kt) fsc[kt] = *(const LAS f32x4*)(ECL + 16 * kt + 4 * g);
          f32x4 pacc[2];
#pragma unroll
          for (int si = 0; si < 2; ++si) { pacc[si] = (f32x4){0.f, 0.f, 0.f, 0.f};
#pragma unroll
              for (int ks = 0; ks < 4; ++ks) pacc[si] = MFMA16(ak[si][ks], bq[ks], pacc[si]); }
#pragma unroll
          for (int kt = 0; kt < 8; ++kt) S[kt] = S[kt] * fsc[kt];
#pragma unroll
          for (int si = 0; si < 2; ++si) { const int st = 2 * (w & 1) + si, tcol = 16 * tt + n, srow = 16 * st + 4 * g;
#pragma unroll
              for (int r = 0; r < 4; ++r) pacc[si][r] = (dir ? (srow + r >= tcol) : (srow + r <= tcol)) ? pacc[si][r] : 0.f;
              *(LAS unsigned long long*)(L + HG_IMP + tcol * HG_PROW + srow * 2) = cvtpk4(pacc[si]); }
#pragma unroll
          for (int kt = 0; kt < 8; ++kt) *(LAS unsigned long long*)(L + HG_IMS + w * 4096 + off_b(n, 2 * kt + (g >> 1)) + 8 * (g & 1)) = cvtpk4(S[kt]);
        }
        pg8::bf16x8 vf[2];
#pragma unroll
        for (int ks = 0; ks < 2; ++ks) vf[ks] = tr_pair(IM + 32768 + off_b(32 * ks + 8 * g + q4, 2 * w + (p4 >> 1)) + 8 * (p4 & 1), IM + 32768 + off_b(32 * ks + 8 * g + 4 + q4, 2 * w + (p4 >> 1)) + 8 * (p4 & 1));
        __syncthreads();
        f32x4 oacc[4];
        { pg8::bf16x8 sf[4];
#pragma unroll
          for (int ks = 0; ks < 4; ++ks) sf[ks] = *(const LAS pg8::bf16x8*)(L + HG_IMS + w * 4096 + off_b(n, 4 * ks + g));
#pragma unroll
          for (int th = 0; th < 2; ++th) {
              pg8::bf16x8 pf[2][2], qf[2][4];
#pragma unroll
              for (int t2 = 0; t2 < 2; ++t2) { const int tt = 2 * th + t2;
#pragma unroll
                  for (int ks = 0; ks < 2; ++ks) { if (dir ? (32 * ks + 31 < 16 * tt) : (32 * ks > 16 * tt + 15)) continue;
                      pf[t2][ks] = *(const LAS pg8::bf16x8*)(L + HG_IMP + (16 * tt + n) * HG_PROW + (32 * ks + 8 * g) * 2); }
#pragma unroll
                  for (int ks = 0; ks < 4; ++ks) qf[t2][ks] = *(const LAS pg8::bf16x8*)(IM + off_b(16 * tt + n, 4 * ks + g)); }
#pragma unroll
              for (int t2 = 0; t2 < 2; ++t2) { const int tt = 2 * th + t2;
                  f32x4 a = (f32x4){0.f, 0.f, 0.f, 0.f};
#pragma unroll
                  for (int ks = 0; ks < 2; ++ks) { if (dir ? (32 * ks + 31 < 16 * tt) : (32 * ks > 16 * tt + 15)) continue; a = MFMA16(vf[ks], pf[t2][ks], a); }
#pragma unroll
                  for (int ks = 0; ks < 4; ++ks) a = MFMA16(sf[ks], qf[t2][ks], a);
                  oacc[tt] = a; }
          } }
        if (MODE == 1) {
#pragma unroll
            for (int tt = 0; tt < 4; ++tt) held[tt] = cvtpk4(oacc[tt]);
            c_held = c;
        }
#pragma unroll
        for (int kh = 0; kh < 2; ++kh) {
            pg8::bf16x8 kf[4][2];
#pragma unroll
            for (int k2 = 0; k2 < 4; ++k2) { const int kt = 4 * kh + k2;
                kf[k2][0] = tr_pair(IM + 16384 + off_b(8 * g + q4, 2 * kt + (p4 >> 1)) + 8 * (p4 & 1), IM + 16384 + off_b(8 * g + 4 + q4, 2 * kt + (p4 >> 1)) + 8 * (p4 & 1));
                kf[k2][1] = tr_pair(IM + 16384 + off_b(32 + 8 * g + q4, 2 * kt + (p4 >> 1)) + 8 * (p4 & 1), IM + 16384 + off_b(32 + 8 * g + 4 + q4, 2 * kt + (p4 >> 1)) + 8 * (p4 & 1)); }
#pragma unroll
            for (int k2 = 0; k2 < 4; ++k2) { const int kt = 4 * kh + k2; S[kt] = MFMA16(kf[k2][0], vf[0], S[kt]); S[kt] = MFMA16(kf[k2][1], vf[1], S[kt]); }
        }
        if (MODE == 2) {
            LAS float* PT = (LAS float*)(L + HG_PART);
#pragma unroll
            for (int tt = 0; tt < 4; ++tt) { const unsigned lo = (unsigned)scr[tt], hi = (unsigned)(scr[tt] >> 32);
                oacc[tt][0] += pg8::bf_lo(lo); oacc[tt][1] += pg8::bf_hi(lo); oacc[tt][2] += pg8::bf_lo(hi); oacc[tt][3] += pg8::bf_hi(hi);
                float ss = (oacc[tt][0] * oacc[tt][0] + oacc[tt][1] * oacc[tt][1]) + (oacc[tt][2] * oacc[tt][2] + oacc[tt][3] * oacc[tt][3]);
                ss += __shfl_xor(ss, 16); ss += __shfl_xor(ss, 32);
                if (g == 0) PT[(16 * tt + n) * 8 + w] = ss; }
            __syncthreads();
#pragma unroll
            for (int tt = 0; tt < 4; ++tt) { const f32x4 pa = *(const LAS f32x4*)(PT + (16 * tt + n) * 8), pb = *(const LAS f32x4*)(PT + (16 * tt + n) * 8 + 4);
                const float rstd = 1.0f / sqrtf(((pa[0] + pa[1]) + (pa[2] + pa[3]) + (pb[0] + pb[1]) + (pb[2] + pb[3])) * (1.f / HGD) + EPS);
                const unsigned long long zz = zz4[tt]; const unsigned zl = (unsigned)zz, zh = (unsigned)(zz >> 32);
                const float z0 = pg8::bf_lo(zl), z1 = pg8::bf_hi(zl), z2 = pg8::bf_lo(zh), z3 = pg8::bf_hi(zh);
                f32x4 ov; ov[0] = oacc[tt][0] * rstd * wv[0] * z0 * pg8::sigmoidf_(z0); ov[1] = oacc[tt][1] * rstd * wv[1] * z1 * pg8::sigmoidf_(z1);
                ov[2] = oacc[tt][2] * rstd * wv[2] * z2 * pg8::sigmoidf_(z2); ov[3] = oacc[tt][3] * rstd * wv[3] * z3 * pg8::sigmoidf_(z3);
                held[tt] = cvtpk4(ov); }
            c_held = c;
        }
    }
    if (c_held >= 0) { const int n = lane & 15, g = lane >> 4;
#pragma unroll
        for (int tt = 0; tt < 4; ++tt) { if (MODE == 1) SCR[(size_t)((c_held - c0) * 4 + tt) * 512 + tid] = held[tt];
            else *(unsigned long long*)(OB + (size_t)(64 * c_held + 16 * tt + n) * PW + chb + 16 * w + 4 * g) = held[tt]; } }
    __syncthreads();
}

constexpr int NA_SLOT = 16384, NA_NSLOT = 9, NA_BIAS = NA_SLOT * NA_NSLOT, NA_LDS_END = NA_BIAS + 2048;
static_assert(NA_LDS_END <= RING_BYTES, "na lds");
__device__ __forceinline__ void tr_read2(unsigned a0, unsigned a1, s16x4& r0, s16x4& r1) {
    asm volatile("ds_read_b64_tr_b16 %0, %2\n\tds_read_b64_tr_b16 %1, %3\n\ts_waitcnt lgkmcnt(0)" : "=&v"(r0), "=&v"(r1) : "v"(a0), "v"(a1) : "memory");
}
__device__ __forceinline__ int na_rs(int r) { int rs = r - 4; return rs < 0 ? 0 : (rs > GROWS - 8 ? GROWS - 8 : rs); }
__device__ __forceinline__ void na_unit(Frame& F, int h, int r0, const bf16* Q, const bf16* K, const bf16* V, const bf16* Z, const float* rpb, bf16* O) {
    LAS unsigned char* L = F.lds + RING_OFF;
    const unsigned lbase = (unsigned)(size_t)L;
    const int tid = F.tid_(), lane = F.lane_(), w = F.wave;
    const int scol = tid >> 3, sch = tid & 7;
    const unsigned sdst = (unsigned)(scol * 128 + 16 * (sch ^ (scol & 7)));
    __syncthreads();
    for (int i = tid; i < 15 * 31; i += NWAVES * 64) ((LAS float*)(L + NA_BIAS))[i] = rpb[h * 465 + i] * 1.44269504089f;
    int hi = na_rs(r0) - 1;
    { const int need = na_rs(r0 + 1) + 7;
      for (int kr = hi + 1; kr <= need; ++kr) { const size_t o = (size_t)(kr * GW + scol) * PW + h * NADH + sch * 8;
          const v4u kv = *(const v4u*)(K + o), vv = *(const v4u*)(V + o); LAS unsigned char* sl = L + (kr % NA_NSLOT) * NA_SLOT;
          *(LAS v4u*)(sl + sdst) = kv; *(LAS v4u*)(sl + 8192 + sdst) = vv; }
      hi = need; }
    __syncthreads();
    pg8::bf16x8 qnx[2]; unsigned long long znx[4];
    { const int rq = r0 + (w >> 2), tq = rq * GW + 16 * (w & 3) + (lane & 15), g0 = lane >> 4;
#pragma unroll
      for (int ks = 0; ks < 2; ++ks) qnx[ks] = *(const pg8::bf16x8*)(Q + (size_t)tq * PW + h * NADH + 32 * ks + 8 * g0);
#pragma unroll
      for (int dt = 0; dt < 4; ++dt) znx[dt] = *(const unsigned long long*)(Z + (size_t)tq * PW + h * NADH + 16 * dt + 4 * g0); }
    for (int st = 0; st < 8; ++st) {
        const int r = r0 + 2 * st;
        pg8::bf16x8 qf[2]; unsigned long long zc[4];
#pragma unroll
        for (int ks = 0; ks < 2; ++ks) qf[ks] = qnx[ks];
#pragma unroll
        for (int dt = 0; dt < 4; ++dt) zc[dt] = znx[dt];
        if (st < 7) { const int rq = r + 2 + (w >> 2), tq = rq * GW + 16 * (w & 3) + (lane & 15), g0 = lane >> 4;
#pragma unroll
            for (int ks = 0; ks < 2; ++ks) qnx[ks] = *(const pg8::bf16x8*)(Q + (size_t)tq * PW + h * NADH + 32 * ks + 8 * g0);
#pragma unroll
            for (int dt = 0; dt < 4; ++dt) znx[dt] = *(const unsigned long long*)(Z + (size_t)tq * PW + h * NADH + 16 * dt + 4 * g0); }
        int nnew = 0; v4u pk[2], pv[2];
        if (st < 7) { const int need = na_rs(r + 3) + 7; nnew = need - hi;
#pragma unroll
            for (int e = 0; e < 2; ++e) if (e < nnew) { const size_t o = (size_t)((hi + 1 + e) * GW + scol) * PW + h * NADH + sch * 8; pk[e] = *(const v4u*)(K + o); pv[e] = *(const v4u*)(V + o); } }
        {
            int lane_v = lane; asm volatile("" : "+v"(lane_v));
            const int n = lane_v & 15, g = lane_v >> 4, q4 = n >> 2, p4 = n & 3;
            const int rq = r + (w >> 2), cb = w & 3, rs = na_rs(rq);
            int kb0 = 16 * cb - 8; kb0 = kb0 < 0 ? 0 : (kb0 > 32 ? 32 : kb0);
            const int qc = 16 * cb + n; int cs = qc - 8; cs = cs < 0 ? 0 : (cs > GW - 16 ? GW - 16 : cs);
            const int tq = rq * GW + qc;
            bool val[2][4]; int ci[2][4];
#pragma unroll
            for (int hf = 0; hf < 2; ++hf)
#pragma unroll
                for (int rr = 0; rr < 4; ++rr) { const int kc = kb0 + 16 * hf + 4 * g + rr; val[hf][rr] = (kc >= cs) && (kc < cs + 16); int c = kc - qc + 15; c = c < 0 ? 0 : (c > 30 ? 30 : c); ci[hf][rr] = c; }
            f32x4 sc[8][2]; float mx = -1e30f;
#pragma unroll
            for (int jr = 0; jr < 8; ++jr) { const int kr = rs + jr; const unsigned slb = (unsigned)((kr % NA_NSLOT) * NA_SLOT); const int ri = kr - rq + 7;
#pragma unroll
                for (int hf = 0; hf < 2; ++hf) { const int col = kb0 + 16 * hf + n; f32x4 a = (f32x4){0.f, 0.f, 0.f, 0.f};
#pragma unroll
                    for (int ks = 0; ks < 2; ++ks) { const pg8::bf16x8 kf = *(const LAS pg8::bf16x8*)(L + slb + col * 128 + 16 * ((4 * ks + g) ^ (col & 7))); a = MFMA16(kf, qf[ks], a); }
                    float bb[4];
#pragma unroll
                    for (int rr = 0; rr < 4; ++rr) bb[rr] = ((const LAS float*)(L + NA_BIAS))[ri * 31 + ci[hf][rr]];
                    asm volatile("" : "+v"(bb[0]), "+v"(bb[1]), "+v"(bb[2]), "+v"(bb[3]));
#pragma unroll
                    for (int rr = 0; rr < 4; ++rr) { const float s2 = val[hf][rr] ? (a[rr] * 1.44269504089f + bb[rr]) : -1e30f; a[rr] = s2; mx = fmaxf(mx, s2); }
                    sc[jr][hf] = a; } }
            mx = fmaxf(mx, __shfl_xor(mx, 16)); mx = fmaxf(mx, __shfl_xor(mx, 32));
            float ls = 0.f; pg8::bf16x8 pf[8];
#pragma unroll
            for (int jr = 0; jr < 8; ++jr) { float e[8];
#pragma unroll
                for (int hf = 0; hf < 2; ++hf)
#pragma unroll
                    for (int rr = 0; rr < 4; ++rr) { e[hf * 4 + rr] = __builtin_amdgcn_exp2f(sc[jr][hf][rr] - mx); ls += e[hf * 4 + rr]; }
                v4u pw; pw.x = pk2(e[0], e[1]); pw.y = pk2(e[2], e[3]); pw.z = pk2(e[4], e[5]); pw.w = pk2(e[6], e[7]); pf[jr] = __builtin_bit_cast(pg8::bf16x8, pw); }
            ls += __shfl_xor(ls, 16); ls += __shfl_xor(ls, 32);
            const float inv = 1.0f / ls;
            f32x4 oacc[4];
#pragma unroll
            for (int dt = 0; dt < 4; ++dt) oacc[dt] = (f32x4){0.f, 0.f, 0.f, 0.f};
#pragma unroll
            for (int jr = 0; jr < 8; ++jr) { const int kr = rs + jr; const unsigned slb = (unsigned)((kr % NA_NSLOT) * NA_SLOT) + 8192u;
                const int c0 = kb0 + 4 * g + q4, c1 = c0 + 16;
#pragma unroll
                for (int dt = 0; dt < 4; ++dt) {
                    const pg8::bf16x8 vf = tr_pair(L + slb + c0 * 128 + 16 * ((2 * dt + (p4 >> 1)) ^ (c0 & 7)) + 8 * (p4 & 1), L + slb + c1 * 128 + 16 * ((2 * dt + (p4 >> 1)) ^ (c1 & 7)) + 8 * (p4 & 1));
                    oacc[dt] = MFMA16(vf, pf[jr], oacc[dt]); } }
#pragma unroll
            for (int dt = 0; dt < 4; ++dt) { const size_t o = (size_t)tq * PW + h * NADH + 16 * dt + 4 * g;
                const unsigned long long zz = zc[dt]; const unsigned zl = (unsigned)zz, zh = (unsigned)(zz >> 32);
                const float z0 = pg8::bf_lo(zl), z1 = pg8::bf_hi(zl), z2 = pg8::bf_lo(zh), z3 = pg8::bf_hi(zh);
                const float o0 = oacc[dt][0] * inv * z0 * pg8::sigmoidf_(z0), o1 = oacc[dt][1] * inv * z1 * pg8::sigmoidf_(z1), o2 = oacc[dt][2] * inv * z2 * pg8::sigmoidf_(z2), o3 = oacc[dt][3] * inv * z3 * pg8::sigmoidf_(z3);
                *(unsigned long long*)(O + o) = (unsigned long long)pk2(o0, o1) | ((unsigned long long)pk2(o2, o3) << 32); }
        }
        __syncthreads();
#pragma unroll
        for (int e = 0; e < 2; ++e) if (e < nnew) { LAS unsigned char* sl = L + ((hi + 1 + e) % NA_NSLOT) * NA_SLOT; *(LAS v4u*)(sl + sdst) = pk[e]; *(LAS v4u*)(sl + 8192 + sdst) = pv[e]; }
        hi += nnew;
        __syncthreads();
    }
}

__device__ __forceinline__ void hg_finish(Frame& F, const float* OFWD, const float* OBWD, const bf16* HZ, const float* w, bf16* OB) {
    const int gw = F.vcu * NWAVES + F.wave, NGW = F.G * NWAVES, lane = F.lane_();
    for (int m = gw; m < M; m += NGW) {
        const f32x4* a = (const f32x4*)(OFWD + (size_t)m * PW) + lane * 4; const f32x4* b = (const f32x4*)(OBWD + (size_t)m * PW) + lane * 4;
        f32x4 o[4]; float ss = 0.f;
#pragma unroll
        for (int i = 0; i < 4; ++i) { o[i] = a[i] + b[i]; ss += (o[i].x * o[i].x + o[i].y * o[i].y) + (o[i].z * o[i].z + o[i].w * o[i].w); }
        ss += __shfl_xor(ss, 1); ss += __shfl_xor(ss, 2); ss += __shfl_xor(ss, 4);
        const float rstd = 1.0f / sqrtf(ss * (1.f / HGD) + EPS);
        const v4u* zp = (const v4u*)(HZ + (size_t)m * PW) + lane * 2; v4u* op = (v4u*)(OB + (size_t)m * PW) + lane * 2;
#pragma unroll
        for (int hh = 0; hh < 2; ++hh) { const v4u zz = zp[hh]; const f32x4 w0 = *((const f32x4*)w + lane * 4 + hh * 2), w1 = *((const f32x4*)w + lane * 4 + hh * 2 + 1);
            const f32x4 o0 = o[hh * 2], o1 = o[hh * 2 + 1];
            float zf[8] = {pg8::bf_lo(zz.x), pg8::bf_hi(zz.x), pg8::bf_lo(zz.y), pg8::bf_hi(zz.y), pg8::bf_lo(zz.z), pg8::bf_hi(zz.z), pg8::bf_lo(zz.w), pg8::bf_hi(zz.w)};
            float r[8] = {o0.x * w0.x, o0.y * w0.y, o0.z * w0.z, o0.w * w0.w, o1.x * w1.x, o1.y * w1.y, o1.z * w1.z, o1.w * w1.w};
#pragma unroll
            for (int i = 0; i < 8; ++i) r[i] = r[i] * rstd * zf[i] * sigm(zf[i]);
            v4u ow; ow.x = pk2(r[0], r[1]); ow.y = pk2(r[2], r[3]); ow.z = pk2(r[4], r[5]); ow.w = pk2(r[6], r[7]); op[hh] = ow; }
    }
}
__device__ __forceinline__ void final_phase(Frame& F, const float* x, const bf16* Zb, const float* ssq, const float* w, float* out) {
    const int gw = F.vcu * NWAVES + F.wave, NGW = F.G * NWAVES, lane = F.lane_();
    for (int m = gw; m < M; m += NGW) {
        const float part = lane < 32 ? ssq[(size_t)m * 32 + lane] : 0.f;
        const float rstd = 1.0f / sqrtf(wave_sum(part) * (1.f / D) + EPS);
        const f32x4* xr = (const f32x4*)(x + (size_t)m * D) + lane; f32x4* orow = (f32x4*)(out + (size_t)m * D) + lane;
        const unsigned long long* zr = (const unsigned long long*)(Zb + (size_t)m * D) + lane;
#pragma unroll
        for (int j = 0; j < 8; ++j) { const f32x4 xv = xr[64 * j]; const unsigned long long zz = zr[64 * j]; const f32x4 wv = *((const f32x4*)w + lane + 64 * j);
            const unsigned lo = (unsigned)zz, hi = (unsigned)(zz >> 32);
            f32x4 o; o.x = xv.x + pg8::bf_lo(lo) * rstd * wv.x; o.y = xv.y + pg8::bf_hi(lo) * rstd * wv.y; o.z = xv.z + pg8::bf_lo(hi) * rstd * wv.z; o.w = xv.w + pg8::bf_hi(hi) * rstd * wv.w;
            orow[64 * j] = o; }
    }
}
struct Args { const float* in[10]; float* out; unsigned char* ws; int ph_lo, ph_hi, li, pad; };
constexpr int N_PHASES = 7;
__global__ void __launch_bounds__(NWAVES * 64, 2) fwd_kernel(Args args) {
    extern __shared__ __attribute__((aligned(16))) unsigned char lds[];
    Frame F;
    F.lds = (LAS unsigned char*)lds;
    F.MISC = (volatile LAS unsigned*)(F.lds + MISC_OFF);
    F.wave = __builtin_amdgcn_readfirstlane((int)threadIdx.x >> 6);
    F.G = gridDim.x; { const int bx = blockIdx.x; F.vcu = (F.G % 8 == 0) ? (bx % 8) * (F.G / 8) + bx / 8 : bx; }
    unsigned char* ws = args.ws;
    F.ctl = (gu32*)(ws + WS_CTL);
    const float* x = args.in[0]; const float* w_pre = args.in[1]; const float* w_in = args.in[2]; const float* b_gate = args.in[3]; const float* rpb = args.in[4];
    const float* lb_logits = args.in[5]; const float* hg_norm_w = args.in[6]; const float* w_br = args.in[7]; const float* w_out = args.in[8]; const float* w_post = args.in[9];
    bf16* WIN_T = (bf16*)(ws + WS_WIN); bf16* WBA_T = (bf16*)(ws + WS_WBA); bf16* WBB_T = (bf16*)(ws + WS_WBB); bf16* WOUT_T = (bf16*)(ws + WS_WOUT);
    bf16* H = (bf16*)(ws + WS_H);
    float* SSQ = (float*)(ws + WS_SSQ);
    bf16* XN = (bf16*)args.out;
    bf16* OA = (bf16*)((unsigned char*)args.out + 32 * MiB); bf16* OB = H + P_HQ * PIECE_ELEMS; unsigned char* QMI = (unsigned char*)args.out + 64 * MiB; float* ECG = (float*)(ws + 40 * MiB); bf16* YA = H + P_NK * PIECE_ELEMS; bf16* Y = H + P_HFF * PIECE_ELEMS; bf16* Zb = H + P_HI * PIECE_ELEMS;
    for (int u = F.tid_(); u < (LDS_BYTES - LDSCTL_OFF) / 4; u += NWAVES * 64) ((LAS unsigned*)(F.lds + LDSCTL_OFF))[u] = 0u;
    __syncthreads();
    XcdBarrier bar = xcd_barrier_post((unsigned*)(F.ctl + CW_BAR) + args.li * XCD_BAR_WORDS, F.MISC + 8);
    const int lo = args.ph_lo, hi = args.ph_hi;
#define IN(k) (lo <= (k) && (k) < hi)
#define BOTH(k) (IN(k) && IN((k) + 1))
#define GRID_BAR() xcd_barrier(bar)
#ifndef REP_PHASE
#define REP_PHASE -1
#endif
#ifndef REP_N
#define REP_N 2
#endif
#define REPEAT(k) for (int rep_ = 0; rep_ < ((REP_PHASE == (k)) ? 1 + REP_N : 1); ++rep_)

    if (IN(0)) REPEAT(0) { p0_prologue(F, x, w_pre, w_in, w_br, w_out, XN, WIN_T, WBA_T, WBB_T, WOUT_T); if (BOTH(0)) GRID_BAR(); }
    if (IN(1)) REPEAT(1) {
        pg8::Gemm g{XN, WIN_T, M, INC, D}; pg8::StaticOrder S; S.init(M, INC, F.G, (int)blockIdx.x);
        pg8::EpiBf16 E{H, PW, PW, PIECE_ELEMS, 0.125f};
        pg8::gemm_phase<pg8::EpiBf16, pg8::StaticOrder, false, true>(F.lds + RING_OFF, g, S, E);
        if (BOTH(1)) GRID_BAR();
    }
    float* SLOC = (float*)(ws + WS_SLOC); float* DSEG = (float*)(ws + WS_DSEG);
    if (IN(2)) {
        for (int u = blockIdx.x; u < 16 * HG_NSEG; u += F.G) { const int hd = u / HG_NSEG, j = u % HG_NSEG, head = hd >> 1, dir = hd & 1;
            const int c0 = dir ? (M / 64 - HG_SEGC * (j + 1)) : HG_SEGC * j;
            hg_pre(F, head, dir, c0, HG_SEGC, H, P_HQ, dir ? P_HFB : P_HFF, P_HI, lb_logits, QMI + (size_t)dir * (32 * MiB), ECG + (size_t)dir * (HGH * (M / 64) * 128),
                   SLOC + (size_t)u * HGD * HGD, DSEG + (size_t)u * HGD); }
        REPEAT(9) for (int u = blockIdx.x; u < NAH * (GROWS / 16); u += F.G) na_unit(F, u & 15, (u >> 4) * 16, H + P_NQ * PIECE_ELEMS, H + P_NK * PIECE_ELEMS, H + P_NV * PIECE_ELEMS, H + P_NZ * PIECE_ELEMS, rpb, OA);
        if (BOTH(2)) GRID_BAR();
    }
    if (IN(3)) REPEAT(3) {
        for (int u = blockIdx.x; u < HGH * HG_NSEG; u += F.G) { const int head = u / HG_NSEG, seg = u % HG_NSEG;
            unsigned long long* scr = (unsigned long long*)args.out + (size_t)u * (HG_SEGC * 4 * 512);
            hg_main<1>(F, head, 0, HG_SEGC * seg, HG_SEGC, H, P_HFF, P_HI, QMI, ECG, SLOC + (size_t)((head * 2 + 0) * HG_NSEG) * HGD * HGD, DSEG + (size_t)((head * 2 + 0) * HG_NSEG) * HGD, seg, scr, nullptr, nullptr, nullptr);
            hg_main<2>(F, head, 1, HG_SEGC * seg, HG_SEGC, H, P_HFB, P_HI, QMI + 32 * MiB, ECG + (size_t)HGH * (M / 64) * 128,
                       SLOC + (size_t)((head * 2 + 1) * HG_NSEG) * HGD * HGD, DSEG + (size_t)((head * 2 + 1) * HG_NSEG) * HGD, HG_NSEG - 1 - seg, scr, H + P_HZ * PIECE_ELEMS, hg_norm_w, OB); }
        if (BOTH(3)) GRID_BAR();
    }
    if (IN(4)) REPEAT(4) {
        { pg8::Gemm g{OA, WBA_T, M, D, PW}; pg8::StaticOrder S; S.init(M, D, F.G, (int)blockIdx.x);
          pg8::EpiGate<false> E{H + P_GA * PIECE_ELEMS, PIECE_ELEMS, b_gate, nullptr, YA, D};
          pg8::gemm_phase<pg8::EpiGate<false>, pg8::StaticOrder, true, true>(F.lds + RING_OFF, g, S, E); }
        { pg8::Gemm g{OB, WBB_T, M, D, PW}; pg8::StaticOrder S; S.init(M, D, F.G, (int)blockIdx.x);
          pg8::EpiGate<true> E{H + P_GB * PIECE_ELEMS, PIECE_ELEMS, b_gate + D, YA, Y, D};
          pg8::gemm_phase<pg8::EpiGate<true>, pg8::StaticOrder, true, true>(F.lds + RING_OFF, g, S, E); }
#if REP_PHASE == 8
        { pg8::Gemm g{OB, WBB_T, M, D, PW}; pg8::StaticOrder S; S.init(M, D, F.G, (int)blockIdx.x);
          pg8::EpiGate<true> E{H + P_GB * PIECE_ELEMS, PIECE_ELEMS, b_gate + D, YA, Y, D};
          pg8::gemm_phase<pg8::EpiGate<true>, pg8::StaticOrder, true, true>(F.lds + RING_OFF, g, S, E); }
        { pg8::Gemm g{OB, WBB_T, M, D, PW}; pg8::StaticOrder S; S.init(M, D, F.G, (int)blockIdx.x);
          pg8::EpiGate<true> E{H + P_GB * PIECE_ELEMS, PIECE_ELEMS, b_gate + D, YA, Y, D};
          pg8::gemm_phase<pg8::EpiGate<true>, pg8::StaticOrder, true, true>(F.lds + RING_OFF, g, S, E); }
#endif
        if (BOTH(4)) GRID_BAR();
    }
    if (IN(5)) REPEAT(5) {
        pg8::Gemm g{Y, WOUT_T, M, D, D}; pg8::StaticOrder S; S.init(M, D, F.G, (int)blockIdx.x);
        pg8::EpiSsq E{Zb, D, SSQ};
        pg8::gemm_phase<pg8::EpiSsq, pg8::StaticOrder, true, true>(F.lds + RING_OFF, g, S, E);
        if (BOTH(5)) GRID_BAR();
    }
    if (IN(6)) REPEAT(6) { final_phase(F, x, Zb, SSQ, w_post, args.out); }
#undef IN
#undef BOTH
}

#ifndef MK_N_LAUNCHES
#define MK_N_LAUNCHES 1
#endif
extern "C" void kernel_launch(void* const* d_in, const int* in_sizes, int n_in, void* d_out, int out_size, void* d_ws, size_t ws_size, hipStream_t stream) {
    static int grid = 0;
    if (grid == 0) {
        if (n_in != 10 || in_sizes[0] != M * D || out_size != M * D || ws_size < WS_END) { fprintf(stderr, "kernel_launch: unexpected shapes: n_in %d in0 %d out %d ws %zu (need %zu)\n", n_in, n_in > 0 ? in_sizes[0] : -1, out_size, ws_size, (size_t)WS_END); grid = -1; return; }
        int dev = 0, cus = 0, per_cu = 0;
        if (hipGetDevice(&dev) != hipSuccess || hipDeviceGetAttribute(&cus, hipDeviceAttributeMultiprocessorCount, dev) != hipSuccess) { fprintf(stderr, "kernel_launch: device query failed\n"); grid = -1; return; }
        if (hipFuncSetAttribute((const void*)fwd_kernel, hipFuncAttributeMaxDynamicSharedMemorySize, LDS_BYTES) != hipSuccess) { fprintf(stderr, "kernel_launch: hipFuncSetAttribute failed\n"); grid = -1; return; }
        if (hipOccupancyMaxActiveBlocksPerMultiprocessor(&per_cu, (const void*)fwd_kernel, NWAVES * 64, LDS_BYTES) != hipSuccess || per_cu < 1) { fprintf(stderr, "kernel_launch: occupancy query reports %d blocks/CU; nothing launched\n", per_cu); (void)hipGetLastError(); grid = -1; return; }
        grid = cus;
    }
    if (grid < 0) return;
    if (hipMemsetAsync((char*)d_ws + WS_CTL, 0, CTL_ZERO_BYTES, stream) != hipSuccess) { fprintf(stderr, "kernel_launch: memset failed\n"); return; }
    Args a{};
    for (int i = 0; i < 10; ++i) a.in[i] = (const float*)d_in[i];
    a.out = (float*)d_out; a.ws = (unsigned char*)d_ws;
#if MK_N_LAUNCHES == 1
    a.ph_lo = 0; a.ph_hi = N_PHASES; a.li = 0;
    hipLaunchKernelGGL(fwd_kernel, dim3(grid), dim3(NWAVES * 64), LDS_BYTES, stream, a);
#else
    for (int li = 0; li < N_PHASES; ++li) { a.ph_lo = li; a.ph_hi = li + 1; a.li = li;
        hipLaunchKernelGGL(fwd_kernel, dim3(grid), dim3(NWAVES * 64), LDS_BYTES, stream, a); }
#endif
    const hipError_t le = hipPeekAtLastError();
    if (le != hipSuccess) fprintf(stderr, "kernel_launch: launch failed: %s\n", hipGetErrorName(le));
}
```
